# Optimizing an MI355X kernel written in HIP

```python
import math
import jax, jax.numpy as jnp
from jax import lax
import numpy as np


D_MODEL = 1024
BATCH = 4
SEQ = 8192
DEPTH = 2

D_FF = 2816
NORM_EPS = 1e-6

HY_WIDTH = D_MODEL // 4
HY_ORDER = 2
HY_SHORT = 3
HY_BANDS = 16
HY_EMB = 1 + 2 * HY_BANDS
HY_FILTER_HIDDEN = 64
HY_FAST_DECAY_PCT = 0.3
HY_SLOW_DECAY_PCT = 1.5
HY_DECAY_TARGET = 1e-2
HY_DECAY_SHIFT = 0.0
HY_IN = (HY_ORDER + 1) * HY_WIDTH

MLA_HEADS = 4
MLA_QK_NOPE = 128
MLA_QK_ROPE = 64
MLA_V_HEAD = 128
MLA_Q_LORA = D_MODEL // 4
MLA_KV_LORA = D_MODEL // 8
MLA_WIDTH = MLA_HEADS * MLA_V_HEAD
ROPE_BASE = 10000.0
Q_BLOCK = 128

GLA_HEADS = 4
GLA_WIDTH = D_MODEL // 4
GLA_KEY = GLA_WIDTH // 2
GLA_DK = GLA_KEY // GLA_HEADS
GLA_DV = GLA_WIDTH // GLA_HEADS
GLA_GATE_RANK = 16
GLA_GATE_NORM = 16.0
GLA_CHUNK = 64

MIX_WIDTH = HY_WIDTH + MLA_WIDTH + GLA_WIDTH
IN_SPLITS = (HY_IN, MLA_Q_LORA, MLA_KV_LORA, MLA_QK_ROPE, GLA_KEY, GLA_KEY, GLA_WIDTH, GLA_GATE_RANK, GLA_GATE_RANK, GLA_WIDTH)
IN_WIDTH = sum(IN_SPLITS)

kernel_name = 'hybrid_hyena_mla_gla_macaron_encoder'


def rms_norm(x, g):
    xf = x.astype(jnp.float32)
    y = xf * lax.rsqrt(jnp.mean(xf * xf, axis=-1, keepdims=True) + NORM_EPS)
    return (y * g.astype(jnp.float32)).astype(x.dtype)


def swiglu_ffn(x, w_gate, w_up, w_down):
    return (jax.nn.silu(x @ w_gate) * (x @ w_up)) @ w_down


def centred_short_conv(u, w, b):
    L = u.shape[1]
    pad = HY_SHORT // 2
    up = jnp.pad(u, ((0, 0), (pad, HY_SHORT - 1 - pad), (0, 0)))
    y = b
    for tap in range(HY_SHORT):
        y = y + up[:, tap:tap + L] * w[tap]
    return y


def hyena_filters(L, w1, b1, f1, w2, b2, f2, w3):
    pos = jnp.arange(L, dtype=jnp.float32)
    t = pos / (L - 1)
    bands = jnp.linspace(1e-4, HY_BANDS - 1, HY_BANDS, dtype=jnp.float32)
    ang = (2.0 * math.pi * pos / L)[:, None] * bands[None, :]
    z = jnp.concatenate([t[:, None], jnp.cos(ang), -jnp.sin(ang)], axis=-1)
    h = jnp.sin(f1 * (z @ w1 + b1))
    h = jnp.sin(f2 * (h @ w2 + b2))
    h = (h @ w3).astype(jnp.float32).reshape(L, HY_ORDER, 2, HY_WIDTH)
    max_decay = math.log(HY_DECAY_TARGET) / HY_FAST_DECAY_PCT
    min_decay = math.log(HY_DECAY_TARGET) / HY_SLOW_DECAY_PCT
    deltas = jnp.abs(jnp.linspace(min_decay, max_decay, HY_WIDTH, dtype=jnp.float32))
    window = jnp.exp(-t[:, None] * deltas[None, :]) + HY_DECAY_SHIFT
    h = h * window[:, None, None, :]
    h_fwd = h[:, :, 0]
    h_bwd = h[1:, :, 1][::-1]
    return jnp.concatenate([h_fwd, jnp.zeros_like(h_fwd[:1]), h_bwd], axis=0)


def fft_long_conv(u, kern, skip):
    L = u.shape[1]
    U = jnp.fft.rfft(u, n=2 * L, axis=1)
    K = jnp.fft.rfft(kern, n=2 * L, axis=0)
    y = jnp.fft.irfft(U * K[None], n=2 * L, axis=1)[:, :L]
    return y + u * skip.astype(jnp.float32)


def hyena_mixer(u_proj, conv_w, conv_b, w1, b1, f1, w2, b2, f2, w3, skip, out_norm):
    dtype = u_proj.dtype
    L = u_proj.shape[1]
    u = centred_short_conv(u_proj, conv_w, conv_b).astype(jnp.float32)
    v, x1, x2 = jnp.split(u, HY_ORDER + 1, axis=-1)
    kern = hyena_filters(L, w1, b1, f1, w2, b2, f2, w3)
    z = x1 * fft_long_conv(v, kern[:, 0], skip[0])
    y = x2 * fft_long_conv(z, kern[:, 1], skip[1])
    return rms_norm(y.astype(dtype), out_norm)


def rope(x, pos):
    half = x.shape[-1] // 2
    inv = ROPE_BASE ** (-jnp.arange(half, dtype=jnp.float32) * 2.0 / x.shape[-1])
    ang = pos[:, None] * inv[None, :]
    cos = jnp.cos(ang)[None, :, None, :]
    sin = jnp.sin(ang)[None, :, None, :]
    xf = x.astype(jnp.float32)
    a, b = xf[..., :half], xf[..., half:]
    return jnp.concatenate([a * cos - b * sin, a * sin + b * cos], axis=-1).astype(x.dtype)


def mla_mixer(cq_in, ckv_in, kr_in, q_norm, w_uq, kv_norm, w_ukv, out_norm):
    B, S, _ = cq_in.shape
    dqk = MLA_QK_NOPE + MLA_QK_ROPE
    pos = jnp.arange(S, dtype=jnp.float32)
    q = (rms_norm(cq_in, q_norm) @ w_uq).reshape(B, S, MLA_HEADS, dqk)
    q = jnp.concatenate([q[..., :MLA_QK_NOPE], rope(q[..., MLA_QK_NOPE:], pos)], axis=-1)
    kv = (rms_norm(ckv_in, kv_norm) @ w_ukv).reshape(B, S, MLA_HEADS, MLA_QK_NOPE + MLA_V_HEAD)
    k_nope, v = kv[..., :MLA_QK_NOPE], kv[..., MLA_QK_NOPE:]
    k_rope = rope(kr_in[:, :, None, :], pos)
    k = jnp.concatenate([k_nope, jnp.broadcast_to(k_rope, (B, S, MLA_HEADS, MLA_QK_ROPE))], axis=-1)
    scale = dqk ** -0.5
    qb = q.reshape(B, S // Q_BLOCK, Q_BLOCK, MLA_HEADS, dqk).transpose(1, 0, 2, 3, 4)

    def attend_block(q_blk):
        s = jnp.einsum('bqhd,bkhd->bhqk', q_blk, k).astype(jnp.float32) * scale
        p = jax.nn.softmax(s, axis=-1).astype(v.dtype)
        return jnp.einsum('bhqk,bkhe->bqhe', p, v)

    o = lax.map(attend_block, qb)
    o = o.transpose(1, 0, 2, 3, 4).reshape(B, S, MLA_WIDTH)
    return rms_norm(o, out_norm)


def gla_chunk_scan(q, k, v, g, inclusive):
    B, S, H, dk = q.shape
    dv = v.shape[-1]
    n_chunks = S // GLA_CHUNK

    def to_chunks(t):
        return t.reshape(B, n_chunks, GLA_CHUNK, H, t.shape[-1]).transpose(1, 0, 3, 2, 4)

    mask = jnp.tril(jnp.ones((GLA_CHUNK, GLA_CHUNK), dtype=bool), k=0 if inclusive else -1)

    def step(state, inp):
        qc, kc, vc, gc = inp
        b = lax.cumsum(gc, axis=2)
        o_inter = jnp.einsum('bhcd,bhde->bhce', qc * jnp.exp(b), state)
        diff = b[:, :, :, None, :] - b[:, :, None, :, :]
        decay = jnp.exp(jnp.where(mask[:, :, None], diff, -jnp.inf))
        attn = jnp.einsum('bhid,bhjd,bhijd->bhij', qc, kc, decay)
        o_intra = jnp.einsum('bhij,bhje->bhie', attn, vc)
        b_last = b[:, :, -1:, :]
        state = jnp.exp(b_last[:, :, 0, :, None]) * state + jnp.einsum('bhcd,bhce->bhde', kc * jnp.exp(b_last - b), vc)
        return state, o_inter + o_intra

    init = jnp.zeros((B, H, dk, dv), jnp.float32)
    _, o = lax.scan(step, init, (to_chunks(q), to_chunks(k), to_chunks(v), to_chunks(g)))
    return o.transpose(1, 0, 3, 2, 4).reshape(B, S, H, dv)


def gla_mixer(q_in, k_in, v_in, gf_in, gb_in, r_in, w_gf, b_gf, w_gb, b_gb, head_norm):
    dtype = q_in.dtype
    B, S, _ = q_in.shape
    f32 = jnp.float32

    def heads(t, d):
        return t.astype(f32).reshape(B, S, GLA_HEADS, d)

    q = heads(q_in, GLA_DK) * (GLA_DK ** -0.5)
    k = heads(k_in, GLA_DK)
    v = heads(v_in, GLA_DV)
    g_f = heads(jax.nn.log_sigmoid(gf_in.astype(f32) @ w_gf.astype(f32) + b_gf.astype(f32)) / GLA_GATE_NORM, GLA_DK)
    g_b = heads(jax.nn.log_sigmoid(gb_in.astype(f32) @ w_gb.astype(f32) + b_gb.astype(f32)) / GLA_GATE_NORM, GLA_DK)
    o_f = gla_chunk_scan(q, k, v, g_f, True)
    o_b = gla_chunk_scan(q[:, ::-1], k[:, ::-1], v[:, ::-1], g_b[:, ::-1], False)[:, ::-1]
    o = rms_norm(o_f + o_b, head_norm).reshape(B, S, GLA_WIDTH)
    return (o * jax.nn.silu(r_in.astype(f32))).astype(dtype)


def hybrid_layer(x, ffn1_norm, ffn1_w_gate, ffn1_w_up, ffn1_w_down, mix_norm, w_in,
                 hy_conv_w, hy_conv_b, hy_filt_w1, hy_filt_b1, hy_filt_freq1, hy_filt_w2, hy_filt_b2,
                 hy_filt_freq2, hy_filt_w3, hy_skip, hy_out_norm,
                 mla_q_norm, mla_w_uq, mla_kv_norm, mla_w_ukv, mla_out_norm,
                 gla_w_gate_fwd, gla_b_gate_fwd, gla_w_gate_bwd, gla_b_gate_bwd, gla_head_norm,
                 w_out, ffn2_norm, ffn2_w_gate, ffn2_w_up, ffn2_w_down):
    x = x + 0.5 * swiglu_ffn(rms_norm(x, ffn1_norm), ffn1_w_gate, ffn1_w_up, ffn1_w_down)
    proj = rms_norm(x, mix_norm) @ w_in
    offsets = [int(o) for o in np.cumsum(IN_SPLITS)[:-1]]
    (hy_in, mla_cq, mla_ckv, mla_kr, gla_q, gla_k, gla_v, gla_gf, gla_gb, gla_r) = jnp.split(proj, offsets, axis=-1)
    y_hy = hyena_mixer(hy_in, hy_conv_w, hy_conv_b, hy_filt_w1, hy_filt_b1, hy_filt_freq1, hy_filt_w2,
                       hy_filt_b2, hy_filt_freq2, hy_filt_w3, hy_skip, hy_out_norm)
    y_mla = mla_mixer(mla_cq, mla_ckv, mla_kr, mla_q_norm, mla_w_uq, mla_kv_norm, mla_w_ukv, mla_out_norm)
    y_gla = gla_mixer(gla_q, gla_k, gla_v, gla_gf, gla_gb, gla_r, gla_w_gate_fwd, gla_b_gate_fwd,
                      gla_w_gate_bwd, gla_b_gate_bwd, gla_head_norm)
    x = x + jnp.concatenate([y_hy, y_mla, y_gla], axis=-1) @ w_out
    x = x + 0.5 * swiglu_ffn(rms_norm(x, ffn2_norm), ffn2_w_gate, ffn2_w_up, ffn2_w_down)
    return x


def setup_inputs(seed: int = 0) -> dict:
    key = jax.random.key(seed)
    ks = iter(jax.random.split(key, 40))

    def nrm(shape, scale):
        return scale * jax.random.normal(next(ks), shape, jnp.float32)

    def gain(shape):
        return 1.0 + nrm(shape, 0.02)

    L = DEPTH
    Hf = HY_FILTER_HIDDEN
    return {
        'x': nrm((BATCH, SEQ, D_MODEL), 1.0),
        'ffn1_norm': gain((L, D_MODEL)),
        'ffn1_w_gate': nrm((L, D_MODEL, D_FF), D_MODEL ** -0.5),
        'ffn1_w_up': nrm((L, D_MODEL, D_FF), D_MODEL ** -0.5),
        'ffn1_w_down': nrm((L, D_FF, D_MODEL), D_FF ** -0.5),
        'mix_norm': gain((L, D_MODEL)),
        'w_in': nrm((L, D_MODEL, IN_WIDTH), D_MODEL ** -0.5),
        'hy_conv_w': nrm((L, HY_SHORT, HY_IN), HY_SHORT ** -0.5),
        'hy_conv_b': nrm((L, HY_IN), 0.02),
        'hy_filt_w1': nrm((L, HY_EMB, Hf), HY_EMB ** -0.5),
        'hy_filt_b1': nrm((L, Hf), 0.02),
        'hy_filt_freq1': gain((L, Hf)),
        'hy_filt_w2': nrm((L, Hf, Hf), Hf ** -0.5),
        'hy_filt_b2': nrm((L, Hf), 0.02),
        'hy_filt_freq2': gain((L, Hf)),
        'hy_filt_w3': nrm((L, Hf, HY_ORDER * 2 * HY_WIDTH), Hf ** -0.5),
        'hy_skip': nrm((L, HY_ORDER, HY_WIDTH), 1.0),
        'hy_out_norm': gain((L, HY_WIDTH)),
        'mla_q_norm': gain((L, MLA_Q_LORA)),
        'mla_w_uq': nrm((L, MLA_Q_LORA, MLA_HEADS * (MLA_QK_NOPE + MLA_QK_ROPE)), MLA_Q_LORA ** -0.5),
        'mla_kv_norm': gain((L, MLA_KV_LORA)),
        'mla_w_ukv': nrm((L, MLA_KV_LORA, MLA_HEADS * (MLA_QK_NOPE + MLA_V_HEAD)), MLA_KV_LORA ** -0.5),
        'mla_out_norm': gain((L, MLA_WIDTH)),
        'gla_w_gate_fwd': nrm((L, GLA_GATE_RANK, GLA_KEY), GLA_GATE_RANK ** -0.5),
        'gla_b_gate_fwd': nrm((L, GLA_KEY), 0.1),
        'gla_w_gate_bwd': nrm((L, GLA_GATE_RANK, GLA_KEY), GLA_GATE_RANK ** -0.5),
        'gla_b_gate_bwd': nrm((L, GLA_KEY), 0.1),
        'gla_head_norm': gain((L, GLA_DV)),
        'w_out': nrm((L, MIX_WIDTH, D_MODEL), MIX_WIDTH ** -0.5),
        'ffn2_norm': gain((L, D_MODEL)),
        'ffn2_w_gate': nrm((L, D_MODEL, D_FF), D_MODEL ** -0.5),
        'ffn2_w_up': nrm((L, D_MODEL, D_FF), D_MODEL ** -0.5),
        'ffn2_w_down': nrm((L, D_FF, D_MODEL), D_FF ** -0.5),
        'final_norm': gain((D_MODEL,)),
    }


def reference(x, ffn1_norm, ffn1_w_gate, ffn1_w_up, ffn1_w_down, mix_norm, w_in,
              hy_conv_w, hy_conv_b, hy_filt_w1, hy_filt_b1, hy_filt_freq1, hy_filt_w2, hy_filt_b2,
              hy_filt_freq2, hy_filt_w3, hy_skip, hy_out_norm,
              mla_q_norm, mla_w_uq, mla_kv_norm, mla_w_ukv, mla_out_norm,
              gla_w_gate_fwd, gla_b_gate_fwd, gla_w_gate_bwd, gla_b_gate_bwd, gla_head_norm,
              w_out, ffn2_norm, ffn2_w_gate, ffn2_w_up, ffn2_w_down, final_norm):
    for l in range(DEPTH):
        x = hybrid_layer(x, ffn1_norm[l], ffn1_w_gate[l], ffn1_w_up[l], ffn1_w_down[l], mix_norm[l], w_in[l],
                         hy_conv_w[l], hy_conv_b[l], hy_filt_w1[l], hy_filt_b1[l], hy_filt_freq1[l],
                         hy_filt_w2[l], hy_filt_b2[l], hy_filt_freq2[l], hy_filt_w3[l], hy_skip[l], hy_out_norm[l],
                         mla_q_norm[l], mla_w_uq[l], mla_kv_norm[l], mla_w_ukv[l], mla_out_norm[l],
                         gla_w_gate_fwd[l], gla_b_gate_fwd[l], gla_w_gate_bwd[l], gla_b_gate_bwd[l], gla_head_norm[l],
                         w_out[l], ffn2_norm[l], ffn2_w_gate[l], ffn2_w_up[l], ffn2_w_down[l])
    return rms_norm(x, final_norm)
```

```cpp
#include <hip/hip_runtime.h>
#include <hip/hip_cooperative_groups.h>
#include <cstdio>
#include <cstdint>
namespace cg = cooperative_groups;

#ifndef MK_COOP
#define MK_COOP 1
#endif
#ifndef PROBE_REP
#define PROBE_REP -1
#endif

typedef unsigned short bf16_t;
typedef short bf16x8 __attribute__((ext_vector_type(8)));
typedef short s16x4 __attribute__((ext_vector_type(4)));
typedef float f32x4 __attribute__((ext_vector_type(4)));
typedef float f32x16 __attribute__((ext_vector_type(16)));
typedef unsigned u32x4 __attribute__((ext_vector_type(4)));
typedef unsigned u32x2 __attribute__((ext_vector_type(2)));
#define LAS __attribute__((address_space(3)))

constexpr int NTOK = 32768, DM = 1024, FF = 2816, SEQ = 8192, NB = 4;
constexpr int NTHR = 512;
constexpr int LDS_BYTES = 149504;

constexpr size_t SZ_WUP = (size_t)5632 * 1024 * 2, SZ_WDN = (size_t)1024 * 2816 * 2, SZ_WIN = (size_t)2048 * 1024 * 2, SZ_WOUT = (size_t)1024 * 1024 * 2,
                 SZ_WUQ = (size_t)768 * 256 * 2, SZ_WUKV = (size_t)1024 * 256 * 2;
constexpr size_t OFF_WUP = 0, OFF_WDN = OFF_WUP + 4 * SZ_WUP, OFF_WIN = OFF_WDN + 4 * SZ_WDN, OFF_WOUT = OFF_WIN + 2 * SZ_WIN, OFF_WUQ = OFF_WOUT + 2 * SZ_WOUT,
                 OFF_WUKV = OFF_WUQ + 2 * SZ_WUQ, OFF_XB = OFF_WUKV + 2 * SZ_WUKV, OFF_SSX = OFF_XB + (size_t)NTOK * DM * 2, OFF_H2T = OFF_SSX + (size_t)NTOK * 16 * 4,
                 OFF_ROPE = OFF_H2T + (size_t)2 * 64 * 8192 * 4, OFF_BAR = OFF_ROPE + (size_t)8192 * 64 * 4, OFF_TR = OFF_BAR + 16384;
constexpr size_t T_ACT = OFF_TR;
constexpr size_t T_HYT = OFF_TR;
constexpr size_t T_CQB = T_HYT + (size_t)768 * NTOK * 2;
constexpr size_t T_CKVB = T_CQB + (size_t)NTOK * 256 * 2;
constexpr size_t T_SSCQ = T_CKVB + (size_t)NTOK * 256 * 2;
constexpr size_t T_SSCKV = T_SSCQ + (size_t)NTOK * 4 * 4;
constexpr size_t T_KR = T_SSCKV + (size_t)NTOK * 4 * 4;
constexpr size_t T_GIN = T_KR + (size_t)NTOK * 64 * 2;
constexpr size_t T_GG = T_GIN + (size_t)NTOK * 832 * 2;
constexpr size_t T_FK = T_GG + (size_t)NTOK * 32 * 4;
constexpr size_t T_ATTO = T_FK;
constexpr size_t T_SF = T_FK + (size_t)256 * 2 * 16384 * 8;
constexpr size_t T_SB = T_SF + (size_t)16 * 128 * 2048 * 4;
constexpr size_t T_DF = T_SB + (size_t)16 * 128 * 2048 * 4;
constexpr size_t T_DB = T_DF + (size_t)16 * 128 * 32 * 4;
constexpr size_t T_QN = T_DB + (size_t)16 * 128 * 32 * 4;
constexpr size_t T_MIXB = T_QN;
constexpr size_t T_QR = T_QN + (size_t)NTOK * 4 * 128 * 2;
constexpr size_t T_KN = T_QR + (size_t)NTOK * 4 * 64 * 2;
constexpr size_t T_V = T_KN + (size_t)NTOK * 4 * 128 * 2;
constexpr size_t WS_END = T_V + (size_t)NTOK * 4 * 128 * 2;
static_assert(WS_END <= (size_t)536870912, "workspace over 512 MiB");
static_assert(T_ACT + (size_t)NTOK * FF * 2 <= WS_END, "act");
static_assert((size_t)NTOK * DM * 2 <= (T_KN + (size_t)NTOK * 4 * 128 * 2) - T_QN, "mixb alias");

struct Params {
    const float* in[34];
    float* out;
    unsigned char* ws;
    int ph_lo, ph_hi;
};

typedef const Params __attribute__((address_space(4)))* KP;
__device__ __forceinline__ int opaque_tid() { int t = threadIdx.x; asm volatile("" : "+v"(t)); return t; }
__device__ __forceinline__ unsigned char* opaque_ptr(unsigned char* q) { return q; }
__device__ __forceinline__ int opaque_bid() { int t = blockIdx.x; asm volatile("" : "+s"(t)); return t; }
__device__ __forceinline__ unsigned cvt_pk_bf16(float lo, float hi) { unsigned r; asm("v_cvt_pk_bf16_f32 %0, %1, %2" : "=v"(r) : "v"(lo), "v"(hi)); return r; }
__device__ __forceinline__ bf16_t f2bf(float f) { return (bf16_t)(cvt_pk_bf16(f, 0.f) & 0xffffu); }
__device__ __forceinline__ float bf2f(bf16_t b) { return __uint_as_float(((unsigned)b) << 16); }
__device__ __forceinline__ float bflo(unsigned w) { return __uint_as_float(w << 16); }
__device__ __forceinline__ float bfhi(unsigned w) { return __uint_as_float(w & 0xffff0000u); }
__device__ __forceinline__ float sin_rev(float r) { return __builtin_amdgcn_sinf(r); }
__device__ __forceinline__ float cos_rev(float r) { return __builtin_amdgcn_cosf(r); }
__device__ __forceinline__ float fast_sin(float x) { float r = x * 0.15915494309189535f; r = r - floorf(r); return __builtin_amdgcn_sinf(r); }
__device__ __forceinline__ float quad_sum(float s) {
    auto a = __builtin_amdgcn_permlane16_swap(__float_as_uint(s), __float_as_uint(s), false, false); s = __uint_as_float(a[0]) + __uint_as_float(a[1]);
    auto b = __builtin_amdgcn_permlane32_swap(__float_as_uint(s), __float_as_uint(s), false, false); return __uint_as_float(b[0]) + __uint_as_float(b[1]);
}
__device__ __forceinline__ float rstd16(const float* ss, int row) {
    const f32x4* p = (const f32x4*)(ss + (size_t)row * 16); const f32x4 a = p[0], b = p[1], c = p[2], d = p[3];
    const float s = ((a.x + a.y) + (a.z + a.w)) + ((b.x + b.y) + (b.z + b.w)) + ((c.x + c.y) + (c.z + c.w)) + ((d.x + d.y) + (d.z + d.w));
    return rsqrtf(s * (1.0f / 1024.0f) + 1e-6f);
}
__device__ __forceinline__ float rstd16q(const float* ss, int row, int fq) {
    const f32x4 a = *(const f32x4*)(ss + (size_t)row * 16 + 4 * fq); float s = (a.x + a.y) + (a.z + a.w);
    s = quad_sum(s);
    return rsqrtf(s * (1.0f / 1024.0f) + 1e-6f);
}
__device__ __forceinline__ float rstd4(const float* ss, int row, float invn) {
    const f32x4 a = *(const f32x4*)(ss + (size_t)row * 4); return rsqrtf(((a.x + a.y) + (a.z + a.w)) * invn + 1e-6f);
}

namespace pg8 {
constexpr int BM = 256, BK = 64, HALF = 128, HTB = HALF * BK * 2, NXCD = 8, WGM = 8;
__host__ __device__ __forceinline__ int lds_byte(int r, int c) { const int st = (r >> 4) * 2 + (c >> 5), rr = r & 15, cc = c & 31, ob = rr * 64 + cc * 2; return st * 1024 + (ob ^ (((ob >> 9) & 1) << 5)); }
__host__ __device__ __forceinline__ void stage_rc(int b, int& R, int& C) { const int st = b / 1024, sb = b % 1024, swz = sb ^ (((sb >> 9) & 1) << 5); R = (st >> 1) * 16 + swz / 64; C = (st & 1) * 32 + (swz % 64) / 2; }
__host__ __device__ __forceinline__ int perm32(int rho) { const int n = rho >> 4, i = rho & 15; return 8 * (i >> 2) + 4 * n + (i & 3); }
struct Unit { int pm, pn; };
struct Gemm { const bf16_t* A; const bf16_t* Bt; int M, N, K, lda; };
struct StaticOrder {
    int nM, nN, nwg, G, c;
    __device__ void init(int M, int N, int G_, int c_) { nM = M / BM; nN = N / BM; nwg = nM * nN; G = G_; c = c_; }
    __device__ bool next(int i, Unit& u) const {
        const long L = (long)i * G + c; if (L >= nwg) return false;
        int wgid = (int)L; { const int q = nwg / NXCD, r = nwg % NXCD, xcd = wgid % NXCD, off = wgid / NXCD; wgid = (xcd < r ? xcd * (q + 1) : r * (q + 1) + (xcd - r) * q) + off; }
        const int nig = WGM * nN, gid = wgid / nig, fm = gid * WGM, gsz = (nM - fm) < WGM ? (nM - fm) : WGM;
        u.pm = fm + ((wgid % nig) % gsz); u.pn = (wgid % nig) / gsz; return true;
    }
};
template <class Epi>
__device__ __forceinline__ void gemm_phase(LAS unsigned char* lds, const Gemm g, const StaticOrder& S, Epi& E) {
    const int tid = opaque_tid(), wid = __builtin_amdgcn_readfirstlane(tid >> 6), lane = tid & 63, wr = wid >> 2, wc = wid & 3, fr = lane & 15, fq = lane >> 4;
    int K = g.K, lda = g.lda; asm volatile("" : "+s"(K), "+s"(lda));
    const int nt = K / BK;
    unsigned voffA[2], voffB[2];
#pragma unroll
    for (int i = 0; i < 2; ++i) { int R, C; stage_rc(tid * 16 + i * 8192, R, C); const int Rb = Epi::PERM ? ((R & ~31) + perm32(R & 31)) : R; voffA[i] = (unsigned)(R * lda + C) * 2u; voffB[i] = (unsigned)(Rb * K + C) * 2u; }
    const size_t kstep = (size_t)(BK * 2);
    const size_t hstepA = (size_t)HALF * lda * 2, hstepB = (size_t)HALF * K * 2;
    const size_t tstepA = 2 * hstepA, tstepB = 2 * hstepB;
    const unsigned ldsw = (unsigned)wid * 1024u;
    const int aoff = lds_byte(wr * 64 + fr, fq * 8), boff = lds_byte(wc * 32 + fr, fq * 8);
#define PG8_SA(b, h) (((b) * 2 + (h)) * HTB)
#define PG8_SB(b, h) ((4 + (b) * 2 + (h)) * HTB)
#define PG8_STAGE(bufoff, gbase, voff) do { _Pragma("unroll") for (int _i = 0; _i < 2; ++_i) \
        __builtin_amdgcn_global_load_lds((const unsigned*)((const char*)(gbase) + (voff)[_i]), (LAS unsigned*)(lds + (bufoff) + ldsw + _i * 8192), 16, 0, 0); } while (0)
#define PG8_LDA(dst, b, h) do { _Pragma("unroll") for (int m = 0; m < 4; ++m) _Pragma("unroll") for (int k = 0; k < 2; ++k) dst[m][k] = *(const LAS bf16x8*)(lds + PG8_SA(b, h) + aoff + m * 2048 + k * 1024); } while (0)
#define PG8_LDB(dst, b, h) do { _Pragma("unroll") for (int n = 0; n < 2; ++n) _Pragma("unroll") for (int k = 0; k < 2; ++k) dst[n][k] = *(const LAS bf16x8*)(lds + PG8_SB(b, h) + boff + n * 2048 + k * 1024); } while (0)
#define PG8_MMA(ai, bj, At, Bt) do { __builtin_amdgcn_s_setprio(1); _Pragma("unroll") for (int m = 0; m < 4; ++m) _Pragma("unroll") for (int n = 0; n < 2; ++n) _Pragma("unroll") for (int k = 0; k < 2; ++k) \
        acc[ai][bj][m][n] = __builtin_amdgcn_mfma_f32_16x16x32_bf16(Bt[n][k], At[m][k], acc[ai][bj][m][n], 0, 0, 0); __builtin_amdgcn_s_setprio(0); } while (0)
#define PG8_WAIT_V(n) asm volatile("s_waitcnt vmcnt(" #n ")" ::: "memory")
#define PG8_WAIT_L(n) asm volatile("s_waitcnt lgkmcnt(" #n ")" ::: "memory")
#define PG8_BAR __builtin_amdgcn_s_barrier()
#define PG8_SCHED __builtin_amdgcn_sched_barrier(0)
    Unit cur, nxt; int ui = 0;
    if (!S.next(0, cur)) return;
    f32x4 acc[2][2][4][2];
#pragma unroll
    for (int a = 0; a < 2; ++a)
#pragma unroll
        for (int b = 0; b < 2; ++b)
#pragma unroll
            for (int m = 0; m < 4; ++m)
#pragma unroll
                for (int n = 0; n < 2; ++n) acc[a][b][m][n] = (f32x4){0.f, 0.f, 0.f, 0.f};
    bf16x8 At[4][2], B0[2][2], B1[2][2];
    const char* cA = (const char*)g.A + (size_t)cur.pm * tstepA; const char* cB = (const char*)g.Bt + (size_t)cur.pn * tstepB;
    PG8_STAGE(PG8_SB(0, 0), cB, voffB); PG8_STAGE(PG8_SA(0, 0), cA, voffA); PG8_STAGE(PG8_SB(0, 1), cB + hstepB, voffB); PG8_STAGE(PG8_SA(0, 1), cA + hstepA, voffA);
    if (wr == 1) PG8_BAR;
    PG8_WAIT_V(4); PG8_BAR;
    PG8_STAGE(PG8_SB(1, 0), cB + kstep, voffB); PG8_STAGE(PG8_SA(1, 0), cA + kstep, voffA); PG8_STAGE(PG8_SB(1, 1), cB + hstepB + kstep, voffB);
    PG8_WAIT_V(6); PG8_BAR;
    for (;;) {
        const bool has_next = S.next(ui + 1, nxt);
        const char* nA = has_next ? (const char*)g.A + (size_t)nxt.pm * tstepA : cA; const char* nB = has_next ? (const char*)g.Bt + (size_t)nxt.pn * tstepB : cB;
        for (int t = 0; t < nt; t += 2) {
            const bool last = (t == nt - 2);
            const char* a1 = cA + (size_t)(t + 1) * kstep;
            const char* a2 = last ? nA : cA + (size_t)(t + 2) * kstep; const char* b2 = last ? nB : cB + (size_t)(t + 2) * kstep;
            const char* a3 = a2 + kstep; const char* b3 = b2 + kstep;
            PG8_LDB(B0, 0, 0); PG8_SCHED; PG8_LDA(At, 0, 0); PG8_STAGE(PG8_SA(1, 1), a1 + hstepA, voffA);
            PG8_WAIT_L(8); PG8_BAR; PG8_WAIT_L(0); PG8_MMA(0, 0, At, B0); PG8_BAR; PG8_SCHED;
            PG8_LDB(B1, 0, 1); PG8_STAGE(PG8_SB(0, 0), b2, voffB);
            PG8_BAR; PG8_WAIT_L(0); PG8_MMA(0, 1, At, B1); PG8_BAR;
            PG8_LDA(At, 0, 1); PG8_STAGE(PG8_SA(0, 0), a2, voffA);
            PG8_BAR; PG8_WAIT_L(0); PG8_MMA(1, 0, At, B0); PG8_BAR; PG8_SCHED;
            PG8_STAGE(PG8_SB(0, 1), b2 + hstepB, voffB);
            PG8_WAIT_V(6); PG8_BAR; PG8_MMA(1, 1, At, B1); PG8_BAR;
            PG8_LDB(B0, 1, 0); PG8_SCHED; PG8_LDA(At, 1, 0); PG8_STAGE(PG8_SA(0, 1), a2 + hstepA, voffA);
            PG8_WAIT_L(8); PG8_BAR; PG8_WAIT_L(0); PG8_MMA(0, 0, At, B0); PG8_BAR; PG8_SCHED;
            PG8_LDB(B1, 1, 1); PG8_STAGE(PG8_SB(1, 0), b3, voffB);
            PG8_BAR; PG8_WAIT_L(0); PG8_MMA(0, 1, At, B1); PG8_BAR;
            PG8_LDA(At, 1, 1); PG8_STAGE(PG8_SA(1, 0), a3, voffA);
            PG8_BAR; PG8_WAIT_L(0); PG8_MMA(1, 0, At, B0); PG8_BAR; PG8_SCHED;
            PG8_STAGE(PG8_SB(1, 1), b3 + hstepB, voffB);
            PG8_WAIT_V(6); PG8_BAR; PG8_MMA(1, 1, At, B1); PG8_BAR;
        }
        { int fr2 = fr, fq2 = fq, wr2 = wr, wc2 = wc; asm volatile("" : "+v"(fr2), "+v"(fq2), "+s"(wr2), "+s"(wc2));
          E(acc, cur, wr2, wc2, fr2, fq2); }
        if (!has_next) break;
#pragma unroll
        for (int a = 0; a < 2; ++a)
#pragma unroll
            for (int b = 0; b < 2; ++b)
#pragma unroll
                for (int m = 0; m < 4; ++m)
#pragma unroll
                    for (int n = 0; n < 2; ++n) acc[a][b][m][n] = (f32x4){0.f, 0.f, 0.f, 0.f};
        cur = nxt; cA = nA; cB = nB; ++ui;
    }
    PG8_WAIT_V(0);
    if (wr == 0) PG8_BAR;
    PG8_BAR;
#undef PG8_SA
#undef PG8_SB
#undef PG8_STAGE
#undef PG8_LDA
#undef PG8_LDB
#undef PG8_MMA
#undef PG8_WAIT_V
#undef PG8_WAIT_L
#undef PG8_BAR
#undef PG8_SCHED
}
}
using pg8::Unit;
typedef f32x4 AccT[2][2][4][2];

struct EpiFfnUp {
    static constexpr bool PERM = true;
    unsigned char* ws; int last_pm; float rsc[8];
    __device__ __forceinline__ void operator()(const AccT& acc, const Unit& u, int wr, int wc, int fr, int fq) {
        bf16_t* act = (bf16_t*)(ws + T_ACT); const float* ssx = (const float*)(ws + OFF_SSX);
        const int row0 = u.pm * 256 + wr * 64 + fr, col0 = u.pn * 128 + wc * 32 + 8 * fq;
        if (u.pm != last_pm) {
            last_pm = u.pm;
#pragma unroll
            for (int ai = 0; ai < 2; ++ai)
#pragma unroll
                for (int m = 0; m < 4; ++m) rsc[ai * 4 + m] = rstd16q(ssx, row0 + ai * 128 + m * 16, fq);
        }
#pragma unroll
        for (int ai = 0; ai < 2; ++ai)
#pragma unroll
            for (int m = 0; m < 4; ++m) {
                const int row = row0 + ai * 128 + m * 16; const float rs = rsc[ai * 4 + m];
                float o[8];
#pragma unroll
                for (int n = 0; n < 2; ++n)
#pragma unroll
                    for (int j = 0; j < 4; ++j) { const float gv = acc[ai][0][m][n][j] * rs, uv = acc[ai][1][m][n][j] * rs; o[4 * n + j] = gv * __builtin_amdgcn_rcpf(1.f + __expf(-gv)) * uv; }
                u32x4 w; w.x = cvt_pk_bf16(o[0], o[1]); w.y = cvt_pk_bf16(o[2], o[3]); w.z = cvt_pk_bf16(o[4], o[5]); w.w = cvt_pk_bf16(o[6], o[7]);
                *(u32x4*)(act + (size_t)row * FF + col0) = w;
            }
    }
};
struct EpiResid {
    static constexpr bool PERM = true;
    unsigned char* ws; float alpha;
    __device__ __forceinline__ void operator()(const AccT& acc, const Unit& u, int wr, int wc, int fr, int fq) const {
        bf16_t* xb = (bf16_t*)(ws + OFF_XB); float* ssx = (float*)(ws + OFF_SSX);
        const int row0 = u.pm * 256 + wr * 64 + fr, col0 = u.pn * 256 + wc * 32 + 8 * fq;
#pragma unroll
        for (int ai = 0; ai < 2; ++ai) {
            u32x4 xo[4][2];
#pragma unroll
            for (int m = 0; m < 4; ++m)
#pragma unroll
                for (int bj = 0; bj < 2; ++bj) xo[m][bj] = *(const u32x4*)(xb + (size_t)(row0 + ai * 128 + m * 16) * DM + col0 + bj * 128);
#pragma unroll
            for (int m = 0; m < 4; ++m) {
                const int row = row0 + ai * 128 + m * 16; float ss = 0.f;
#pragma unroll
                for (int bj = 0; bj < 2; ++bj) {
                    const size_t idx = (size_t)row * DM + col0 + bj * 128;
                    const u32x4 xw = xo[m][bj];
                    const f32x4 xo0 = {bflo(xw.x), bfhi(xw.x), bflo(xw.y), bfhi(xw.y)}, xo1 = {bflo(xw.z), bfhi(xw.z), bflo(xw.w), bfhi(xw.w)};
                    const f32x4 x0 = xo0 + acc[ai][bj][m][0] * alpha, x1 = xo1 + acc[ai][bj][m][1] * alpha;
                    u32x4 w; w.x = cvt_pk_bf16(x0[0], x0[1]); w.y = cvt_pk_bf16(x0[2], x0[3]); w.z = cvt_pk_bf16(x1[0], x1[1]); w.w = cvt_pk_bf16(x1[2], x1[3]); *(u32x4*)(xb + idx) = w;
                    ss += x0[0] * x0[0] + x0[1] * x0[1] + x0[2] * x0[2] + x0[3] * x0[3] + x1[0] * x1[0] + x1[1] * x1[1] + x1[2] * x1[2] + x1[3] * x1[3];
                }
                ss = quad_sum(ss);
                if (fq == 0) ssx[(size_t)row * 16 + u.pn * 4 + wc] = ss;
            }
        }
    }
};
struct EpiWin {
    static constexpr bool PERM = false;
    unsigned char* ws;
    __device__ __forceinline__ void operator()(const AccT& acc, const Unit& u, int wr, int wc, int fr, int fq) const {
        const float* ssx = (const float*)(ws + OFF_SSX); bf16_t* hyt = (bf16_t*)(ws + T_HYT); bf16_t* cqb = (bf16_t*)(ws + T_CQB); bf16_t* ckvb = (bf16_t*)(ws + T_CKVB);
        float* sscq = (float*)(ws + T_SSCQ); float* ssckv = (float*)(ws + T_SSCKV); bf16_t* kr = (bf16_t*)(ws + T_KR); bf16_t* gin = (bf16_t*)(ws + T_GIN); float* gg = (float*)(ws + T_GG); const float* rope = (const float*)(ws + OFF_ROPE);
        const int row0 = u.pm * 256 + wr * 64 + fr, pn = u.pn;
        if (pn < 3) {
#pragma unroll
            for (int ai = 0; ai < 2; ++ai)
#pragma unroll
                for (int m = 0; m < 4; ++m) {
                    const int row = row0 + ai * 128 + m * 16; const float rs = rstd16q(ssx, row, fq);
#pragma unroll
                    for (int bj = 0; bj < 2; ++bj)
#pragma unroll
                        for (int n = 0; n < 2; ++n)
#pragma unroll
                            for (int j = 0; j < 4; ++j) { const int col = pn * 256 + bj * 128 + wc * 32 + n * 16 + 4 * fq + j; hyt[(size_t)col * NTOK + row] = f2bf(acc[ai][bj][m][n][j] * rs); }
                }
        } else if (pn == 3 || pn == 4) {
            bf16_t* dst = pn == 3 ? cqb : ckvb; float* sdst = pn == 3 ? sscq : ssckv;
#pragma unroll
            for (int ai = 0; ai < 2; ++ai)
#pragma unroll
                for (int m = 0; m < 4; ++m) {
                    const int row = row0 + ai * 128 + m * 16; const float rs = rstd16q(ssx, row, fq);
                    float ss = 0.f;
#pragma unroll
                    for (int bj = 0; bj < 2; ++bj)
#pragma unroll
                        for (int n = 0; n < 2; ++n) {
                            const f32x4 v = acc[ai][bj][m][n] * rs; const float q = v[0] * v[0] + v[1] * v[1] + v[2] * v[2] + v[3] * v[3];
                            if (bj == 0 || pn == 3) ss += q;
                            u32x2 w; w.x = cvt_pk_bf16(v[0], v[1]); w.y = cvt_pk_bf16(v[2], v[3]);
                            *(u32x2*)(dst + (size_t)row * 256 + bj * 128 + wc * 32 + n * 16 + 4 * fq) = w;
                        }
                    ss = quad_sum(ss);
                    if (fq == 0) sdst[(size_t)row * 4 + wc] = ss;
                    if (pn == 4) {
                        if (wc < 2) {
                            const int s0 = 16 * wc + 4 * fq; const float* rp = rope + (size_t)(row & (SEQ - 1)) * 64 + s0;
                            const f32x4 cs = *(const f32x4*)rp, sn = *(const f32x4*)(rp + 32);
                            const f32x4 a = acc[ai][1][m][0] * rs, b = acc[ai][1][m][1] * rs;
                            const f32x4 oa = a * cs - b * sn, ob = a * sn + b * cs;
                            u32x2 w; w.x = cvt_pk_bf16(oa[0], oa[1]); w.y = cvt_pk_bf16(oa[2], oa[3]); *(u32x2*)(kr + (size_t)row * 64 + s0) = w;
                            w.x = cvt_pk_bf16(ob[0], ob[1]); w.y = cvt_pk_bf16(ob[2], ob[3]); *(u32x2*)(kr + (size_t)row * 64 + s0 + 32) = w;
                        } else {
#pragma unroll
                            for (int n = 0; n < 2; ++n) {
                                const f32x4 v = acc[ai][1][m][n] * rs; u32x2 w; w.x = cvt_pk_bf16(v[0], v[1]); w.y = cvt_pk_bf16(v[2], v[3]);
                                *(u32x2*)(gin + (size_t)row * 832 + (1152 + wc * 32 + n * 16 + 4 * fq - 1216)) = w;
                            }
                        }
                    }
                }
        } else {
#pragma unroll
            for (int ai = 0; ai < 2; ++ai)
#pragma unroll
                for (int m = 0; m < 4; ++m) {
                    const int row = row0 + ai * 128 + m * 16; const float rs = rstd16q(ssx, row, fq);
#pragma unroll
                    for (int bj = 0; bj < 2; ++bj)
#pragma unroll
                        for (int n = 0; n < 2; ++n) {
                            const f32x4 v = acc[ai][bj][m][n] * rs; const int col = pn * 256 + bj * 128 + wc * 32 + n * 16 + 4 * fq;
                            if (pn == 6 && bj == 1 && wc == 2) *(f32x4*)(gg + (size_t)row * 32 + n * 16 + 4 * fq) = v;
                            u32x2 w; w.x = cvt_pk_bf16(v[0], v[1]); w.y = cvt_pk_bf16(v[2], v[3]);
                            *(u32x2*)(gin + (size_t)row * 832 + (col - 1216)) = w;
                        }
                }
        }
    }
};
struct EpiUq {
    static constexpr bool PERM = false;
    unsigned char* ws;
    __device__ __forceinline__ void operator()(const AccT& acc, const Unit& u, int wr, int wc, int fr, int fq) const {
        const float* sscq = (const float*)(ws + T_SSCQ); bf16_t* qn = (bf16_t*)(ws + T_QN); bf16_t* qr = (bf16_t*)(ws + T_QR); const float* rope = (const float*)(ws + OFF_ROPE);
        const int row0 = u.pm * 256 + wr * 64 + fr, pn = u.pn;
        if (pn < 2) {
#pragma unroll
            for (int ai = 0; ai < 2; ++ai)
#pragma unroll
                for (int m = 0; m < 4; ++m) {
                    const int row = row0 + ai * 128 + m * 16; const float rs = rstd4(sscq, row, 1.0f / 256.0f);
                    const int b = row >> 13, s = row & (SEQ - 1);
#pragma unroll
                    for (int bj = 0; bj < 2; ++bj) { const int h = 2 * pn + bj; bf16_t* rp = qn + ((size_t)(b * 4 + h) * SEQ + s) * 128 + wc * 32 + 4 * fq;
#pragma unroll
                        for (int n = 0; n < 2; ++n) { const f32x4 v = acc[ai][bj][m][n] * rs; u32x2 w; w.x = cvt_pk_bf16(v[0], v[1]); w.y = cvt_pk_bf16(v[2], v[3]); *(u32x2*)(rp + n * 16) = w; } }
                }
        } else {
            const int s0 = 16 * (wc & 1) + 4 * fq;
#pragma unroll
            for (int ai = 0; ai < 2; ++ai)
#pragma unroll
                for (int m = 0; m < 4; ++m) {
                    const int row = row0 + ai * 128 + m * 16; const float rs = rstd4(sscq, row, 1.0f / 256.0f);
                    const int b = row >> 13, s = row & (SEQ - 1);
                    const float* rt = rope + (size_t)s * 64 + s0; const f32x4 cs = *(const f32x4*)rt, sn = *(const f32x4*)(rt + 32);
#pragma unroll
                    for (int bj = 0; bj < 2; ++bj) { const int h = 2 * bj + (wc >> 1); bf16_t* rp = qr + ((size_t)(b * 4 + h) * SEQ + s) * 64 + s0;
                        const f32x4 a = acc[ai][bj][m][0] * rs, bb = acc[ai][bj][m][1] * rs;
                        const f32x4 oa = a * cs - bb * sn, ob = a * sn + bb * cs;
                        u32x2 w; w.x = cvt_pk_bf16(oa[0], oa[1]); w.y = cvt_pk_bf16(oa[2], oa[3]); *(u32x2*)rp = w;
                        w.x = cvt_pk_bf16(ob[0], ob[1]); w.y = cvt_pk_bf16(ob[2], ob[3]); *(u32x2*)(rp + 32) = w; }
                }
        }
    }
};
struct EpiUkv {
    static constexpr bool PERM = false;
    unsigned char* ws;
    __device__ __forceinline__ void operator()(const AccT& acc, const Unit& u, int wr, int wc, int fr, int fq) const {
        const float* ssckv = (const float*)(ws + T_SSCKV); bf16_t* kn = (bf16_t*)(ws + T_KN); bf16_t* vv = (bf16_t*)(ws + T_V);
        const int row0 = u.pm * 256 + wr * 64 + fr, h = u.pn;
#pragma unroll
        for (int ai = 0; ai < 2; ++ai)
#pragma unroll
            for (int m = 0; m < 4; ++m) {
                const int row = row0 + ai * 128 + m * 16; const float rs = rstd4(ssckv, row, 1.0f / 128.0f);
                const int b = row >> 13, s = row & (SEQ - 1); const size_t base = ((size_t)(b * 4 + h) * SEQ + s) * 128 + wc * 32 + 4 * fq;
#pragma unroll
                for (int bj = 0; bj < 2; ++bj) { bf16_t* rp = (bj == 0 ? kn : vv) + base;
#pragma unroll
                    for (int n = 0; n < 2; ++n) { const f32x4 v = acc[ai][bj][m][n] * rs; u32x2 w; w.x = cvt_pk_bf16(v[0], v[1]); w.y = cvt_pk_bf16(v[2], v[3]); *(u32x2*)(rp + n * 16) = w; } }
            }
    }
};

__device__ __forceinline__ int map_col(int type, int nd, int& which) {
    which = 0;
    if (type == 1) { const int t = nd >> 8, r = nd & 255; which = r >> 7; return t * 128 + (r & 127); }
    if (type == 2) { if (nd >= 2016) return -1; if (nd >= 1152 && nd < 1216) { const int P = nd - 1152, w = P >> 5, n = (P >> 4) & 1, i = P & 15; return 1152 + 16 * w + i + 32 * n; } return nd; }
    if (type == 3) { if (nd < 512) { const int h = nd >> 7, d = nd & 127; return h * 192 + d; } const int Pp = nd - 512, h = Pp >> 6, P = Pp & 63; const int s = 16 * (P >> 5) + (P & 15) + 32 * ((P >> 4) & 1); return h * 192 + 128 + s; }
    return nd;
}
struct PrepJob { const float* src; const float* src2; const float* gain; bf16_t* dst; int Ks, Kd, Nsrc, Nd, type; };
__device__ __forceinline__ PrepJob prep_job(KP p, unsigned char* ws, int j) {
    const int l = j >> 3;
    switch (j & 7) {
        case 0: return PrepJob{p->in[2] + (size_t)l * DM * FF, p->in[3] + (size_t)l * DM * FF, p->in[1] + l * DM, (bf16_t*)(ws + OFF_WUP + (l * 2 + 0) * SZ_WUP), 1024, 1024, FF, 5632, 1};
        case 1: return PrepJob{p->in[30] + (size_t)l * DM * FF, p->in[31] + (size_t)l * DM * FF, p->in[29] + l * DM, (bf16_t*)(ws + OFF_WUP + (l * 2 + 1) * SZ_WUP), 1024, 1024, FF, 5632, 1};
        case 2: return PrepJob{p->in[4] + (size_t)l * FF * DM, nullptr, nullptr, (bf16_t*)(ws + OFF_WDN + (l * 2 + 0) * SZ_WDN), FF, FF, DM, DM, 0};
        case 3: return PrepJob{p->in[32] + (size_t)l * FF * DM, nullptr, nullptr, (bf16_t*)(ws + OFF_WDN + (l * 2 + 1) * SZ_WDN), FF, FF, DM, DM, 0};
        case 4: return PrepJob{p->in[6] + (size_t)l * DM * 2016, nullptr, p->in[5] + l * DM, (bf16_t*)(ws + OFF_WIN + l * SZ_WIN), 1024, 1024, 2016, 2048, 2};
        case 5: return PrepJob{p->in[28] + (size_t)l * DM * DM, nullptr, nullptr, (bf16_t*)(ws + OFF_WOUT + l * SZ_WOUT), 1024, 1024, 1024, 1024, 0};
        case 6: return PrepJob{p->in[19] + (size_t)l * 256 * 768, nullptr, p->in[18] + l * 256, (bf16_t*)(ws + OFF_WUQ + l * SZ_WUQ), 256, 256, 768, 768, 3};
        default: return PrepJob{p->in[21] + (size_t)l * 128 * 1024, nullptr, p->in[20] + l * 128, (bf16_t*)(ws + OFF_WUKV + l * SZ_WUKV), 128, 256, 1024, 1024, 0};
    }
}
__device__ __forceinline__ int prep_job_tiles(int j) { const int k = j & 7; return k < 2 ? 352 : k < 4 ? 176 : k == 4 ? 128 : k == 5 ? 64 : k == 6 ? 12 : 16; }
__device__ __forceinline__ void phase_prep(KP p, float* lds) {
    unsigned char* ws = opaque_ptr(p->ws); const int tid = opaque_tid(), wid = tid >> 6, lane = tid & 63;
    { float* tile = lds; constexpr int TOTAL = 2 * (352 * 2 + 176 * 2 + 128 + 64 + 12 + 16);
      float v[32]; bf16_t* dstp = nullptr; int Kd_c = 0, nd0_c = 0, k0_c = 0;
#define PREP_ISSUE(TT) do { int j_ = 0, t_ = (TT); \
          while (t_ >= prep_job_tiles(j_)) { t_ -= prep_job_tiles(j_); ++j_; } \
          const PrepJob J = prep_job(p, ws, j_); \
          const int ntk_ = J.Kd / 256, nd0_ = (t_ / ntk_) * 64, k0_ = (t_ % ntk_) * 256; \
          const int nn_ = tid & 63, kk_ = tid >> 6; int which_; const int ns_ = map_col(J.type, nd0_ + nn_, which_); const float* sp_ = which_ ? J.src2 : J.src; \
          _Pragma("unroll") for (int sub = 0; sub < 4; ++sub) _Pragma("unroll") for (int r = 0; r < 8; ++r) { const int k_ = k0_ + sub * 64 + kk_ + 8 * r; float x_ = 0.f; \
              if (ns_ >= 0 && k_ < J.Ks) { x_ = sp_[(size_t)k_ * J.Nsrc + ns_]; if (J.gain) x_ *= J.gain[k_]; } v[sub * 8 + r] = x_; } \
          dstp = J.dst; Kd_c = J.Kd; nd0_c = nd0_; k0_c = k0_; } while (0)
      int tt = opaque_bid();
      PREP_ISSUE(tt < TOTAL ? tt : TOTAL - 1);
      for (; tt < TOTAL; tt += gridDim.x) {
          { const int nn = tid & 63, kk = tid >> 6;
#pragma unroll
            for (int sub = 0; sub < 4; ++sub)
#pragma unroll
                for (int r = 0; r < 8; ++r) tile[sub * (64 * 65) + nn * 65 + kk + 8 * r] = v[sub * 8 + r]; }
          bf16_t* dcur = dstp; const int Kd = Kd_c, nd0 = nd0_c, k0 = k0_c;
          PREP_ISSUE(tt + (int)gridDim.x < TOTAL ? tt + (int)gridDim.x : TOTAL - 1);
          __syncthreads();
          { const int row = tid >> 3, kc = (tid & 7) * 8;
#pragma unroll
            for (int sub = 0; sub < 4; ++sub) { const float* tp = tile + sub * (64 * 65) + row * 65 + kc;
              u32x4 w; w.x = cvt_pk_bf16(tp[0], tp[1]); w.y = cvt_pk_bf16(tp[2], tp[3]); w.z = cvt_pk_bf16(tp[4], tp[5]); w.w = cvt_pk_bf16(tp[6], tp[7]);
              *(u32x4*)(dcur + (size_t)(nd0 + row) * Kd + k0 + sub * 64 + kc) = w; } }
          __syncthreads();
      } }
    { const float* x = p->in[0]; bf16_t* xb = (bf16_t*)(ws + OFF_XB); float* ssx = (float*)(ws + OFF_SSX);
      for (int rb = (opaque_bid() * 8 + wid) * 4; rb < NTOK; rb += gridDim.x * 32) {
          f32x4 v[4][4];
#pragma unroll
          for (int q = 0; q < 4; ++q)
#pragma unroll
              for (int i = 0; i < 4; ++i) v[q][i] = *(const f32x4*)(x + (size_t)(rb + q) * DM + lane * 16 + 4 * i);
#pragma unroll
          for (int q = 0; q < 4; ++q) { const int row = rb + q; float ss = 0.f;
#pragma unroll
              for (int i = 0; i < 4; ++i) ss += v[q][i][0] * v[q][i][0] + v[q][i][1] * v[q][i][1] + v[q][i][2] * v[q][i][2] + v[q][i][3] * v[q][i][3];
              u32x4 w0, w1; w0.x = cvt_pk_bf16(v[q][0][0], v[q][0][1]); w0.y = cvt_pk_bf16(v[q][0][2], v[q][0][3]); w0.z = cvt_pk_bf16(v[q][1][0], v[q][1][1]); w0.w = cvt_pk_bf16(v[q][1][2], v[q][1][3]);
              w1.x = cvt_pk_bf16(v[q][2][0], v[q][2][1]); w1.y = cvt_pk_bf16(v[q][2][2], v[q][2][3]); w1.z = cvt_pk_bf16(v[q][3][0], v[q][3][1]); w1.w = cvt_pk_bf16(v[q][3][2], v[q][3][3]);
              *(u32x4*)(xb + (size_t)row * DM + lane * 16) = w0; *(u32x4*)(xb + (size_t)row * DM + lane * 16 + 8) = w1;
              ss += __shfl_xor(ss, 1); ss += __shfl_xor(ss, 2);
              if ((lane & 3) == 0) ssx[(size_t)row * 16 + (lane >> 2)] = ss; }
      } }
    { float* rt = (float*)(ws + OFF_ROPE);
      for (int i = opaque_bid() * NTHR + tid; i < 8192 * 32; i += gridDim.x * NTHR) {
          const int pos = i >> 5, sx = i & 31; const float inv = __builtin_amdgcn_exp2f(-(float)sx * (13.287712379549449f / 32.0f));
          float rev = (float)pos * inv * 0.15915494309189535f; rev -= floorf(rev);
          rt[pos * 64 + sx] = cos_rev(rev); rt[pos * 64 + 32 + sx] = sin_rev(rev);
      } }
    { float* h2t = (float*)(ws + OFF_H2T); float* zs = lds; float* h1s = lds + 8 * 40;
      const int pp = tid >> 6, j = tid & 63;
      for (int l = 0; l < 2; ++l) {
          const float* w1 = p->in[9] + l * 33 * 64; const float* w2 = p->in[12] + l * 64 * 64;
          float w1c[33], w2c[64];
#pragma unroll
          for (int i = 0; i < 33; ++i) w1c[i] = w1[i * 64 + j];
#pragma unroll
          for (int i = 0; i < 64; ++i) w2c[i] = w2[i * 64 + j];
          const float b1 = p->in[10][l * 64 + j], f1 = p->in[11][l * 64 + j], b2 = p->in[13][l * 64 + j], f2 = p->in[14][l * 64 + j];
          for (int it = opaque_bid(); it < 1024; it += gridDim.x) {
              const int m0 = it * 8;
              __syncthreads();
              if (j < 33) { const int m = m0 + pp; float z;
                  if (j == 0) z = (float)m * (1.0f / 8191.0f);
                  else { const int bi = (j - 1) & 15; const float band = 1e-4f + (float)bi * ((15.0f - 1e-4f) / 15.0f); float rev = (float)m * band * (1.0f / 8192.0f); rev -= floorf(rev);
                         z = (j <= 16) ? cos_rev(rev) : -sin_rev(rev); }
                  zs[pp * 40 + j] = z; }
              __syncthreads();
              float a = b1;
#pragma unroll
              for (int i = 0; i < 33; ++i) a += zs[pp * 40 + i] * w1c[i];
              h1s[pp * 64 + j] = fast_sin(f1 * a);
              __syncthreads();
              float c = b2;
#pragma unroll
              for (int i = 0; i < 64; ++i) c += h1s[pp * 64 + i] * w2c[i];
              h2t[((size_t)l * 64 + j) * 8192 + m0 + pp] = fast_sin(f2 * c);
          }
      } }
}

namespace att {
constexpr float SCALE = 0.07216878364870322f;
constexpr float THR = 8.f;
constexpr int SHM_V = 64 * 128 * 2, SHM_K = 64 * 128 * 2, SHM_KR = 64 * 64 * 2;
constexpr int OFF_K = 2 * SHM_V, OFF_KR = OFF_K + 2 * SHM_K, OFF_QR = OFF_KR + 2 * SHM_KR, OFF_WS = OFF_QR + 8 * 8192, SHM_TOTAL = OFF_WS + 8 * 64 * 4;
static_assert(SHM_TOTAL <= LDS_BYTES, "attention LDS");
#define KSWZ(row, colB) ((row) * 256 + ((colB) ^ (((row) & 7) << 4)))
#define KRSWZ(row, chunk) ((row) * 128 + ((((chunk) ^ (((row) >> 1) & 7))) << 4))
#define SBAR() __builtin_amdgcn_sched_barrier(0)
__device__ __forceinline__ int crow(int r, int hi) { return (r & 3) + 8 * (r >> 2) + 4 * hi; }
__device__ __forceinline__ void partialSM(f32x16& p0, f32x16& p1, float& m_reg, float& mn, float& alpha) {
    constexpr float C = SCALE * 1.4426950408889634f;
    float pmax = p0[0];
#pragma unroll
    for (int r = 1; r < 16; ++r) pmax = fmaxf(pmax, p0[r]);
#pragma unroll
    for (int r = 0; r < 16; ++r) pmax = fmaxf(pmax, p1[r]);
    { auto rr = __builtin_amdgcn_permlane32_swap(__float_as_uint(pmax), __float_as_uint(pmax), false, false); pmax = fmaxf(__uint_as_float(rr[0]), __uint_as_float(rr[1])); }
    if (__builtin_expect(__all(pmax - m_reg <= THR / SCALE), 1)) { mn = m_reg; alpha = 1.f; }
    else { mn = fmaxf(m_reg, pmax); alpha = __builtin_amdgcn_exp2f((m_reg - mn) * C); m_reg = mn; }
    const float mnC = -mn * C;
#pragma unroll
    for (int r = 0; r < 16; ++r) p0[r] = fmaf(p0[r], C, mnC);
#pragma unroll
    for (int r = 0; r < 16; ++r) p1[r] = fmaf(p1[r], C, mnC);
#pragma unroll
    for (int r = 0; r < 16; ++r) p0[r] = __builtin_amdgcn_exp2f(p0[r]);
}
__device__ __forceinline__ void finishSM(f32x16& p0, f32x16& p1, float alpha, float& l_reg, bf16x8& pa0, bf16x8& pa1, bf16x8& pa2, bf16x8& pa3) {
#pragma unroll
    for (int r = 0; r < 16; ++r) p1[r] = __builtin_amdgcn_exp2f(p1[r]);
    float ps = 0;
#pragma unroll
    for (int r = 0; r < 16; ++r) ps += p0[r];
#pragma unroll
    for (int r = 0; r < 16; ++r) ps += p1[r];
    { auto rr = __builtin_amdgcn_permlane32_swap(__float_as_uint(ps), __float_as_uint(ps), false, false); ps = __uint_as_float(rr[0]) + __uint_as_float(rr[1]); }
    l_reg = l_reg * alpha + ps;
#define PK4(P, BASE, OUT) do { unsigned a0 = cvt_pk_bf16(P[BASE + 0], P[BASE + 1]), a1 = cvt_pk_bf16(P[BASE + 2], P[BASE + 3]);   \
    unsigned b0 = cvt_pk_bf16(P[BASE + 4], P[BASE + 5]), b1 = cvt_pk_bf16(P[BASE + 6], P[BASE + 7]);                              \
    auto r0 = __builtin_amdgcn_permlane32_swap(a0, b0, false, false); auto r1 = __builtin_amdgcn_permlane32_swap(a1, b1, false, false); \
    u32x4 w = {r0[0], r1[0], r0[1], r1[1]}; OUT = *reinterpret_cast<bf16x8*>(&w); } while (0)
    PK4(p0, 0, pa0); PK4(p0, 8, pa1); PK4(p1, 0, pa2); PK4(p1, 8, pa3);
#undef PK4
}
__device__ __forceinline__ void qkt(f32x16& p0, f32x16& p1, const char* Ks, const char* Krs, const bf16x8* qr, const char* qrl, int r32, int hi) {
    p0 = f32x16{}; p1 = f32x16{};
#pragma unroll
    for (int d0 = 0; d0 < 8; ++d0) { const int cb = (d0 * 16 + hi * 8) * 2;
        const bf16x8 b0 = *reinterpret_cast<const bf16x8*>(Ks + KSWZ(r32, cb));
        const bf16x8 b1 = *reinterpret_cast<const bf16x8*>(Ks + KSWZ(32 + r32, cb));
        const bf16x8 q = d0 < 4 ? qr[d0 & 3] : *reinterpret_cast<const bf16x8*>(qrl + d0 * 1024);
        p0 = __builtin_amdgcn_mfma_f32_32x32x16_bf16(b0, q, p0, 0, 0, 0);
        p1 = __builtin_amdgcn_mfma_f32_32x32x16_bf16(b1, q, p1, 0, 0, 0); }
#pragma unroll
    for (int d0 = 0; d0 < 4; ++d0) { const int ch = d0 * 2 + hi;
        const bf16x8 b0 = *reinterpret_cast<const bf16x8*>(Krs + KRSWZ(r32, ch));
        const bf16x8 b1 = *reinterpret_cast<const bf16x8*>(Krs + KRSWZ(32 + r32, ch));
        const bf16x8 q = *reinterpret_cast<const bf16x8*>(qrl + d0 * 1024);
        p0 = __builtin_amdgcn_mfma_f32_32x32x16_bf16(b0, q, p0, 0, 0, 0);
        p1 = __builtin_amdgcn_mfma_f32_32x32x16_bf16(b1, q, p1, 0, 0, 0); }
}
__device__ __forceinline__ int v_st(int k, int c) { const int kk = (k & ~0xC) | ((k & 4) << 1) | ((k & 8) >> 1); return ((kk >> 3) * 4 + (c >> 5)) * 512 + ((kk & 7) * 32 + (c & 31)) * 2; }
__device__ __forceinline__ int v_rd_base(int lane) { return ((lane & 3) << 3) | (((lane >> 2) & 3) << 6) | (((lane >> 4) & 1) << 5) | (((lane >> 5) & 1) << 8); }
constexpr int v_rd_off(int d0, int ks, int half) { return d0 * 512 + ks * 4096 + half * 2048; }
template <int OFF> __device__ __forceinline__ s16x4 tr_read(int vb) { s16x4 r; asm volatile("ds_read_b64_tr_b16 %0, %1 offset:%2" : "=&v"(r) : "v"(vb), "i"(OFF) : "memory"); return r; }
template <int D0> __device__ __forceinline__ void pv_one(f32x16& od, int vb, bf16x8 pa0, bf16x8 pa1, bf16x8 pa2, bf16x8 pa3) {
    const s16x4 l0 = tr_read<v_rd_off(D0, 0, 0)>(vb), h0 = tr_read<v_rd_off(D0, 0, 1)>(vb), l1 = tr_read<v_rd_off(D0, 1, 0)>(vb), h1 = tr_read<v_rd_off(D0, 1, 1)>(vb);
    const s16x4 l2 = tr_read<v_rd_off(D0, 2, 0)>(vb), h2 = tr_read<v_rd_off(D0, 2, 1)>(vb), l3 = tr_read<v_rd_off(D0, 3, 0)>(vb), h3 = tr_read<v_rd_off(D0, 3, 1)>(vb);
    asm volatile("s_waitcnt lgkmcnt(0)" ::: "memory"); SBAR();
#define PK(L, H) (bf16x8){L[0], L[1], L[2], L[3], H[0], H[1], H[2], H[3]}
    od = __builtin_amdgcn_mfma_f32_32x32x16_bf16(pa0, PK(l0, h0), od, 0, 0, 0);
    od = __builtin_amdgcn_mfma_f32_32x32x16_bf16(pa1, PK(l1, h1), od, 0, 0, 0);
    od = __builtin_amdgcn_mfma_f32_32x32x16_bf16(pa2, PK(l2, h2), od, 0, 0, 0);
    od = __builtin_amdgcn_mfma_f32_32x32x16_bf16(pa3, PK(l3, h3), od, 0, 0, 0);
#undef PK
}
__device__ __forceinline__ void pv_d0(f32x16* o, int vb, bf16x8 pa0, bf16x8 pa1, bf16x8 pa2, bf16x8 pa3) {
    pv_one<0>(o[0], vb, pa0, pa1, pa2, pa3); pv_one<1>(o[1], vb, pa0, pa1, pa2, pa3); pv_one<2>(o[2], vb, pa0, pa1, pa2, pa3); pv_one<3>(o[3], vb, pa0, pa1, pa2, pa3);
}
__device__ __forceinline__ void attn_body(const bf16_t* __restrict__ Qb, const bf16_t* __restrict__ QRb, const bf16_t* __restrict__ Kh, const bf16_t* __restrict__ Krh,
                                          const bf16_t* __restrict__ Vh, bf16_t* __restrict__ Ob, int seq, char* lds) {
    const int tid = opaque_tid(), wid = tid >> 6, lane = tid & 63, r32 = lane & 31, hi = lane >> 5;
    char* V_lds = lds; char* K_lds = lds + OFF_K; char* Kr_lds = lds + OFF_KR; char* qrl = lds + OFF_QR + wid * 8192 + lane * 16;
    float* wsf = (float*)(lds + OFF_WS) + wid * 64; float* li_l = wsf; float* al_l = wsf + 32;
    float m_reg = -1e30f, l_reg = 0; f32x16 o[4] = {}; bf16x8 qr[4];
    __syncthreads();
    { const bf16_t* Qw = Qb + (long)(wid * 32 + r32) * 128 + hi * 8;
#pragma unroll
      for (int d0 = 0; d0 < 4; ++d0) qr[d0] = *reinterpret_cast<const bf16x8*>(Qw + d0 * 16);
#pragma unroll
      for (int d0 = 4; d0 < 8; ++d0) *reinterpret_cast<bf16x8*>(qrl + d0 * 1024) = *reinterpret_cast<const bf16x8*>(Qw + d0 * 16);
      const bf16_t* QRw = QRb + (long)(wid * 32 + r32) * 64 + hi * 8;
#pragma unroll
      for (int d0 = 0; d0 < 4; ++d0) *reinterpret_cast<bf16x8*>(qrl + d0 * 1024) = *reinterpret_cast<const bf16x8*>(QRw + d0 * 16); }
    const int sr = tid >> 4, sc = (tid & 15) * 8, vst0 = v_st(sr, sc), vst1 = v_st(32 + sr, sc);
    const int krr = tid >> 3, krc = tid & 7, krst = KRSWZ(krr, krc);
    const int vb0 = (int)(uintptr_t)V_lds + v_rd_base(lane);
    struct { bf16x8 vs0, vs1, ks0, ks1, kr; } sr_[1];
#define SLOAD(i, k0) do { sr_[i].vs0 = *reinterpret_cast<const bf16x8*>(&Vh[(long)((k0) + sr) * 128 + sc]); sr_[i].vs1 = *reinterpret_cast<const bf16x8*>(&Vh[(long)((k0) + 32 + sr) * 128 + sc]); \
    sr_[i].ks0 = *reinterpret_cast<const bf16x8*>(&Kh[(long)((k0) + sr) * 128 + sc]); sr_[i].ks1 = *reinterpret_cast<const bf16x8*>(&Kh[(long)((k0) + 32 + sr) * 128 + sc]); \
    sr_[i].kr = *reinterpret_cast<const bf16x8*>(&Krh[(long)((k0) + krr) * 64 + krc * 8]); } while (0)
#define SWRITE(b, i) do { *(bf16x8*)(V_lds + (b) * SHM_V + vst0) = sr_[i].vs0; *(bf16x8*)(V_lds + (b) * SHM_V + vst1) = sr_[i].vs1; const int kc = sc * 2; \
    *(bf16x8*)(K_lds + (b) * SHM_K + KSWZ(sr, kc)) = sr_[i].ks0; *(bf16x8*)(K_lds + (b) * SHM_K + KSWZ(32 + sr, kc)) = sr_[i].ks1; \
    *(bf16x8*)(Kr_lds + (b) * SHM_KR + krst) = sr_[i].kr; } while (0)
#define SWAIT() asm volatile("s_waitcnt vmcnt(0)" ::: "memory")
#define RESC(a) do { if (__any((a) < 1.f)) { if (hi == 0) al_l[r32] = (a); asm volatile("s_waitcnt lgkmcnt(0)" ::: "memory"); \
    _Pragma("unroll") for (int d = 0; d < 4; ++d) _Pragma("unroll") for (int r = 0; r < 16; ++r) o[d][r] *= al_l[crow(r, hi)]; } } while (0)
    f32x16 pA0, pA1, pB0, pB1; float mnA, mnB, alA, alB; bf16x8 pa0, pa1, pa2, pa3; const int NT = seq / 64;
    constexpr int SE = 0, SO = 0;
    SLOAD(SE, 0); asm volatile("s_waitcnt vmcnt(0)" ::: "memory"); SWRITE(0, SE); __syncthreads();
    qkt(pA0, pA1, K_lds, Kr_lds, qr, qrl, r32, hi); partialSM(pA0, pA1, m_reg, mnA, alA);
    SLOAD(SO, 64);
    SWAIT(); SWRITE(1, SO); __syncthreads();
    for (int j = 1; j + 1 < NT; j += 2) {
        SBAR(); qkt(pB0, pB1, K_lds + SHM_K, Kr_lds + SHM_KR, qr, qrl, r32, hi);
        finishSM(pA0, pA1, alA, l_reg, pa0, pa1, pa2, pa3); SBAR();
        SLOAD(SO, (j + 1) * 64); SBAR();
        pv_d0(o, vb0, pa0, pa1, pa2, pa3); partialSM(pB0, pB1, m_reg, mnB, alB);
        __syncthreads(); SWAIT(); SWRITE(0, SE);
        RESC(alB); __syncthreads();
        SBAR(); qkt(pA0, pA1, K_lds, Kr_lds, qr, qrl, r32, hi);
        finishSM(pB0, pB1, alB, l_reg, pa0, pa1, pa2, pa3); SBAR();
        SLOAD(SE, (j + 2) * 64); SBAR();
        pv_d0(o, vb0 + SHM_V, pa0, pa1, pa2, pa3); partialSM(pA0, pA1, m_reg, mnA, alA);
        __syncthreads(); SWAIT(); SWRITE(1, SO);
        RESC(alA); __syncthreads();
    }
    SBAR(); qkt(pB0, pB1, K_lds + SHM_K, Kr_lds + SHM_KR, qr, qrl, r32, hi);
    finishSM(pA0, pA1, alA, l_reg, pa0, pa1, pa2, pa3); SBAR();
    pv_d0(o, vb0, pa0, pa1, pa2, pa3); partialSM(pB0, pB1, m_reg, mnB, alB);
    __syncthreads(); RESC(alB);
    finishSM(pB0, pB1, alB, l_reg, pa0, pa1, pa2, pa3); SBAR();
    pv_d0(o, vb0 + SHM_V, pa0, pa1, pa2, pa3);
    if (hi == 0) li_l[r32] = l_reg; asm volatile("s_waitcnt lgkmcnt(0)" ::: "memory");
    float rli[16];
#pragma unroll
    for (int r = 0; r < 16; ++r) rli[r] = __builtin_amdgcn_rcpf(li_l[crow(r, hi)]);
    bf16_t* Ow = Ob + (long)(wid * 32) * 512;
#pragma unroll
    for (int r = 0; r < 16; ++r) { const int orow = crow(r, hi);
#pragma unroll
        for (int d0 = 0; d0 < 4; ++d0) Ow[(long)orow * 512 + d0 * 32 + r32] = f2bf(o[d0][r] * rli[r]); }
#undef SLOAD
#undef SWRITE
#undef SWAIT
#undef RESC
}
}

__device__ __forceinline__ float2 cmul(float2 a, float2 b) { return make_float2(a.x * b.x - a.y * b.y, a.x * b.y + a.y * b.x); }
template <bool LAST = true, bool FIRST = true> __device__ __forceinline__ void fft_dif(float2* d) {
    const int tid = opaque_tid();
    for (int s = FIRST ? 0 : 1; s < 6; ++s) {
        const int lg = 12 - 2 * s, span = 1 << lg; const float rs = 1.0f / (float)(4 << lg);
#pragma unroll 4
        for (int i = 0; i < 8; ++i) {
            const int bf = tid + 512 * i, j = bf & (span - 1), g = bf >> lg, base = ((g << 2) << lg) + j;
            const float2 a0 = d[base], a1 = d[base + span], a2 = d[base + 2 * span], a3 = d[base + 3 * span];
            const float2 b0 = make_float2(a0.x + a2.x, a0.y + a2.y), b1 = make_float2(a0.x - a2.x, a0.y - a2.y), b2 = make_float2(a1.x + a3.x, a1.y + a3.y), b3 = make_float2(a1.x - a3.x, a1.y - a3.y);
            const float2 y0 = make_float2(b0.x + b2.x, b0.y + b2.y), y2 = make_float2(b0.x - b2.x, b0.y - b2.y);
            const float2 y1 = make_float2(b1.x + b3.y, b1.y - b3.x), y3 = make_float2(b1.x - b3.y, b1.y + b3.x);
            const float r = (float)j * rs;
            const float2 w1 = make_float2(cos_rev(r), -sin_rev(r)), w2 = make_float2(cos_rev(2.f * r), -sin_rev(2.f * r)), w3 = make_float2(cos_rev(3.f * r), -sin_rev(3.f * r));
            d[base] = y0; d[base + span] = cmul(y1, w1); d[base + 2 * span] = cmul(y2, w2); d[base + 3 * span] = cmul(y3, w3);
        }
        __syncthreads();
    }
    if (!LAST) return;
#pragma unroll 4
    for (int i = 0; i < 8; ++i) {
        f32x4* q = (f32x4*)(d + 4 * (tid + 512 * i));
        const f32x4 A = q[0], B = q[1];
        const float b0x = A[0] + B[0], b0y = A[1] + B[1], b1x = A[0] - B[0], b1y = A[1] - B[1], b2x = A[2] + B[2], b2y = A[3] + B[3], b3x = A[2] - B[2], b3y = A[3] - B[3];
        q[0] = (f32x4){b0x + b2x, b0y + b2y, b1x + b3y, b1y - b3x};
        q[1] = (f32x4){b0x - b2x, b0y - b2y, b1x - b3y, b1y + b3x};
    }
    __syncthreads();
}
template <bool FIRST = true, bool LASTS = true> __device__ __forceinline__ void fft_dit_inv(float2* d) {
    const int tid = opaque_tid();
    if (FIRST) {
#pragma unroll 4
    for (int i = 0; i < 8; ++i) {
        f32x4* q = (f32x4*)(d + 4 * (tid + 512 * i));
        const f32x4 A = q[0], B = q[1];
        const float c0x = A[0] + B[0], c0y = A[1] + B[1], c1x = A[0] - B[0], c1y = A[1] - B[1], c2x = A[2] + B[2], c2y = A[3] + B[3], c3x = A[2] - B[2], c3y = A[3] - B[3];
        q[0] = (f32x4){c0x + c2x, c0y + c2y, c1x - c3y, c1y + c3x};
        q[1] = (f32x4){c0x - c2x, c0y - c2y, c1x + c3y, c1y - c3x};
    }
    __syncthreads();
    }
    for (int s = 5; s >= (LASTS ? 0 : 1); --s) {
        const int lg = 12 - 2 * s, span = 1 << lg; const float rs = 1.0f / (float)(4 << lg);
#pragma unroll 4
        for (int i = 0; i < 8; ++i) {
            const int bf = tid + 512 * i, j = bf & (span - 1), g = bf >> lg, base = ((g << 2) << lg) + j;
            const float r = (float)j * rs;
            const float2 w1 = make_float2(cos_rev(r), sin_rev(r)), w2 = make_float2(cos_rev(2.f * r), sin_rev(2.f * r)), w3 = make_float2(cos_rev(3.f * r), sin_rev(3.f * r));
            const float2 y0 = d[base], y1 = cmul(d[base + span], w1), y2 = cmul(d[base + 2 * span], w2), y3 = cmul(d[base + 3 * span], w3);
            const float2 c0 = make_float2(y0.x + y2.x, y0.y + y2.y), c1 = make_float2(y0.x - y2.x, y0.y - y2.y), c2 = make_float2(y1.x + y3.x, y1.y + y3.y), c3 = make_float2(y1.x - y3.x, y1.y - y3.y);
            d[base] = make_float2(c0.x + c2.x, c0.y + c2.y); d[base + 2 * span] = make_float2(c0.x - c2.x, c0.y - c2.y);
            d[base + span] = make_float2(c1.x - c3.y, c1.y + c3.x); d[base + 3 * span] = make_float2(c1.x + c3.y, c1.y - c3.x);
        }
        __syncthreads();
    }
}
__device__ __forceinline__ float sconv(const bf16_t* p, int t, float w0, float w1, float w2, float bias) {
    const float a = t > 0 ? bf2f(p[t - 1]) : 0.f, b = bf2f(p[t]), c = t < SEQ - 1 ? bf2f(p[t + 1]) : 0.f;
    return bias + w0 * a + w1 * b + w2 * c;
}
__device__ __forceinline__ float2 sconv2(const bf16_t* p, int m, float w0, float w1, float w2, float bias) {
    const unsigned* pw = (const unsigned*)p;
    const unsigned wm = m > 0 ? pw[m - 1] : 0u, wc = pw[m], wp = m < SEQ / 2 - 1 ? pw[m + 1] : 0u;
    const float a = bfhi(wm), b = bflo(wc), c = bfhi(wc), d = bflo(wp);
    return make_float2(bias + w0 * a + w1 * b + w2 * c, bias + w0 * b + w1 * c + w2 * d);
}
__device__ __forceinline__ int rev4_14(int x) { const unsigned b = __brev((unsigned)x) >> 18; return (int)(((b & 0x1555u) << 1) | ((b >> 1) & 0x1555u)); }
__device__ __forceinline__ void hyena_filter(KP p, int l, int c, float2* data, float2* Kd, float delta) {
    const int tid = opaque_tid(); unsigned char* ws = opaque_ptr(p->ws);
    const float* h2t = (const float*)(ws + OFF_H2T) + (size_t)l * 64 * 8192; const float* w3 = p->in[15] + (size_t)l * 64 * 1024;
    const int m0 = tid * 16;
    f32x4 af0[4], ab0[4], af1[4], ab1[4];
#pragma unroll
    for (int q = 0; q < 4; ++q) { af0[q] = (f32x4){0.f, 0.f, 0.f, 0.f}; ab0[q] = af0[q]; af1[q] = af0[q]; ab1[q] = af0[q]; }
#pragma unroll 2
    for (int j = 0; j < 64; ++j) {
        const float wf0 = w3[j * 1024 + c], wb0 = w3[j * 1024 + 256 + c], wf1 = w3[j * 1024 + 512 + c], wb1 = w3[j * 1024 + 768 + c];
        const f32x4* hp = (const f32x4*)(h2t + j * 8192 + m0);
#pragma unroll
        for (int q = 0; q < 4; ++q) { const f32x4 h = hp[q]; af0[q] += h * wf0; ab0[q] += h * wb0; af1[q] += h * wf1; ab1[q] += h * wb1; }
    }
#pragma unroll
    for (int q = 0; q < 4; ++q)
#pragma unroll
        for (int k = 0; k < 4; ++k) {
            const int m = m0 + q * 4 + k; const float win = __expf(-((float)m * (1.0f / 8191.0f)) * delta);
            data[m] = make_float2(af0[q][k] * win, af1[q][k] * win);
            if (m >= 1) data[16384 - m] = make_float2(ab0[q][k] * win, ab1[q][k] * win);
        }
    if (tid == 0) data[8192] = make_float2(0.f, 0.f);
    __syncthreads();
    fft_dif(data);
#pragma unroll 8
    for (int i = 0; i < 32; ++i) { const int q = tid + 512 * i; const float2 v = data[q]; Kd[q] = make_float2(v.x * (1.0f / 16384.0f), v.y * (1.0f / 16384.0f)); }
    __syncthreads();
}
template <int O> __device__ __forceinline__ void hyena_mid(float2* d, const float2* Z) {
    const int tid = opaque_tid();
#pragma unroll 4
    for (int i = 0; i < 8; ++i) {
        const int q0 = 4 * (tid + 512 * i);
        f32x4* qp = (f32x4*)(d + q0);
        const f32x4 A = qp[0], B = qp[1];
        const f32x4 ZA = *(const f32x4*)(Z + q0), ZB = *(const f32x4*)(Z + q0 + 2);
        float2 z2[4];
#pragma unroll
        for (int e = 0; e < 4; ++e) { const int f = rev4_14(q0 + e); z2[e] = Z[rev4_14((16384 - f) & 16383)]; }
        const float b0x = A[0] + B[0], b0y = A[1] + B[1], b1x = A[0] - B[0], b1y = A[1] - B[1], b2x = A[2] + B[2], b2y = A[3] + B[3], b3x = A[2] - B[2], b3y = A[3] - B[3];
        float2 y[4] = {make_float2(b0x + b2x, b0y + b2y), make_float2(b1x + b3y, b1y - b3x), make_float2(b0x - b2x, b0y - b2y), make_float2(b1x - b3y, b1y + b3x)};
        const float2 z[4] = {make_float2(ZA[0], ZA[1]), make_float2(ZA[2], ZA[3]), make_float2(ZB[0], ZB[1]), make_float2(ZB[2], ZB[3])};
#pragma unroll
        for (int e = 0; e < 4; ++e) {
            const float2 k = O == 0 ? make_float2(0.5f * (z[e].x + z2[e].x), 0.5f * (z[e].y - z2[e].y)) : make_float2(0.5f * (z[e].y + z2[e].y), -0.5f * (z[e].x - z2[e].x));
            y[e] = cmul(y[e], k);
        }
        const float c0x = y[0].x + y[2].x, c0y = y[0].y + y[2].y, c1x = y[0].x - y[2].x, c1y = y[0].y - y[2].y, c2x = y[1].x + y[3].x, c2y = y[1].y + y[3].y, c3x = y[1].x - y[3].x, c3y = y[1].y - y[3].y;
        qp[0] = (f32x4){c0x + c2x, c0y + c2y, c1x - c3y, c1y + c3x};
        qp[1] = (f32x4){c0x - c2x, c0y - c2y, c1x + c3y, c1y - c3x};
    }
    __syncthreads();
}
template <int O> __device__ __forceinline__ void hyena_mul(float2* data, const float2* Z) {
    const int tid = opaque_tid();
#pragma unroll 8
    for (int i = 0; i < 32; ++i) {
        const int q = tid + 512 * i, f = rev4_14(q), q2 = rev4_14((16384 - f) & 16383);
        const float2 z = Z[q], z2 = Z[q2];
        const float2 k = O == 0 ? make_float2(0.5f * (z.x + z2.x), 0.5f * (z.y - z2.y)) : make_float2(0.5f * (z.y + z2.y), -0.5f * (z.x - z2.x));
        data[q] = cmul(data[q], k);
    }
    __syncthreads();
}
__device__ __forceinline__ void dif0_pair(float2* d, int j, f32x4 in0, f32x4 in1) {
    f32x4 o0, o1, o2, o3;
#pragma unroll
    for (int e = 0; e < 2; ++e) {
        const float2 a0 = make_float2(in0[2 * e], in0[2 * e + 1]), a1 = make_float2(in1[2 * e], in1[2 * e + 1]);
        const float r = (float)(j + e) * (1.0f / 16384.0f);
        const float2 w1 = make_float2(cos_rev(r), -sin_rev(r)), w2 = make_float2(cos_rev(2.f * r), -sin_rev(2.f * r)), w3 = make_float2(cos_rev(3.f * r), -sin_rev(3.f * r));
        const float2 y0 = make_float2(a0.x + a1.x, a0.y + a1.y), y2 = cmul(make_float2(a0.x - a1.x, a0.y - a1.y), w2);
        const float2 y1 = cmul(make_float2(a0.x + a1.y, a0.y - a1.x), w1), y3 = cmul(make_float2(a0.x - a1.y, a0.y + a1.x), w3);
        o0[2 * e] = y0.x; o0[2 * e + 1] = y0.y; o1[2 * e] = y1.x; o1[2 * e + 1] = y1.y; o2[2 * e] = y2.x; o2[2 * e + 1] = y2.y; o3[2 * e] = y3.x; o3[2 * e + 1] = y3.y;
    }
    *(f32x4*)(d + j) = o0; *(f32x4*)(d + j + 4096) = o1; *(f32x4*)(d + j + 8192) = o2; *(f32x4*)(d + j + 12288) = o3;
}
__device__ __forceinline__ void dit0_pair(const float2* d, int j, f32x4& out0, f32x4& out1) {
    const f32x4 i0 = *(const f32x4*)(d + j), i1 = *(const f32x4*)(d + j + 4096), i2 = *(const f32x4*)(d + j + 8192), i3 = *(const f32x4*)(d + j + 12288);
#pragma unroll
    for (int e = 0; e < 2; ++e) {
        const float r = (float)(j + e) * (1.0f / 16384.0f);
        const float2 w1 = make_float2(cos_rev(r), sin_rev(r)), w2 = make_float2(cos_rev(2.f * r), sin_rev(2.f * r)), w3 = make_float2(cos_rev(3.f * r), sin_rev(3.f * r));
        const float2 y0 = make_float2(i0[2 * e], i0[2 * e + 1]), y1 = cmul(make_float2(i1[2 * e], i1[2 * e + 1]), w1), y2 = cmul(make_float2(i2[2 * e], i2[2 * e + 1]), w2), y3 = cmul(make_float2(i3[2 * e], i3[2 * e + 1]), w3);
        const float2 c0 = make_float2(y0.x + y2.x, y0.y + y2.y), c1 = make_float2(y0.x - y2.x, y0.y - y2.y), c2 = make_float2(y1.x + y3.x, y1.y + y3.y), c3 = make_float2(y1.x - y3.x, y1.y - y3.y);
        out0[2 * e] = c0.x + c2.x; out0[2 * e + 1] = c0.y + c2.y; out1[2 * e] = c1.x - c3.y; out1[2 * e + 1] = c1.y + c3.x;
    }
}
__device__ __forceinline__ void hyena_item(KP p, int l, int c, float2* data, bool do_store) {
    const int tid = opaque_tid(); unsigned char* ws = opaque_ptr(p->ws);
    bf16_t* hv = (bf16_t*)(ws + T_HYT) + (size_t)c * NTOK; const bf16_t* hx1 = (const bf16_t*)(ws + T_HYT) + (size_t)(256 + c) * NTOK; const bf16_t* hx2 = (const bf16_t*)(ws + T_HYT) + (size_t)(512 + c) * NTOK;
    float2* RA = (float2*)(ws + T_FK) + (size_t)c * 2 * 16384; float2* RB = RA + 16384;
    const float* cw = p->in[7] + l * 3 * 768; const float* cb = p->in[8] + l * 768;
    const float wv0 = cw[c], wv1 = cw[768 + c], wv2 = cw[1536 + c], bv = cb[c];
    const float wa0 = cw[256 + c], wa1 = cw[768 + 256 + c], wa2 = cw[1536 + 256 + c], ba = cb[256 + c];
    const float wb0 = cw[512 + c], wb1 = cw[768 + 512 + c], wb2 = cw[1536 + 512 + c], bb = cb[512 + c];
    const float skip0 = p->in[16][l * 512 + c], skip1 = p->in[16][l * 512 + 256 + c];
    const float mind = -3.0701134573253945f, maxd = -15.350567286626973f;
    const float delta = fabsf(mind + (float)c * ((maxd - mind) / 255.0f));
    __syncthreads();
    hyena_filter(p, l, c, data, RA, delta);
#pragma unroll 1
    for (int pr = 0; pr < 2; ++pr) {
        const int o0 = (2 * pr) * SEQ, o1 = (2 * pr + 1) * SEQ;
        { const int tq = opaque_tid();
#pragma unroll
          for (int i = 0; i < 4; ++i) { const int m = tq + 512 * i;
              const float2 a0 = sconv2(hv + o0, m, wv0, wv1, wv2, bv), a1 = sconv2(hv + o1, m, wv0, wv1, wv2, bv);
              const float2 b0 = sconv2(hv + o0, m + 2048, wv0, wv1, wv2, bv), b1 = sconv2(hv + o1, m + 2048, wv0, wv1, wv2, bv);
              dif0_pair(data, 2 * m, (f32x4){a0.x, a1.x, a0.y, a1.y}, (f32x4){b0.x, b1.x, b0.y, b1.y}); } }
        __syncthreads();
        fft_dif<false, false>(data);
        hyena_mid<0>(data, RA);
        fft_dit_inv<false, false>(data);
        { const int tq = opaque_tid();
#pragma unroll
          for (int i = 0; i < 4; ++i) { const int m = tq + 512 * i; f32x4 cva, cvb; dit0_pair(data, 2 * m, cva, cvb);
              { const float2 v0 = sconv2(hv + o0, m, wv0, wv1, wv2, bv), v1 = sconv2(hv + o1, m, wv0, wv1, wv2, bv);
                const float2 x0 = sconv2(hx1 + o0, m, wa0, wa1, wa2, ba), x1 = sconv2(hx1 + o1, m, wa0, wa1, wa2, ba);
                *(f32x4*)(RB + pr * 8192 + 2 * m) = (f32x4){x0.x * (cva[0] + skip0 * v0.x), x1.x * (cva[1] + skip0 * v1.x), x0.y * (cva[2] + skip0 * v0.y), x1.y * (cva[3] + skip0 * v1.y)}; }
              { const int mb = m + 2048;
                const float2 v0 = sconv2(hv + o0, mb, wv0, wv1, wv2, bv), v1 = sconv2(hv + o1, mb, wv0, wv1, wv2, bv);
                const float2 x0 = sconv2(hx1 + o0, mb, wa0, wa1, wa2, ba), x1 = sconv2(hx1 + o1, mb, wa0, wa1, wa2, ba);
                *(f32x4*)(RB + pr * 8192 + 2 * mb) = (f32x4){x0.x * (cvb[0] + skip0 * v0.x), x1.x * (cvb[1] + skip0 * v1.x), x0.y * (cvb[2] + skip0 * v0.y), x1.y * (cvb[3] + skip0 * v1.y)}; } } }
        __syncthreads();
    }
#pragma unroll 1
    for (int pr = 0; pr < 2; ++pr) {
        const int o0 = (2 * pr) * SEQ, o1 = (2 * pr + 1) * SEQ;
        { const int tq = opaque_tid();
#pragma unroll
          for (int i = 0; i < 4; ++i) { const int m = tq + 512 * i;
              dif0_pair(data, 2 * m, *(const f32x4*)(RB + pr * 8192 + 2 * m), *(const f32x4*)(RB + pr * 8192 + 2 * m + 4096)); } }
        __syncthreads();
        fft_dif<false, false>(data);
        hyena_mid<1>(data, RA);
        fft_dit_inv<false, false>(data);
        { const int tq = opaque_tid();
#pragma unroll
          for (int i = 0; i < 4; ++i) { const int m = tq + 512 * i; f32x4 cva, cvb; dit0_pair(data, 2 * m, cva, cvb);
              { const f32x4 y1 = *(const f32x4*)(RB + pr * 8192 + 2 * m);
                const float2 x0 = sconv2(hx2 + o0, m, wb0, wb1, wb2, bb), x1 = sconv2(hx2 + o1, m, wb0, wb1, wb2, bb);
                if (do_store) { *(unsigned*)(hv + o0 + 2 * m) = cvt_pk_bf16(x0.x * (cva[0] + skip1 * y1[0]), x0.y * (cva[2] + skip1 * y1[2]));
                                *(unsigned*)(hv + o1 + 2 * m) = cvt_pk_bf16(x1.x * (cva[1] + skip1 * y1[1]), x1.y * (cva[3] + skip1 * y1[3])); } }
              { const int mb = m + 2048; const f32x4 y1 = *(const f32x4*)(RB + pr * 8192 + 2 * mb);
                const float2 x0 = sconv2(hx2 + o0, mb, wb0, wb1, wb2, bb), x1 = sconv2(hx2 + o1, mb, wb0, wb1, wb2, bb);
                if (do_store) { *(unsigned*)(hv + o0 + 2 * mb) = cvt_pk_bf16(x0.x * (cvb[0] + skip1 * y1[0]), x0.y * (cvb[2] + skip1 * y1[2]));
                                *(unsigned*)(hv + o1 + 2 * mb) = cvt_pk_bf16(x1.x * (cvb[1] + skip1 * y1[1]), x1.y * (cvb[3] + skip1 * y1[3])); } } } }
        __syncthreads();
    }
}

constexpr int G_QF = 0, G_QB = G_QF + 64 * 33, G_KF = G_QB + 64 * 33, G_KB = G_KF + 32 * 68, G_V = G_KB + 32 * 68, G_A = G_V + 64 * 68, G_S = G_A + 64 * 68, G_T = G_S + 32 * 68,
              G_GF = G_T + 32 * 68, G_GB = G_GF + 64 * 33, G_O = G_GB + 64 * 33, G_O1 = G_O + 64 * 68, G_END = G_O1 + 64 * 68;
static_assert(G_END * 4 <= LDS_BYTES, "gla lds");
template <int CTRL, int ROW_MASK> __device__ __forceinline__ float dpp_add(float v) {
    const int s = __builtin_amdgcn_update_dpp(0, __float_as_int(v), CTRL, ROW_MASK, 0xf, true);
    return v + __int_as_float(s);
}
__device__ __forceinline__ float wave_incl_scan(float v) {
    v = dpp_add<0x111, 0xf>(v); v = dpp_add<0x112, 0xf>(v); v = dpp_add<0x114, 0xf>(v); v = dpp_add<0x118, 0xf>(v);
    v = dpp_add<0x142, 0xa>(v); v = dpp_add<0x143, 0xc>(v);
    return v;
}
struct GlaLoads { f32x4 gx[8]; u32x4 vw; u32x2 qw, kw; };
__device__ __forceinline__ GlaLoads gla_issue(KP p, int it) {
    const int tid = opaque_tid(), wid = __builtin_amdgcn_readfirstlane(tid >> 6), lane = tid & 63; unsigned char* ws = opaque_ptr(p->ws);
    const int h = it & 3, n = (it >> 2) & 127, b = it >> 9, row0 = b * SEQ + n * 64;
    const bf16_t* gin = (const bf16_t*)(ws + T_GIN); const float* gg = (const float*)(ws + T_GG);
    GlaLoads g;
    { const f32x4* gr = (const f32x4*)(gg + (size_t)(row0 + lane) * 32);
#pragma unroll
      for (int q = 0; q < 8; ++q) g.gx[q] = gr[q]; }
    g.vw = *(const u32x4*)(gin + (size_t)(row0 + (tid >> 3)) * 832 + 256 + h * 64 + (tid & 7) * 8);
    g.qw = *(const u32x2*)(gin + (size_t)(row0 + lane) * 832 + h * 32 + 4 * wid); g.kw = *(const u32x2*)(gin + (size_t)(row0 + lane) * 832 + 128 + h * 32 + 4 * wid);
    return g;
}
__device__ __forceinline__ void gla_prepare(KP p, int l, int h, const GlaLoads& g, float* L) {
    const int tid = opaque_tid(), wid = __builtin_amdgcn_readfirstlane(tid >> 6), lane = tid & 63;
    const float* wf = p->in[23] + l * 16 * 128 + h * 32 + 4 * wid; const float* wb = p->in[25] + l * 16 * 128 + h * 32 + 4 * wid;
    f32x4 af = *(const f32x4*)(p->in[24] + l * 128 + h * 32 + 4 * wid), ab = *(const f32x4*)(p->in[26] + l * 128 + h * 32 + 4 * wid);
#pragma unroll
    for (int r = 0; r < 16; ++r) { const float xf = g.gx[r >> 2][r & 3], xb = g.gx[4 + (r >> 2)][r & 3];
        af += *(const f32x4*)(wf + r * 128) * xf; ab += *(const f32x4*)(wb + r * 128) * xb; }
    float bb[4], cc[4];
#pragma unroll
    for (int k = 0; k < 4; ++k) {
        const float vf = (fminf(af[k], 0.f) - __logf(1.f + __expf(-fabsf(af[k])))) * (1.0f / 16.0f), vb = (fminf(ab[k], 0.f) - __logf(1.f + __expf(-fabsf(ab[k])))) * (1.0f / 16.0f);
        const float pf = wave_incl_scan(vf), pb = wave_incl_scan(vb);
        const float tot = __int_as_float(__builtin_amdgcn_readlane(__float_as_int(pb), 63));
        bb[k] = pf; cc[k] = tot - pb + vb; }
    __syncthreads();
    { float* vp = L + G_V + (tid >> 3) * 68 + (tid & 7) * 8; const u32x4 vw = g.vw;
      vp[0] = bflo(vw.x); vp[1] = bfhi(vw.x); vp[2] = bflo(vw.y); vp[3] = bfhi(vw.y); vp[4] = bflo(vw.z); vp[5] = bfhi(vw.z); vp[6] = bflo(vw.w); vp[7] = bfhi(vw.w); }
    { const u32x2 qw = g.qw, kw = g.kw; const float qv[4] = {bflo(qw.x), bfhi(qw.x), bflo(qw.y), bfhi(qw.y)}, kv[4] = {bflo(kw.x), bfhi(kw.x), bflo(kw.y), bfhi(kw.y)};
#pragma unroll
      for (int k = 0; k < 4; ++k) { const int d = 4 * wid + k; const float qs = qv[k] * 0.17677669529663687f;
          L[G_QF + lane * 33 + d] = qs * __expf(bb[k]); L[G_QB + lane * 33 + d] = qs * __expf(cc[k]); L[G_KF + d * 68 + lane] = kv[k] * __expf(-bb[k]); L[G_KB + d * 68 + lane] = kv[k] * __expf(-cc[k]);
          if (lane == 63) L[G_GF + 63 * 33 + d] = bb[k];
          if (lane == 0) L[G_GB + d] = cc[k]; } }
    __syncthreads();
}
__device__ __forceinline__ int crow32(int r, int hi) { return (r & 3) + 8 * (r >> 2) + 4 * hi; }
__device__ __forceinline__ void gla_pass1(KP p, int l, float* L) {
    const int tid = opaque_tid(), wid = tid >> 6, lane = tid & 63, c = lane & 31, kh = lane >> 5; unsigned char* ws = opaque_ptr(p->ws);
    float* SF = (float*)(ws + T_SF); float* SB = (float*)(ws + T_SB); float* DF = (float*)(ws + T_DF); float* DB = (float*)(ws + T_DB);
    int it = opaque_bid(); if (it >= 2048) return;
    GlaLoads cur = gla_issue(p, it);
    for (; it < 2048; it += gridDim.x) {
        const int h = it & 3, n = (it >> 2) & 127, b = it >> 9;
        const int itn = it + (int)gridDim.x < 2048 ? it + (int)gridDim.x : it;
        const GlaLoads nxt = gla_issue(p, itn);
        gla_prepare(p, l, h, cur, L);
        cur = nxt;
        if (wid < 4) {
            const int te = wid & 1, dir = wid >> 1; const float* Kx = L + (dir ? G_KB : G_KF) + c * 68 + kh; const float* Vx = L + G_V + kh * 68 + 32 * te + c;
            f32x16 acc = {};
#pragma unroll 8
            for (int kk = 0; kk < 32; ++kk) acc = __builtin_amdgcn_mfma_f32_32x32x2f32(Kx[2 * kk], Vx[2 * kk * 68], acc, 0, 0, 0);
            float* Sx = (dir ? SB : SF) + ((size_t)((b * 4 + h) * 128 + n)) * 2048 + 32 * te + c;
#pragma unroll
            for (int r = 0; r < 16; ++r) { const int d = crow32(r, kh); const float sc = __expf(dir ? L[G_GB + d] : L[G_GF + 63 * 33 + d]); Sx[d * 64] = acc[r] * sc; }
        }
        if (tid < 32) { DF[((b * 4 + h) * 128 + n) * 32 + tid] = __expf(L[G_GF + 63 * 33 + tid]); DB[((b * 4 + h) * 128 + n) * 32 + tid] = __expf(L[G_GB + tid]); }
    }
}
__device__ __forceinline__ void gla_pass2(KP p) {
    unsigned char* ws = opaque_ptr(p->ws); const int gid = opaque_bid() * NTHR + opaque_tid();
    if (gid >= 65536) return;
    const int bh = gid >> 12, dir = (gid >> 11) & 1, el = gid & 2047, d = el >> 6;
    float* S = (float*)(ws + (dir ? T_SB : T_SF)) + (size_t)bh * 128 * 2048 + el; const float* Dc = (const float*)(ws + (dir ? T_DB : T_DF)) + bh * 128 * 32 + d;
    float st = 0.f;
    for (int n0 = 0; n0 < 128; n0 += 32) {
        float Lv[32], Dv[32];
#pragma unroll
        for (int k = 0; k < 32; ++k) { const int n = dir ? 127 - (n0 + k) : n0 + k; Lv[k] = S[(size_t)n * 2048]; Dv[k] = Dc[n * 32]; }
#pragma unroll
        for (int k = 0; k < 32; ++k) { const int n = dir ? 127 - (n0 + k) : n0 + k; S[(size_t)n * 2048] = st; st = Dv[k] * st + Lv[k]; }
    }
}
__device__ __forceinline__ void gla_pass3(KP p, int l, float* L) {
    const int tid = opaque_tid(), wid = tid >> 6, lane = tid & 63, c = lane & 31, kh = lane >> 5; unsigned char* ws = opaque_ptr(p->ws);
    const float* SF = (const float*)(ws + T_SF); const float* SB = (const float*)(ws + T_SB);
    const bf16_t* gin = (const bf16_t*)(ws + T_GIN); bf16_t* mixb = (bf16_t*)(ws + T_MIXB);
    int it = opaque_bid(); if (it >= 2048) return;
    GlaLoads cur = gla_issue(p, it);
    for (; it < 2048; it += gridDim.x) {
        const int h = it & 3, n = (it >> 2) & 127, b = it >> 9;
        const size_t so = ((size_t)((b * 4 + h) * 128 + n)) * 2048 + tid * 4;
        const f32x4 sreg = *(const f32x4*)(SF + so), treg = *(const f32x4*)(SB + so);
        const int i0 = (tid >> 4) * 2, e0 = (tid & 15) * 4;
        const u32x2 rw0 = *(const u32x2*)(gin + (size_t)(b * SEQ + n * 64 + i0) * 832 + 544 + h * 64 + e0), rw1 = *(const u32x2*)(gin + (size_t)(b * SEQ + n * 64 + i0 + 1) * 832 + 544 + h * 64 + e0);
        const f32x4 gn = *(const f32x4*)(p->in[27] + l * 64 + e0);
        const int itn = it + (int)gridDim.x < 2048 ? it + (int)gridDim.x : it;
        const GlaLoads nxt = gla_issue(p, itn);
        gla_prepare(p, l, h, cur, L);
        cur = nxt;
        { const int d = tid >> 4; *(f32x4*)(L + G_S + d * 68 + e0) = sreg; *(f32x4*)(L + G_T + d * 68 + e0) = treg; }
        { const int ti = (wid >> 1) & 1, tj = wid & 1, dir = wid >> 2;
          const float* Qx = L + (dir ? G_QB : G_QF) + (32 * ti + c) * 33 + kh; const float* Kx = L + (dir ? G_KB : G_KF) + kh * 68 + 32 * tj + c;
          f32x16 acc = {};
#pragma unroll
          for (int kk = 0; kk < 16; ++kk) acc = __builtin_amdgcn_mfma_f32_32x32x2f32(Qx[2 * kk], Kx[2 * kk * 68], acc, 0, 0, 0);
          const int j = 32 * tj + c;
#pragma unroll
          for (int r = 0; r < 16; ++r) { const int i = 32 * ti + crow32(r, kh); const bool mine = dir ? (j > i) : (j <= i); if (mine) L[G_A + i * 65 + j] = acc[r]; } }
        __syncthreads();
        { const int ti = (wid >> 1) & 1, te = wid & 1, half = wid >> 2; f32x16 acc = {};
          if (half == 0) {
              const float* Ax = L + G_A + (32 * ti + c) * 65 + kh; const float* Vx = L + G_V + kh * 68 + 32 * te + c;
#pragma unroll 8
              for (int kk = 0; kk < 32; ++kk) acc = __builtin_amdgcn_mfma_f32_32x32x2f32(Ax[2 * kk], Vx[2 * kk * 68], acc, 0, 0, 0);
          } else {
              const float* Qf = L + G_QF + (32 * ti + c) * 33 + kh; const float* Qb = L + G_QB + (32 * ti + c) * 33 + kh;
              const float* Sx = L + G_S + kh * 68 + 32 * te + c; const float* Tx = L + G_T + kh * 68 + 32 * te + c;
#pragma unroll
              for (int kk = 0; kk < 16; ++kk) acc = __builtin_amdgcn_mfma_f32_32x32x2f32(Qf[2 * kk], Sx[2 * kk * 68], acc, 0, 0, 0);
#pragma unroll
              for (int kk = 0; kk < 16; ++kk) acc = __builtin_amdgcn_mfma_f32_32x32x2f32(Qb[2 * kk], Tx[2 * kk * 68], acc, 0, 0, 0);
#pragma unroll
              for (int r = 0; r < 16; ++r) L[G_O1 + (32 * ti + crow32(r, kh)) * 68 + 32 * te + c] = acc[r];
          }
          __syncthreads();
          if (half == 0) {
#pragma unroll
              for (int r = 0; r < 16; ++r) { const int o = (32 * ti + crow32(r, kh)) * 68 + 32 * te + c; L[G_O + o] = acc[r] + L[G_O1 + o]; }
          } }
        __syncthreads();
        const f32x4 o0 = *(const f32x4*)(L + G_O + i0 * 68 + e0), o1 = *(const f32x4*)(L + G_O + (i0 + 1) * 68 + e0);
        float s0 = o0[0] * o0[0] + o0[1] * o0[1] + o0[2] * o0[2] + o0[3] * o0[3], s1 = o1[0] * o1[0] + o1[1] * o1[1] + o1[2] * o1[2] + o1[3] * o1[3];
        s0 = dpp_add<0x128, 0xf>(s0); s0 = dpp_add<0x124, 0xf>(s0); s0 = dpp_add<0x122, 0xf>(s0); s0 = dpp_add<0x121, 0xf>(s0);
        s1 = dpp_add<0x128, 0xf>(s1); s1 = dpp_add<0x124, 0xf>(s1); s1 = dpp_add<0x122, 0xf>(s1); s1 = dpp_add<0x121, 0xf>(s1);
        const float r0 = rsqrtf(s0 * (1.0f / 64.0f) + 1e-6f), r1 = rsqrtf(s1 * (1.0f / 64.0f) + 1e-6f);
#pragma unroll
        for (int rr = 0; rr < 2; ++rr) { const int row = b * SEQ + n * 64 + i0 + rr; const f32x4 ov = rr ? o1 : o0; const float rs = rr ? r1 : r0;
            const u32x2 rw = rr ? rw1 : rw0; const float rv[4] = {bflo(rw.x), bfhi(rw.x), bflo(rw.y), bfhi(rw.y)};
            float ot[4];
#pragma unroll
            for (int k = 0; k < 4; ++k) ot[k] = ov[k] * rs * gn[k] * (rv[k] * __builtin_amdgcn_rcpf(1.f + __expf(-rv[k])));
            u32x2 w; w.x = cvt_pk_bf16(ot[0], ot[1]); w.y = cvt_pk_bf16(ot[2], ot[3]); *(u32x2*)(mixb + (size_t)row * DM + 768 + h * 64 + e0) = w; }
    }
}

__device__ __forceinline__ void mix_assemble(KP p, int l, float* L) {
    const int tid = opaque_tid(), wid = tid >> 6, lane = tid & 63; unsigned char* ws = opaque_ptr(p->ws);
    const bf16_t* hy = (const bf16_t*)(ws + T_HYT); bf16_t* mixb = (bf16_t*)(ws + T_MIXB); const bf16_t* atto = (const bf16_t*)(ws + T_ATTO);
    const float* gh = p->in[17] + l * 256; const float* gm = p->in[22] + l * 512;
    float* tile = L; float* red = L + 256 * 65;
    for (int it = opaque_bid(); it < NTOK / 64; it += gridDim.x) {
        const int row0 = it * 64;
        __syncthreads();
        { const int c = tid >> 1, t0 = (tid & 1) * 32; const bf16_t* sp = hy + (size_t)c * NTOK + row0 + t0;
#pragma unroll
          for (int q = 0; q < 4; ++q) { const u32x4 w = *(const u32x4*)(sp + q * 8); float* tp = tile + c * 65 + t0 + q * 8;
              tp[0] = bflo(w.x); tp[1] = bfhi(w.x); tp[2] = bflo(w.y); tp[3] = bfhi(w.y); tp[4] = bflo(w.z); tp[5] = bfhi(w.z); tp[6] = bflo(w.w); tp[7] = bfhi(w.w); } }
        __syncthreads();
        { const int t = tid & 63, part = tid >> 6; float ss = 0.f;
#pragma unroll 8
          for (int cc = 0; cc < 32; ++cc) { const float v = tile[(part * 32 + cc) * 65 + t]; ss += v * v; }
          red[part * 64 + t] = ss; }
        __syncthreads();
        { const int t = tid >> 3, cg8 = (tid & 7) * 32; float ss = 0.f;
#pragma unroll
          for (int q = 0; q < 8; ++q) ss += red[q * 64 + t];
          const float rs = rsqrtf(ss * (1.0f / 256.0f) + 1e-6f); bf16_t* op = mixb + (size_t)(row0 + t) * DM + cg8;
#pragma unroll
          for (int q = 0; q < 4; ++q) { float v[8];
#pragma unroll
              for (int k = 0; k < 8; ++k) v[k] = tile[(cg8 + q * 8 + k) * 65 + t] * rs * gh[cg8 + q * 8 + k];
              u32x4 w; w.x = cvt_pk_bf16(v[0], v[1]); w.y = cvt_pk_bf16(v[2], v[3]); w.z = cvt_pk_bf16(v[4], v[5]); w.w = cvt_pk_bf16(v[6], v[7]);
              *(u32x4*)(op + q * 8) = w; } }
    }
    for (int rb = (opaque_bid() * 8 + wid) * 4; rb < NTOK; rb += gridDim.x * 32) {
        u32x4 w[4];
#pragma unroll
        for (int q = 0; q < 4; ++q) w[q] = *(const u32x4*)(atto + (size_t)(rb + q) * 512 + lane * 8);
        const f32x4 g0 = *(const f32x4*)(gm + lane * 8), g1 = *(const f32x4*)(gm + lane * 8 + 4);
#pragma unroll
        for (int q = 0; q < 4; ++q) {
            float v[8] = {bflo(w[q].x), bfhi(w[q].x), bflo(w[q].y), bfhi(w[q].y), bflo(w[q].z), bfhi(w[q].z), bflo(w[q].w), bfhi(w[q].w)}; float ss = 0.f;
#pragma unroll
            for (int k = 0; k < 8; ++k) ss += v[k] * v[k];
#pragma unroll
            for (int sft = 1; sft < 64; sft <<= 1) ss += __shfl_xor(ss, sft);
            const float rs = rsqrtf(ss * (1.0f / 512.0f) + 1e-6f);
#pragma unroll
            for (int k = 0; k < 8; ++k) v[k] *= rs * (k < 4 ? g0[k & 3] : g1[k & 3]);
            u32x4 o; o.x = cvt_pk_bf16(v[0], v[1]); o.y = cvt_pk_bf16(v[2], v[3]); o.z = cvt_pk_bf16(v[4], v[5]); o.w = cvt_pk_bf16(v[6], v[7]);
            *(u32x4*)(mixb + (size_t)(rb + q) * DM + 256 + lane * 8) = o;
        }
    }
}

#define XB_TMO      128
#define XB_XCNT(j)  (256  + 64 * (j))
#define XB_XSUB(j)  (1280 + 64 * (j))
#define XB_XGEN(j)  (2304 + 64 * (j))
#define XB_TOP      3328
#define XB_TOPGEN   3392
#define XCD_BAR_WORDS 3456
#define XB_SPIN_CAP (1u << 20)
__device__ __forceinline__ unsigned xb_ld(unsigned* p)              { return __hip_atomic_load(p, __ATOMIC_RELAXED, __HIP_MEMORY_SCOPE_AGENT); }
__device__ __forceinline__ unsigned xb_add(unsigned* p, unsigned v) { return __hip_atomic_fetch_add(p, v, __ATOMIC_RELAXED, __HIP_MEMORY_SCOPE_AGENT); }
__device__ __forceinline__ unsigned xb_xcc_id() { return (unsigned)__builtin_amdgcn_s_getreg((3 << 11) | 20) & 0xFu; }
#define XB_SPIN(cond, bar) do { unsigned _sp = 0; while (cond) { __builtin_amdgcn_s_sleep(1); \
    if ((++_sp & 255u) == 0u) { if (xb_ld(&(bar)[XB_TMO])) break; if (_sp > XB_SPIN_CAP) { atomicAdd(&(bar)[XB_TMO], 1u); break; } } } } while (0)
struct XcdBarrier { unsigned* bar; unsigned x; volatile LAS unsigned* st; };
__device__ __forceinline__ XcdBarrier xcd_barrier_post(unsigned* bar, volatile LAS unsigned* st) {
    XcdBarrier b; b.bar = bar; b.x = xb_xcc_id(); b.st = st;
    if (threadIdx.x == 0) (void)xb_add(&bar[XB_XCNT(b.x)], 1u);
    return b;
}
__device__ __forceinline__ void xcd_barrier_complete(unsigned* bar, unsigned x, unsigned& nloc, unsigned& nx) {
    const unsigned G = gridDim.x * gridDim.y * gridDim.z;
    unsigned sum, cnt, mine, sp = 0u;
    for (;;) {
        sum = 0u; cnt = 0u; mine = 0u;
#pragma unroll
        for (unsigned j = 0; j < 16; ++j) { const unsigned c = xb_ld(&bar[XB_XCNT(j)]); sum += c; cnt += (c > 0u) ? 1u : 0u; mine = (j == x) ? c : mine; }
        if (sum == G) break;
        __builtin_amdgcn_s_sleep(1);
        if ((++sp & 255u) == 0u) { if (xb_ld(&bar[XB_TMO])) break; if (sp > XB_SPIN_CAP) { atomicAdd(&bar[XB_TMO], 1u); break; } }
    }
    nloc = mine > 0u ? mine : 1u; nx = cnt > 0u ? cnt : 1u;
}
__device__ __forceinline__ void xcd_barrier(const XcdBarrier& b) {
    asm volatile("s_waitcnt vmcnt(0)" ::: "memory");
    __syncthreads();
    if (threadIdx.x == 0) {
        unsigned* bar = b.bar;
        __builtin_amdgcn_s_waitcnt(0);
        unsigned nloc = b.st[0], nx = b.st[1];
        if (nloc == 0u) { xcd_barrier_complete(bar, b.x, nloc, nx); b.st[0] = nloc; b.st[1] = nx; }
        const unsigned old = xb_add(&bar[XB_XSUB(b.x)], 1u);
        const unsigned gen = old / nloc;
        if (old + 1u == (gen + 1u) * nloc) {
            __builtin_amdgcn_fence(__ATOMIC_RELEASE, "agent");
            asm volatile("s_waitcnt vmcnt(0)" ::: "memory");
            const unsigned og = xb_add(&bar[XB_TOP], 1u);
            const unsigned tg = og / nx;
            if (og + 1u == (tg + 1u) * nx) xb_add(&bar[XB_TOPGEN], 1u);
            else XB_SPIN(xb_ld(&bar[XB_TOPGEN]) == tg, bar);
            __builtin_amdgcn_fence(__ATOMIC_ACQUIRE, "agent");
            xb_add(&bar[XB_XGEN(b.x)], 1u);
            asm volatile("s_waitcnt vmcnt(0)" ::: "memory");
        } else {
            XB_SPIN(xb_ld(&bar[XB_XGEN(b.x)]) == gen, bar);
            __builtin_amdgcn_fence(__ATOMIC_ACQUIRE, "agent");
            asm volatile("s_waitcnt vmcnt(0)" ::: "memory");
        }
    }
    __syncthreads();
}

template <int SEL> __global__ __launch_bounds__(NTHR, 2) void mega_t(Params pv) {
    extern __shared__ __attribute__((aligned(16))) unsigned char shm[];
    cg::grid_group grid = cg::this_grid();
    __shared__ uint4 xb_words;
    if (threadIdx.x == 0) xb_words = make_uint4(0u, 0u, 0u, 0u);
    __syncthreads();
    const XcdBarrier xb = xcd_barrier_post((unsigned*)(pv.ws + OFF_BAR), (volatile LAS unsigned*)&xb_words);
    const KP kp = (KP)__builtin_amdgcn_kernarg_segment_ptr();
    unsigned char* ws = pv.ws;
    float* X = pv.out; bf16_t* XB = (bf16_t*)(ws + OFF_XB); float* SSX = (float*)(ws + OFF_SSX);
    for (int ph = pv.ph_lo; ph < pv.ph_hi; ++ph) {
        KP p = kp; asm volatile("" : "+s"(p));
        if (ph == 0) { if constexpr (SEL < 0 || SEL == 100) for (int r0 = 0; r0 < (PROBE_REP == 100 ? 2 : 1); ++r0) phase_prep(p, (float*)shm); }
        else if (ph == 19) { if constexpr (SEL < 0 || SEL == 101) {
            const float* g = p->in[33]; const int tid = opaque_tid(), wid = tid >> 6, lane = tid & 63;
            f32x4 gv[4];
#pragma unroll
            for (int i = 0; i < 4; ++i) gv[i] = *(const f32x4*)(g + lane * 16 + 4 * i);
            for (int rb = (opaque_bid() * 8 + wid) * 4; rb < NTOK; rb += gridDim.x * 32) {
                u32x4 w0[4], w1[4]; float rs[4];
#pragma unroll
                for (int q = 0; q < 4; ++q) { const bf16_t* bp = XB + (size_t)(rb + q) * DM + lane * 16; w0[q] = *(const u32x4*)bp; w1[q] = *(const u32x4*)(bp + 8); rs[q] = rstd16(SSX, rb + q); }
#pragma unroll
                for (int q = 0; q < 4; ++q) { float* xp = X + (size_t)(rb + q) * DM + lane * 16;
                    const float xv[16] = {bflo(w0[q].x), bfhi(w0[q].x), bflo(w0[q].y), bfhi(w0[q].y), bflo(w0[q].z), bfhi(w0[q].z), bflo(w0[q].w), bfhi(w0[q].w), bflo(w1[q].x), bfhi(w1[q].x), bflo(w1[q].y), bfhi(w1[q].y), bflo(w1[q].z), bfhi(w1[q].z), bflo(w1[q].w), bfhi(w1[q].w)};
#pragma unroll
                    for (int i = 0; i < 4; ++i) { f32x4 v = {xv[4 * i], xv[4 * i + 1], xv[4 * i + 2], xv[4 * i + 3]}; v = v * rs[q] * gv[i]; *(f32x4*)(xp + 4 * i) = v; } }
            } }
        } else {
            const int l = (ph - 1) / 9, sp = (ph - 1) % 9;
            pg8::StaticOrder S;
            if constexpr (SEL < 0 || SEL == 0) if (sp == 0 || sp == 7) {
                const int f = sp == 0 ? 0 : 1;
                pg8::Gemm g{XB, (const bf16_t*)(ws + OFF_WUP + (l * 2 + f) * SZ_WUP), NTOK, 5632, 1024, 1024}; S.init(g.M, g.N, gridDim.x, opaque_bid());
                EpiFfnUp E{ws, -1, {0.f, 0.f, 0.f, 0.f, 0.f, 0.f, 0.f, 0.f}};
                for (int r1 = 0; r1 < (PROBE_REP == 0 ? 2 : 1); ++r1) pg8::gemm_phase(( LAS unsigned char*)shm, g, S, E);
            }
            if constexpr (SEL < 0 || SEL == 1) if (sp == 1 || sp == 8) {
                const int f = sp == 1 ? 0 : 1;
                pg8::Gemm g{(const bf16_t*)(ws + T_ACT), (const bf16_t*)(ws + OFF_WDN + (l * 2 + f) * SZ_WDN), NTOK, 1024, FF, FF}; S.init(g.M, g.N, gridDim.x, opaque_bid());
                for (int r1 = (PROBE_REP == 1 ? 0 : 1); r1 < 2; ++r1) { EpiResid E{ws, r1 == 0 ? 0.f : 0.5f};
                pg8::gemm_phase((LAS unsigned char*)shm, g, S, E); }
            }
            if constexpr (SEL < 0 || SEL == 2) if (sp == 2) {
                pg8::Gemm g{XB, (const bf16_t*)(ws + OFF_WIN + l * SZ_WIN), NTOK, 2048, 1024, 1024}; S.init(g.M, g.N, gridDim.x, opaque_bid());
                EpiWin E{ws};
                for (int r1 = 0; r1 < (PROBE_REP == 2 ? 2 : 1); ++r1) pg8::gemm_phase((LAS unsigned char*)shm, g, S, E);
            }
            if constexpr (SEL < 0 || SEL == 30 || SEL == 31 || SEL == 32) if (sp == 3) {
                if constexpr (SEL < 0 || SEL == 30) for (int r3 = 0; r3 < (PROBE_REP == 30 ? 2 : 1); ++r3) {
                { pg8::Gemm g{(const bf16_t*)(ws + T_CQB), (const bf16_t*)(ws + OFF_WUQ + l * SZ_WUQ), NTOK, 768, 256, 256}; S.init(g.M, g.N, gridDim.x, opaque_bid());
                  EpiUq E{ws};
                  pg8::gemm_phase((LAS unsigned char*)shm, g, S, E); }
                { pg8::Gemm g{(const bf16_t*)(ws + T_CKVB), (const bf16_t*)(ws + OFF_WUKV + l * SZ_WUKV), NTOK, 1024, 256, 256}; S.init(g.M, g.N, gridDim.x, opaque_bid());
                  EpiUkv E{ws};
                  pg8::gemm_phase((LAS unsigned char*)shm, g, S, E); }
                }
                if constexpr (SEL < 0 || SEL == 31) for (int r3 = (PROBE_REP == 31 ? 0 : 1); r3 < 2; ++r3) for (int c = opaque_bid(); c < 256; c += gridDim.x) hyena_item(p, l, c, (float2*)shm, r3 == 1);
                if constexpr (SEL < 0 || SEL == 32) for (int r3 = 0; r3 < (PROBE_REP == 32 ? 2 : 1); ++r3) gla_pass1(p, l, (float*)shm);
            }
            if constexpr (SEL < 0 || SEL == 4) if (sp == 4) {
                gla_pass2(p);
                const bf16_t* QN = (const bf16_t*)(ws + T_QN); const bf16_t* QR = (const bf16_t*)(ws + T_QR); const bf16_t* KN = (const bf16_t*)(ws + T_KN);
                const bf16_t* KR = (const bf16_t*)(ws + T_KR); const bf16_t* VV = (const bf16_t*)(ws + T_V); bf16_t* AO = (bf16_t*)(ws + T_ATTO);
                const int nper = (512 * 8) / (int)gridDim.x;
                (void)nper;
                for (int r4 = 0; r4 < (PROBE_REP == 4 ? 2 : 1); ++r4)
                for (int it = opaque_bid(); it < 512; it += gridDim.x) {
                    const int x = it & 7, y = it >> 3;
                    const int bh = x + 8 * (y >> 5), qb = y & 31;
                    const int b = bh >> 2, h = bh & 3;
                    const size_t hoff = ((size_t)bh * SEQ) * 128;
                    att::attn_body(QN + hoff + (size_t)qb * 256 * 128, QR + ((size_t)bh * SEQ + qb * 256) * 64, KN + hoff, KR + (size_t)b * SEQ * 64, VV + hoff,
                                   AO + ((size_t)b * SEQ + qb * 256) * 512 + h * 128, SEQ, (char*)shm);
                }
            }
            if constexpr (SEL < 0 || SEL == 5) if (sp == 5) {
                for (int r5 = 0; r5 < (PROBE_REP == 50 ? 2 : 1); ++r5) mix_assemble(p, l, (float*)shm);
                for (int r5 = 0; r5 < (PROBE_REP == 51 ? 2 : 1); ++r5) gla_pass3(p, l, (float*)shm);
            }
            if constexpr (SEL < 0 || SEL == 6) if (sp == 6) {
                pg8::Gemm g{(const bf16_t*)(ws + T_MIXB), (const bf16_t*)(ws + OFF_WOUT + l * SZ_WOUT), NTOK, 1024, 1024, 1024}; S.init(g.M, g.N, gridDim.x, opaque_bid());
                for (int r1 = (PROBE_REP == 6 ? 0 : 1); r1 < 2; ++r1) { EpiResid E{ws, r1 == 0 ? 0.f : 1.0f};
                pg8::gemm_phase((LAS unsigned char*)shm, g, S, E); }
            }
        }
        if (ph + 1 < pv.ph_hi) { if (pv.ph_hi > 1000) grid.sync(); else xcd_barrier(xb); }
    }
}

#if MK_COOP
#define MEGA_MAIN mega_t<-1>
#else
#define MEGA_MAIN mega_t<0>
#endif
extern "C" void kernel_launch(void* const* d_in, const int* in_sizes, int n_in, void* d_out, int out_size, void* d_ws, size_t ws_size, hipStream_t stream) {
    static int grid_blocks = 0;
    if (grid_blocks == 0) {
        if (n_in != 34 || out_size != NTOK * DM || ws_size < WS_END) { fprintf(stderr, "kernel_launch: unexpected shapes n_in %d out %d ws %zu (need %zu)\n", n_in, out_size, ws_size, (size_t)WS_END); grid_blocks = -1; return; }
        if (hipFuncSetAttribute((const void*)MEGA_MAIN, hipFuncAttributeMaxDynamicSharedMemorySize, LDS_BYTES) != hipSuccess) { fprintf(stderr, "kernel_launch: hipFuncSetAttribute failed\n"); grid_blocks = -1; return; }
        int dev = 0, cus = 0, per_cu = 0;
        (void)hipGetDevice(&dev); (void)hipDeviceGetAttribute(&cus, hipDeviceAttributeMultiprocessorCount, dev);
        (void)hipOccupancyMaxActiveBlocksPerMultiprocessor(&per_cu, (const void*)MEGA_MAIN, NTHR, LDS_BYTES);
        if (per_cu < 1) { fprintf(stderr, "kernel_launch: occupancy query says %d blocks/CU\n", per_cu); per_cu = 1; }
        (void)hipGetLastError();
        grid_blocks = cus * per_cu;
        fprintf(stderr, "kernel_launch: grid %d (cus %d x %d)\n", grid_blocks, cus, per_cu);
    }
    if (grid_blocks < 0) return;
    Params p{};
    for (int i = 0; i < 34; ++i) p.in[i] = (const float*)d_in[i];
    p.out = (float*)d_out; p.ws = (unsigned char*)d_ws;
    if (hipMemsetAsync((unsigned char*)d_ws + OFF_BAR, 0, 16384, stream) != hipSuccess) { fprintf(stderr, "kernel_launch: memset of barrier words failed\n"); return; }
#if MK_COOP == 2
    for (int ph = 0; ph < 20; ++ph) { p.ph_lo = ph; p.ph_hi = ph + 1; hipLaunchKernelGGL(mega_t<-1>, dim3(grid_blocks), dim3(NTHR), LDS_BYTES, stream, p); }
#elif MK_COOP
    p.ph_lo = 0; p.ph_hi = 20;
    void* args[] = {&p};
    hipError_t e = hipLaunchCooperativeKernel((const void*)mega_t<-1>, dim3(grid_blocks), dim3(NTHR), args, LDS_BYTES, stream);
    if (e != hipSuccess) fprintf(stderr, "cooperative launch failed: %s (grid %d)\n", hipGetErrorString(e), grid_blocks);
#else
    static int attr_done = 0;
    if (!attr_done) {
        attr_done = 1;
        (void)hipFuncSetAttribute((const void*)mega_t<0>, hipFuncAttributeMaxDynamicSharedMemorySize, LDS_BYTES); (void)hipFuncSetAttribute((const void*)mega_t<1>, hipFuncAttributeMaxDynamicSharedMemorySize, LDS_BYTES);
        (void)hipFuncSetAttribute((const void*)mega_t<2>, hipFuncAttributeMaxDynamicSharedMemorySize, LDS_BYTES); (void)hipFuncSetAttribute((const void*)mega_t<30>, hipFuncAttributeMaxDynamicSharedMemorySize, LDS_BYTES); (void)hipFuncSetAttribute((const void*)mega_t<31>, hipFuncAttributeMaxDynamicSharedMemorySize, LDS_BYTES); (void)hipFuncSetAttribute((const void*)mega_t<32>, hipFuncAttributeMaxDynamicSharedMemorySize, LDS_BYTES);
        (void)hipFuncSetAttribute((const void*)mega_t<4>, hipFuncAttributeMaxDynamicSharedMemorySize, LDS_BYTES); (void)hipFuncSetAttribute((const void*)mega_t<5>, hipFuncAttributeMaxDynamicSharedMemorySize, LDS_BYTES);
        (void)hipFuncSetAttribute((const void*)mega_t<6>, hipFuncAttributeMaxDynamicSharedMemorySize, LDS_BYTES); (void)hipFuncSetAttribute((const void*)mega_t<100>, hipFuncAttributeMaxDynamicSharedMemorySize, LDS_BYTES);
        (void)hipFuncSetAttribute((const void*)mega_t<101>, hipFuncAttributeMaxDynamicSharedMemorySize, LDS_BYTES);
    }
    for (int ph = 0; ph < 20; ++ph) {
        p.ph_lo = ph; p.ph_hi = ph + 1;
        const int sp = (ph == 0) ? 100 : (ph == 19) ? 101 : (ph - 1) % 9;
        switch (sp) {
            case 0: case 7: hipLaunchKernelGGL(mega_t<0>, dim3(grid_blocks), dim3(NTHR), LDS_BYTES, stream, p); break;
            case 1: case 8: hipLaunchKernelGGL(mega_t<1>, dim3(grid_blocks), dim3(NTHR), LDS_BYTES, stream, p); break;
            case 2: hipLaunchKernelGGL(mega_t<2>, dim3(grid_blocks), dim3(NTHR), LDS_BYTES, stream, p); break;
            case 3: hipLaunchKernelGGL(mega_t<30>, dim3(grid_blocks), dim3(NTHR), LDS_BYTES, stream, p); hipLaunchKernelGGL(mega_t<31>, dim3(grid_blocks), dim3(NTHR), LDS_BYTES, stream, p);
                    hipLaunchKernelGGL(mega_t<32>, dim3(grid_blocks), dim3(NTHR), LDS_BYTES, stream, p); break;
            case 4: hipLaunchKernelGGL(mega_t<4>, dim3(grid_blocks), dim3(NTHR), LDS_BYTES, stream, p); break;
            case 5: hipLaunchKernelGGL(mega_t<5>, dim3(grid_blocks), dim3(NTHR), LDS_BYTES, stream, p); break;
            case 6: hipLaunchKernelGGL(mega_t<6>, dim3(grid_blocks), dim3(NTHR), LDS_BYTES, stream, p); break;
            case 100: hipLaunchKernelGGL(mega_t<100>, dim3(grid_blocks), dim3(NTHR), LDS_BYTES, stream, p); break;
            default: hipLaunchKernelGGL(mega_t<101>, dim3(grid_blocks), dim3(NTHR), LDS_BYTES, stream, p); break;
        }
    }
#endif
}
```

```cpp
#include <hip/hip_runtime.h>
#include <hip/hip_cooperative_groups.h>
#include <cstdio>
#include <cstdint>
namespace cg = cooperative_groups;

#ifndef MK_COOP
#define MK_COOP 1
#endif
#ifndef PROBE_REP
#define PROBE_REP -1
#endif

typedef unsigned short bf16_t;
typedef short bf16x8 __attribute__((ext_vector_type(8)));
typedef short s16x4 __attribute__((ext_vector_type(4)));
typedef float f32x4 __attribute__((ext_vector_type(4)));
typedef float f32x16 __attribute__((ext_vector_type(16)));
typedef unsigned u32x4 __attribute__((ext_vector_type(4)));
typedef unsigned u32x2 __attribute__((ext_vector_type(2)));
#define LAS __attribute__((address_space(3)))

constexpr int NTOK = 32768, DM = 1024, FF = 2816, SEQ = 8192, NB = 4;
constexpr int NTHR = 512;
constexpr int LDS_BYTES = 149504;

constexpr size_t SZ_WUP = (size_t)5632 * 1024 * 2, SZ_WDN = (size_t)1024 * 2816 * 2, SZ_WIN = (size_t)2048 * 1024 * 2, SZ_WOUT = (size_t)1024 * 1024 * 2,
                 SZ_WUQ = (size_t)768 * 256 * 2, SZ_WUKV = (size_t)1024 * 256 * 2;
constexpr size_t OFF_WUP = 0, OFF_WDN = OFF_WUP + 4 * SZ_WUP, OFF_WIN = OFF_WDN + 4 * SZ_WDN, OFF_WOUT = OFF_WIN + 2 * SZ_WIN, OFF_WUQ = OFF_WOUT + 2 * SZ_WOUT,
                 OFF_WUKV = OFF_WUQ + 2 * SZ_WUQ, OFF_XB = OFF_WUKV + 2 * SZ_WUKV, OFF_SSX = OFF_XB + (size_t)NTOK * DM * 2, OFF_H2T = OFF_SSX + (size_t)NTOK * 16 * 4,
                 OFF_ROPE = OFF_H2T + (size_t)2 * 64 * 8192 * 4, OFF_BAR = OFF_ROPE + (size_t)8192 * 64 * 4, OFF_TR = OFF_BAR + 16384;
constexpr size_t T_ACT = OFF_TR;
constexpr size_t T_HYT = OFF_TR;
constexpr size_t T_CQB = T_HYT + (size_t)768 * NTOK * 2;
constexpr size_t T_CKVB = T_CQB + (size_t)NTOK * 256 * 2;
constexpr size_t T_SSCQ = T_CKVB + (size_t)NTOK * 256 * 2;
constexpr size_t T_SSCKV = T_SSCQ + (size_t)NTOK * 4 * 4;
constexpr size_t T_KR = T_SSCKV + (size_t)NTOK * 4 * 4;
constexpr size_t T_GIN = T_KR + (size_t)NTOK * 64 * 2;
constexpr size_t T_GG = T_GIN + (size_t)NTOK * 832 * 2;
constexpr size_t T_FK = T_GG + (size_t)NTOK * 32 * 4;
constexpr size_t T_ATTO = T_FK;
constexpr size_t T_SF = T_FK + (size_t)256 * 2 * 16384 * 8;
constexpr size_t T_SB = T_SF + (size_t)16 * 128 * 2048 * 4;
constexpr size_t T_DF = T_SB + (size_t)16 * 128 * 2048 * 4;
constexpr size_t T_DB = T_DF + (size_t)16 * 128 * 32 * 4;
constexpr size_t T_QN = T_DB + (size_t)16 * 128 * 32 * 4;
constexpr size_t T_MIXB = T_QN;
constexpr size_t T_QR = T_QN + (size_t)NTOK * 4 * 128 * 2;
constexpr size_t T_KN = T_QR + (size_t)NTOK * 4 * 64 * 2;
constexpr size_t T_V = T_KN + (size_t)NTOK * 4 * 128 * 2;
constexpr size_t WS_END = T_V + (size_t)NTOK * 4 * 128 * 2;
static_assert(WS_END <= (size_t)536870912, "workspace over 512 MiB");
static_assert(T_ACT + (size_t)NTOK * FF * 2 <= WS_END, "act");
static_assert((size_t)NTOK * DM * 2 <= (T_KN + (size_t)NTOK * 4 * 128 * 2) - T_QN, "mixb alias");

struct Params {
    const float* in[34];
    float* out;
    unsigned char* ws;
    int ph_lo, ph_hi;
};

typedef const Params __attribute__((address_space(4)))* KP;
__device__ __forceinline__ int opaque_tid() { int t = threadIdx.x; asm volatile("" : "+v"(t)); return t; }
__device__ __forceinline__ unsigned char* opaque_ptr(unsigned char* q) { return q; }
__device__ __forceinline__ int opaque_bid() { int t = blockIdx.x; asm volatile("" : "+s"(t)); return t; }
__device__ __forceinline__ unsigned cvt_pk_bf16(float lo, float hi) { unsigned r; asm volatile("v_cvt_pk_bf16_f32 %0, %1, %2" : "=v"(r) : "v"(lo), "v"(hi)); return r; }
__device__ __forceinline__ bf16_t f2bf(float f) { return (bf16_t)(cvt_pk_bf16(f, 0.f) & 0xffffu); }
__device__ __forceinline__ float bf2f(bf16_t b) { return __uint_as_float(((unsigned)b) << 16); }
__device__ __forceinline__ float bflo(unsigned w) { return __uint_as_float(w << 16); }
__device__ __forceinline__ float bfhi(unsigned w) { return __uint_as_float(w & 0xffff0000u); }
__device__ __forceinline__ float sin_rev(float r) { return __builtin_amdgcn_sinf(r); }
__device__ __forceinline__ float cos_rev(float r) { return __builtin_amdgcn_cosf(r); }
__device__ __forceinline__ float fast_sin(float x) { float r = x * 0.15915494309189535f; r = r - floorf(r); return __builtin_amdgcn_sinf(r); }
__device__ __forceinline__ float quad_sum(float s) {
    auto a = __builtin_amdgcn_permlane16_swap(__float_as_uint(s), __float_as_uint(s), false, false); s = __uint_as_float(a[0]) + __uint_as_float(a[1]);
    auto b = __builtin_amdgcn_permlane32_swap(__float_as_uint(s), __float_as_uint(s), false, false); return __uint_as_float(b[0]) + __uint_as_float(b[1]);
}
__device__ __forceinline__ float rstd16(const float* ss, int row) {
    const f32x4* p = (const f32x4*)(ss + (size_t)row * 16); const f32x4 a = p[0], b = p[1], c = p[2], d = p[3];
    const float s = ((a.x + a.y) + (a.z + a.w)) + ((b.x + b.y) + (b.z + b.w)) + ((c.x + c.y) + (c.z + c.w)) + ((d.x + d.y) + (d.z + d.w));
    return rsqrtf(s * (1.0f / 1024.0f) + 1e-6f);
}
__device__ __forceinline__ float rstd16q(const float* ss, int row, int fq) {
    const f32x4 a = *(const f32x4*)(ss + (size_t)row * 16 + 4 * fq); float s = (a.x + a.y) + (a.z + a.w);
    s = quad_sum(s);
    return rsqrtf(s * (1.0f / 1024.0f) + 1e-6f);
}
__device__ __forceinline__ float rstd4(const float* ss, int row, float invn) {
    const f32x4 a = *(const f32x4*)(ss + (size_t)row * 4); return rsqrtf(((a.x + a.y) + (a.z + a.w)) * invn + 1e-6f);
}

namespace pg8 {
constexpr int BM = 256, BK = 64, HALF = 128, HTB = HALF * BK * 2, NXCD = 8, WGM = 8;
__host__ __device__ __forceinline__ int lds_byte(int r, int c) { const int st = (r >> 4) * 2 + (c >> 5), rr = r & 15, cc = c & 31, ob = rr * 64 + cc * 2; return st * 1024 + (ob ^ (((ob >> 9) & 1) << 5)); }
__host__ __device__ __forceinline__ void stage_rc(int b, int& R, int& C) { const int st = b / 1024, sb = b % 1024, swz = sb ^ (((sb >> 9) & 1) << 5); R = (st >> 1) * 16 + swz / 64; C = (st & 1) * 32 + (swz % 64) / 2; }
__host__ __device__ __forceinline__ int perm32(int rho) { const int n = rho >> 4, i = rho & 15; return 8 * (i >> 2) + 4 * n + (i & 3); }
struct Unit { int pm, pn; };
struct Gemm { const bf16_t* A; const bf16_t* Bt; int M, N, K, lda; };
struct StaticOrder {
    int nM, nN, nwg, G, c;
    __device__ void init(int M, int N, int G_, int c_) { nM = M / BM; nN = N / BM; nwg = nM * nN; G = G_; c = c_; }
    __device__ bool next(int i, Unit& u) const {
        const long L = (long)i * G + c; if (L >= nwg) return false;
        int wgid = (int)L; { const int q = nwg / NXCD, r = nwg % NXCD, xcd = wgid % NXCD, off = wgid / NXCD; wgid = (xcd < r ? xcd * (q + 1) : r * (q + 1) + (xcd - r) * q) + off; }
        const int nig = WGM * nN, gid = wgid / nig, fm = gid * WGM, gsz = (nM - fm) < WGM ? (nM - fm) : WGM;
        u.pm = fm + ((wgid % nig) % gsz); u.pn = (wgid % nig) / gsz; return true;
    }
};
template <class Epi>
__device__ __forceinline__ void gemm_phase(LAS unsigned char* lds, const Gemm g, const StaticOrder& S, Epi& E) {
    const int tid = opaque_tid(), wid = __builtin_amdgcn_readfirstlane(tid >> 6), lane = tid & 63, wr = wid >> 2, wc = wid & 3, fr = lane & 15, fq = lane >> 4;
    int K = g.K, lda = g.lda; asm volatile("" : "+s"(K), "+s"(lda));
    const int nt = K / BK;
    unsigned voffA[2], voffB[2];
#pragma unroll
    for (int i = 0; i < 2; ++i) { int R, C; stage_rc(tid * 16 + i * 8192, R, C); const int Rb = Epi::PERM ? ((R & ~31) + perm32(R & 31)) : R; voffA[i] = (unsigned)(R * lda + C) * 2u; voffB[i] = (unsigned)(Rb * K + C) * 2u; }
    const size_t kstep = (size_t)(BK * 2);
    const size_t hstepA = (size_t)HALF * lda * 2, hstepB = (size_t)HALF * K * 2;
    const size_t tstepA = 2 * hstepA, tstepB = 2 * hstepB;
    const unsigned ldsw = (unsigned)wid * 1024u;
    const int aoff = lds_byte(wr * 64 + fr, fq * 8), boff = lds_byte(wc * 32 + fr, fq * 8);
#define PG8_SA(b, h) (((b) * 2 + (h)) * HTB)
#define PG8_SB(b, h) ((4 + (b) * 2 + (h)) * HTB)
#define PG8_STAGE(bufoff, gbase, voff) do { _Pragma("unroll") for (int _i = 0; _i < 2; ++_i) \
        __builtin_amdgcn_global_load_lds((const unsigned*)((const char*)(gbase) + (voff)[_i]), (LAS unsigned*)(lds + (bufoff) + ldsw + _i * 8192), 16, 0, 0); } while (0)
#define PG8_LDA(dst, b, h) do { _Pragma("unroll") for (int m = 0; m < 4; ++m) _Pragma("unroll") for (int k = 0; k < 2; ++k) dst[m][k] = *(const LAS bf16x8*)(lds + PG8_SA(b, h) + aoff + m * 2048 + k * 1024); } while (0)
#define PG8_LDB(dst, b, h) do { _Pragma("unroll") for (int n = 0; n < 2; ++n) _Pragma("unroll") for (int k = 0; k < 2; ++k) dst[n][k] = *(const LAS bf16x8*)(lds + PG8_SB(b, h) + boff + n * 2048 + k * 1024); } while (0)
#define PG8_MMA(ai, bj, At, Bt) do { __builtin_amdgcn_s_setprio(1); _Pragma("unroll") for (int m = 0; m < 4; ++m) _Pragma("unroll") for (int n = 0; n < 2; ++n) _Pragma("unroll") for (int k = 0; k < 2; ++k) \
        acc[ai][bj][m][n] = __builtin_amdgcn_mfma_f32_16x16x32_bf16(Bt[n][k], At[m][k], acc[ai][bj][m][n], 0, 0, 0); __builtin_amdgcn_s_setprio(0); } while (0)
#define PG8_WAIT_V(n) asm volatile("s_waitcnt vmcnt(" #n ")" ::: "memory")
#define PG8_WAIT_L(n) asm volatile("s_waitcnt lgkmcnt(" #n ")" ::: "memory")
#define PG8_BAR __builtin_amdgcn_s_barrier()
#define PG8_SCHED __builtin_amdgcn_sched_barrier(0)
    Unit cur, nxt; int ui = 0;
    if (!S.next(0, cur)) return;
    f32x4 acc[2][2][4][2];
#pragma unroll
    for (int a = 0; a < 2; ++a)
#pragma unroll
        for (int b = 0; b < 2; ++b)
#pragma unroll
            for (int m = 0; m < 4; ++m)
#pragma unroll
                for (int n = 0; n < 2; ++n) acc[a][b][m][n] = (f32x4){0.f, 0.f, 0.f, 0.f};
    bf16x8 At[4][2], B0[2][2], B1[2][2];
    const char* cA = (const char*)g.A + (size_t)cur.pm * tstepA; const char* cB = (const char*)g.Bt + (size_t)cur.pn * tstepB;
    PG8_STAGE(PG8_SB(0, 0), cB, voffB); PG8_STAGE(PG8_SA(0, 0), cA, voffA); PG8_STAGE(PG8_SB(0, 1), cB + hstepB, voffB); PG8_STAGE(PG8_SA(0, 1), cA + hstepA, voffA);
    if (wr == 1) PG8_BAR;
    PG8_WAIT_V(4); PG8_BAR;
    PG8_STAGE(PG8_SB(1, 0), cB + kstep, voffB); PG8_STAGE(PG8_SA(1, 0), cA + kstep, voffA); PG8_STAGE(PG8_SB(1, 1), cB + hstepB + kstep, voffB);
    PG8_WAIT_V(6); PG8_BAR;
    for (;;) {
        const bool has_next = S.next(ui + 1, nxt);
        const char* nA = has_next ? (const char*)g.A + (size_t)nxt.pm * tstepA : cA; const char* nB = has_next ? (const char*)g.Bt + (size_t)nxt.pn * tstepB : cB;
        for (int t = 0; t < nt; t += 2) {
            const bool last = (t == nt - 2);
            const char* a1 = cA + (size_t)(t + 1) * kstep;
            const char* a2 = last ? nA : cA + (size_t)(t + 2) * kstep; const char* b2 = last ? nB : cB + (size_t)(t + 2) * kstep;
            const char* a3 = a2 + kstep; const char* b3 = b2 + kstep;
            PG8_LDB(B0, 0, 0); PG8_SCHED; PG8_LDA(At, 0, 0); PG8_STAGE(PG8_SA(1, 1), a1 + hstepA, voffA);
            PG8_WAIT_L(8); PG8_BAR; PG8_WAIT_L(0); PG8_MMA(0, 0, At, B0); PG8_BAR; PG8_SCHED;
            PG8_LDB(B1, 0, 1); PG8_STAGE(PG8_SB(0, 0), b2, voffB);
            PG8_BAR; PG8_WAIT_L(0); PG8_MMA(0, 1, At, B1); PG8_BAR;
            PG8_LDA(At, 0, 1); PG8_STAGE(PG8_SA(0, 0), a2, voffA);
            PG8_BAR; PG8_WAIT_L(0); PG8_MMA(1, 0, At, B0); PG8_BAR; PG8_SCHED;
            PG8_STAGE(PG8_SB(0, 1), b2 + hstepB, voffB);
            PG8_WAIT_V(6); PG8_BAR; PG8_MMA(1, 1, At, B1); PG8_BAR;
            PG8_LDB(B0, 1, 0); PG8_SCHED; PG8_LDA(At, 1, 0); PG8_STAGE(PG8_SA(0, 1), a2 + hstepA, voffA);
            PG8_WAIT_L(8); PG8_BAR; PG8_WAIT_L(0); PG8_MMA(0, 0, At, B0); PG8_BAR; PG8_SCHED;
            PG8_LDB(B1, 1, 1); PG8_STAGE(PG8_SB(1, 0), b3, voffB);
            PG8_BAR; PG8_WAIT_L(0); PG8_MMA(0, 1, At, B1); PG8_BAR;
            PG8_LDA(At, 1, 1); PG8_STAGE(PG8_SA(1, 0), a3, voffA);
            PG8_BAR; PG8_WAIT_L(0); PG8_MMA(1, 0, At, B0); PG8_BAR; PG8_SCHED;
            PG8_STAGE(PG8_SB(1, 1), b3 + hstepB, voffB);
            PG8_WAIT_V(6); PG8_BAR; PG8_MMA(1, 1, At, B1); PG8_BAR;
        }
        { int fr2 = fr, fq2 = fq, wr2 = wr, wc2 = wc; asm volatile("" : "+v"(fr2), "+v"(fq2), "+s"(wr2), "+s"(wc2));
          E(acc, cur, wr2, wc2, fr2, fq2); }
        if (!has_next) break;
#pragma unroll
        for (int a = 0; a < 2; ++a)
#pragma unroll
            for (int b = 0; b < 2; ++b)
#pragma unroll
                for (int m = 0; m < 4; ++m)
#pragma unroll
                    for (int n = 0; n < 2; ++n) acc[a][b][m][n] = (f32x4){0.f, 0.f, 0.f, 0.f};
        cur = nxt; cA = nA; cB = nB; ++ui;
    }
    PG8_WAIT_V(0);
    if (wr == 0) PG8_BAR;
    PG8_BAR;
#undef PG8_SA
#undef PG8_SB
#undef PG8_STAGE
#undef PG8_LDA
#undef PG8_LDB
#undef PG8_MMA
#undef PG8_WAIT_V
#undef PG8_WAIT_L
#undef PG8_BAR
#undef PG8_SCHED
}
}
using pg8::Unit;
typedef f32x4 AccT[2][2][4][2];

struct EpiFfnUp {
    static constexpr bool PERM = true;
    unsigned char* ws; int last_pm; float rsc[8];
    __device__ __forceinline__ void operator()(const AccT& acc, const Unit& u, int wr, int wc, int fr, int fq) {
        bf16_t* act = (bf16_t*)(ws + T_ACT); const float* ssx = (const float*)(ws + OFF_SSX);
        const int row0 = u.pm * 256 + wr * 64 + fr, col0 = u.pn * 128 + wc * 32 + 8 * fq;
        if (u.pm != last_pm) {
            last_pm = u.pm;
#pragma unroll
            for (int ai = 0; ai < 2; ++ai)
#pragma unroll
                for (int m = 0; m < 4; ++m) rsc[ai * 4 + m] = rstd16q(ssx, row0 + ai * 128 + m * 16, fq);
        }
#pragma unroll
        for (int ai = 0; ai < 2; ++ai)
#pragma unroll
            for (int m = 0; m < 4; ++m) {
                const int row = row0 + ai * 128 + m * 16; const float rs = rsc[ai * 4 + m];
                float o[8];
#pragma unroll
                for (int n = 0; n < 2; ++n)
#pragma unroll
                    for (int j = 0; j < 4; ++j) { const float gv = acc[ai][0][m][n][j] * rs, uv = acc[ai][1][m][n][j] * rs; o[4 * n + j] = gv * __builtin_amdgcn_rcpf(1.f + __expf(-gv)) * uv; }
                u32x4 w; w.x = cvt_pk_bf16(o[0], o[1]); w.y = cvt_pk_bf16(o[2], o[3]); w.z = cvt_pk_bf16(o[4], o[5]); w.w = cvt_pk_bf16(o[6], o[7]);
                __builtin_nontemporal_store(w, (u32x4*)(act + (size_t)row * FF + col0));
            }
    }
};
struct EpiResid {
    static constexpr bool PERM = true;
    unsigned char* ws; float alpha;
    __device__ __forceinline__ void operator()(const AccT& acc, const Unit& u, int wr, int wc, int fr, int fq) const {
        bf16_t* xb = (bf16_t*)(ws + OFF_XB); float* ssx = (float*)(ws + OFF_SSX);
        const int row0 = u.pm * 256 + wr * 64 + fr, col0 = u.pn * 256 + wc * 32 + 8 * fq;
#pragma unroll
        for (int ai = 0; ai < 2; ++ai) {
            u32x4 xo[4][2];
#pragma unroll
            for (int m = 0; m < 4; ++m)
#pragma unroll
                for (int bj = 0; bj < 2; ++bj) xo[m][bj] = *(const u32x4*)(xb + (size_t)(row0 + ai * 128 + m * 16) * DM + col0 + bj * 128);
#pragma unroll
            for (int m = 0; m < 4; ++m) {
                const int row = row0 + ai * 128 + m * 16; float ss = 0.f;
#pragma unroll
                for (int bj = 0; bj < 2; ++bj) {
                    const size_t idx = (size_t)row * DM + col0 + bj * 128;
                    const u32x4 xw = xo[m][bj];
                    const f32x4 xo0 = {bflo(xw.x), bfhi(xw.x), bflo(xw.y), bfhi(xw.y)}, xo1 = {bflo(xw.z), bfhi(xw.z), bflo(xw.w), bfhi(xw.w)};
                    const f32x4 x0 = xo0 + acc[ai][bj][m][0] * alpha, x1 = xo1 + acc[ai][bj][m][1] * alpha;
                    u32x4 w; w.x = cvt_pk_bf16(x0[0], x0[1]); w.y = cvt_pk_bf16(x0[2], x0[3]); w.z = cvt_pk_bf16(x1[0], x1[1]); w.w = cvt_pk_bf16(x1[2], x1[3]); *(u32x4*)(xb + idx) = w;
                    ss += x0[0] * x0[0] + x0[1] * x0[1] + x0[2] * x0[2] + x0[3] * x0[3] + x1[0] * x1[0] + x1[1] * x1[1] + x1[2] * x1[2] + x1[3] * x1[3];
                }
                ss = quad_sum(ss);
                if (fq == 0) ssx[(size_t)row * 16 + u.pn * 4 + wc] = ss;
            }
        }
    }
};
struct EpiWin {
    static constexpr bool PERM = false;
    unsigned char* ws;
    __device__ __forceinline__ void operator()(const AccT& acc, const Unit& u, int wr, int wc, int fr, int fq) const {
        const float* ssx = (const float*)(ws + OFF_SSX); bf16_t* hyt = (bf16_t*)(ws + T_HYT); bf16_t* cqb = (bf16_t*)(ws + T_CQB); bf16_t* ckvb = (bf16_t*)(ws + T_CKVB);
        float* sscq = (float*)(ws + T_SSCQ); float* ssckv = (float*)(ws + T_SSCKV); bf16_t* kr = (bf16_t*)(ws + T_KR); bf16_t* gin = (bf16_t*)(ws + T_GIN); float* gg = (float*)(ws + T_GG); const float* rope = (const float*)(ws + OFF_ROPE);
        const int row0 = u.pm * 256 + wr * 64 + fr, pn = u.pn;
        if (pn < 3) {
#pragma unroll
            for (int ai = 0; ai < 2; ++ai)
#pragma unroll
                for (int m = 0; m < 4; ++m) {
                    const int row = row0 + ai * 128 + m * 16; const float rs = rstd16q(ssx, row, fq);
#pragma unroll
                    for (int bj = 0; bj < 2; ++bj)
#pragma unroll
                        for (int n = 0; n < 2; ++n)
#pragma unroll
                            for (int j = 0; j < 4; ++j) { const int col = pn * 256 + bj * 128 + wc * 32 + n * 16 + 4 * fq + j; hyt[(size_t)col * NTOK + row] = f2bf(acc[ai][bj][m][n][j] * rs); }
                }
        } else if (pn == 3 || pn == 4) {
            bf16_t* dst = pn == 3 ? cqb : ckvb; float* sdst = pn == 3 ? sscq : ssckv;
#pragma unroll
            for (int ai = 0; ai < 2; ++ai)
#pragma unroll
                for (int m = 0; m < 4; ++m) {
                    const int row = row0 + ai * 128 + m * 16; const float rs = rstd16q(ssx, row, fq);
                    float ss = 0.f;
#pragma unroll
                    for (int bj = 0; bj < 2; ++bj)
#pragma unroll
                        for (int n = 0; n < 2; ++n) {
                            const f32x4 v = acc[ai][bj][m][n] * rs; const float q = v[0] * v[0] + v[1] * v[1] + v[2] * v[2] + v[3] * v[3];
                            if (bj == 0 || pn == 3) ss += q;
                            u32x2 w; w.x = cvt_pk_bf16(v[0], v[1]); w.y = cvt_pk_bf16(v[2], v[3]);
                            *(u32x2*)(dst + (size_t)row * 256 + bj * 128 + wc * 32 + n * 16 + 4 * fq) = w;
                        }
                    ss = quad_sum(ss);
                    if (fq == 0) sdst[(size_t)row * 4 + wc] = ss;
                    if (pn == 4) {
                        if (wc < 2) {
                            const int s0 = 16 * wc + 4 * fq; const float* rp = rope + (size_t)(row & (SEQ - 1)) * 64 + s0;
                            const f32x4 cs = *(const f32x4*)rp, sn = *(const f32x4*)(rp + 32);
                            const f32x4 a = acc[ai][1][m][0] * rs, b = acc[ai][1][m][1] * rs;
                            const f32x4 oa = a * cs - b * sn, ob = a * sn + b * cs;
                            u32x2 w; w.x = cvt_pk_bf16(oa[0], oa[1]); w.y = cvt_pk_bf16(oa[2], oa[3]); *(u32x2*)(kr + (size_t)row * 64 + s0) = w;
                            w.x = cvt_pk_bf16(ob[0], ob[1]); w.y = cvt_pk_bf16(ob[2], ob[3]); *(u32x2*)(kr + (size_t)row * 64 + s0 + 32) = w;
                        } else {
#pragma unroll
                            for (int n = 0; n < 2; ++n) {
                                const f32x4 v = acc[ai][1][m][n] * rs; u32x2 w; w.x = cvt_pk_bf16(v[0], v[1]); w.y = cvt_pk_bf16(v[2], v[3]);
                                *(u32x2*)(gin + (size_t)row * 832 + (1152 + wc * 32 + n * 16 + 4 * fq - 1216)) = w;
                            }
                        }
                    }
                }
        } else {
#pragma unroll
            for (int ai = 0; ai < 2; ++ai)
#pragma unroll
                for (int m = 0; m < 4; ++m) {
                    const int row = row0 + ai * 128 + m * 16; const float rs = rstd16q(ssx, row, fq);
#pragma unroll
                    for (int bj = 0; bj < 2; ++bj)
#pragma unroll
                        for (int n = 0; n < 2; ++n) {
                            const f32x4 v = acc[ai][bj][m][n] * rs; const int col = pn * 256 + bj * 128 + wc * 32 + n * 16 + 4 * fq;
                            if (pn == 6 && bj == 1 && wc == 2) *(f32x4*)(gg + (size_t)row * 32 + n * 16 + 4 * fq) = v;
                            u32x2 w; w.x = cvt_pk_bf16(v[0], v[1]); w.y = cvt_pk_bf16(v[2], v[3]);
                            *(u32x2*)(gin + (size_t)row * 832 + (col - 1216)) = w;
                        }
                }
        }
    }
};
struct EpiUq {
    static constexpr bool PERM = false;
    unsigned char* ws;
    __device__ __forceinline__ void operator()(const AccT& acc, const Unit& u, int wr, int wc, int fr, int fq) const {
        const float* sscq = (const float*)(ws + T_SSCQ); bf16_t* qn = (bf16_t*)(ws + T_QN); bf16_t* qr = (bf16_t*)(ws + T_QR); const float* rope = (const float*)(ws + OFF_ROPE);
        const int row0 = u.pm * 256 + wr * 64 + fr, pn = u.pn;
        if (pn < 2) {
#pragma unroll
            for (int ai = 0; ai < 2; ++ai)
#pragma unroll
                for (int m = 0; m < 4; ++m) {
                    const int row = row0 + ai * 128 + m * 16; const float rs = rstd4(sscq, row, 1.0f / 256.0f);
                    const int b = row >> 13, s = row & (SEQ - 1);
#pragma unroll
                    for (int bj = 0; bj < 2; ++bj) { const int h = 2 * pn + bj; bf16_t* rp = qn + ((size_t)(b * 4 + h) * SEQ + s) * 128 + wc * 32 + 4 * fq;
#pragma unroll
                        for (int n = 0; n < 2; ++n) { const f32x4 v = acc[ai][bj][m][n] * rs; u32x2 w; w.x = cvt_pk_bf16(v[0], v[1]); w.y = cvt_pk_bf16(v[2], v[3]); *(u32x2*)(rp + n * 16) = w; } }
                }
        } else {
            const int s0 = 16 * (wc & 1) + 4 * fq;
#pragma unroll
            for (int ai = 0; ai < 2; ++ai)
#pragma unroll
                for (int m = 0; m < 4; ++m) {
                    const int row = row0 + ai * 128 + m * 16; const float rs = rstd4(sscq, row, 1.0f / 256.0f);
                    const int b = row >> 13, s = row & (SEQ - 1);
                    const float* rt = rope + (size_t)s * 64 + s0; const f32x4 cs = *(const f32x4*)rt, sn = *(const f32x4*)(rt + 32);
#pragma unroll
                    for (int bj = 0; bj < 2; ++bj) { const int h = 2 * bj + (wc >> 1); bf16_t* rp = qr + ((size_t)(b * 4 + h) * SEQ + s) * 64 + s0;
                        const f32x4 a = acc[ai][bj][m][0] * rs, bb = acc[ai][bj][m][1] * rs;
                        const f32x4 oa = a * cs - bb * sn, ob = a * sn + bb * cs;
                        u32x2 w; w.x = cvt_pk_bf16(oa[0], oa[1]); w.y = cvt_pk_bf16(oa[2], oa[3]); *(u32x2*)rp = w;
                        w.x = cvt_pk_bf16(ob[0], ob[1]); w.y = cvt_pk_bf16(ob[2], ob[3]); *(u32x2*)(rp + 32) = w; }
                }
        }
    }
};
struct EpiUkv {
    static constexpr bool PERM = false;
    unsigned char* ws;
    __device__ __forceinline__ void operator()(const AccT& acc, const Unit& u, int wr, int wc, int fr, int fq) const {
        const float* ssckv = (const float*)(ws + T_SSCKV); bf16_t* kn = (bf16_t*)(ws + T_KN); bf16_t* vv = (bf16_t*)(ws + T_V);
        const int row0 = u.pm * 256 + wr * 64 + fr, h = u.pn;
#pragma unroll
        for (int ai = 0; ai < 2; ++ai)
#pragma unroll
            for (int m = 0; m < 4; ++m) {
                const int row = row0 + ai * 128 + m * 16; const float rs = rstd4(ssckv, row, 1.0f / 128.0f);
                const int b = row >> 13, s = row & (SEQ - 1); const size_t base = ((size_t)(b * 4 + h) * SEQ + s) * 128 + wc * 32 + 4 * fq;
#pragma unroll
                for (int bj = 0; bj < 2; ++bj) { bf16_t* rp = (bj == 0 ? kn : vv) + base;
#pragma unroll
                    for (int n = 0; n < 2; ++n) { const f32x4 v = acc[ai][bj][m][n] * rs; u32x2 w; w.x = cvt_pk_bf16(v[0], v[1]); w.y = cvt_pk_bf16(v[2], v[3]); *(u32x2*)(rp + n * 16) = w; } }
            }
    }
};

__device__ __forceinline__ int map_col(int type, int nd, int& which) {
    which = 0;
    if (type == 1) { const int t = nd >> 8, r = nd & 255; which = r >> 7; return t * 128 + (r & 127); }
    if (type == 2) { if (nd >= 2016) return -1; if (nd >= 1152 && nd < 1216) { const int P = nd - 1152, w = P >> 5, n = (P >> 4) & 1, i = P & 15; return 1152 + 16 * w + i + 32 * n; } return nd; }
    if (type == 3) { if (nd < 512) { const int h = nd >> 7, d = nd & 127; return h * 192 + d; } const int Pp = nd - 512, h = Pp >> 6, P = Pp & 63; const int s = 16 * (P >> 5) + (P & 15) + 32 * ((P >> 4) & 1); return h * 192 + 128 + s; }
    return nd;
}
struct PrepJob { const float* src; const float* src2; const float* gain; bf16_t* dst; int Ks, Kd, Nsrc, Nd, type; };
__device__ __forceinline__ PrepJob prep_job(KP p, unsigned char* ws, int j) {
    const int l = j >> 3;
    switch (j & 7) {
        case 0: return PrepJob{p->in[2] + (size_t)l * DM * FF, p->in[3] + (size_t)l * DM * FF, p->in[1] + l * DM, (bf16_t*)(ws + OFF_WUP + (l * 2 + 0) * SZ_WUP), 1024, 1024, FF, 5632, 1};
        case 1: return PrepJob{p->in[30] + (size_t)l * DM * FF, p->in[31] + (size_t)l * DM * FF, p->in[29] + l * DM, (bf16_t*)(ws + OFF_WUP + (l * 2 + 1) * SZ_WUP), 1024, 1024, FF, 5632, 1};
        case 2: return PrepJob{p->in[4] + (size_t)l * FF * DM, nullptr, nullptr, (bf16_t*)(ws + OFF_WDN + (l * 2 + 0) * SZ_WDN), FF, FF, DM, DM, 0};
        case 3: return PrepJob{p->in[32] + (size_t)l * FF * DM, nullptr, nullptr, (bf16_t*)(ws + OFF_WDN + (l * 2 + 1) * SZ_WDN), FF, FF, DM, DM, 0};
        case 4: return PrepJob{p->in[6] + (size_t)l * DM * 2016, nullptr, p->in[5] + l * DM, (bf16_t*)(ws + OFF_WIN + l * SZ_WIN), 1024, 1024, 2016, 2048, 2};
        case 5: return PrepJob{p->in[28] + (size_t)l * DM * DM, nullptr, nullptr, (bf16_t*)(ws + OFF_WOUT + l * SZ_WOUT), 1024, 1024, 1024, 1024, 0};
        case 6: return PrepJob{p->in[19] + (size_t)l * 256 * 768, nullptr, p->in[18] + l * 256, (bf16_t*)(ws + OFF_WUQ + l * SZ_WUQ), 256, 256, 768, 768, 3};
        default: return PrepJob{p->in[21] + (size_t)l * 128 * 1024, nullptr, p->in[20] + l * 128, (bf16_t*)(ws + OFF_WUKV + l * SZ_WUKV), 128, 256, 1024, 1024, 0};
    }
}
__device__ __forceinline__ int prep_job_tiles(int j) { const int k = j & 7; return k < 2 ? 352 : k < 4 ? 176 : k == 4 ? 128 : k == 5 ? 64 : k == 6 ? 12 : 16; }
__device__ __forceinline__ void phase_prep(KP p, float* lds) {
    unsigned char* ws = opaque_ptr(p->ws); const int tid = opaque_tid(), wid = tid >> 6, lane = tid & 63;
    { float* tile = lds; constexpr int TOTAL = 2 * (352 * 2 + 176 * 2 + 128 + 64 + 12 + 16);
      float v[32]; bf16_t* dstp = nullptr; int Kd_c = 0, nd0_c = 0, k0_c = 0;
#define PREP_ISSUE(TT) do { int j_ = 0, t_ = (TT); \
          while (t_ >= prep_job_tiles(j_)) { t_ -= prep_job_tiles(j_); ++j_; } \
          const PrepJob J = prep_job(p, ws, j_); \
          const int ntk_ = J.Kd / 256, nd0_ = (t_ / ntk_) * 64, k0_ = (t_ % ntk_) * 256; \
          const int nn_ = tid & 63, kk_ = tid >> 6; int which_; const int ns_ = map_col(J.type, nd0_ + nn_, which_); const float* sp_ = which_ ? J.src2 : J.src; \
          _Pragma("unroll") for (int sub = 0; sub < 4; ++sub) _Pragma("unroll") for (int r = 0; r < 8; ++r) { const int k_ = k0_ + sub * 64 + kk_ + 8 * r; float x_ = 0.f; \
              if (ns_ >= 0 && k_ < J.Ks) { x_ = sp_[(size_t)k_ * J.Nsrc + ns_]; if (J.gain) x_ *= J.gain[k_]; } v[sub * 8 + r] = x_; } \
          dstp = J.dst; Kd_c = J.Kd; nd0_c = nd0_; k0_c = k0_; } while (0)
      int tt = opaque_bid();
      PREP_ISSUE(tt < TOTAL ? tt : TOTAL - 1);
      for (; tt < TOTAL; tt += gridDim.x) {
          { const int nn = tid & 63, kk = tid >> 6;
#pragma unroll
            for (int sub = 0; sub < 4; ++sub)
#pragma unroll
                for (int r = 0; r < 8; ++r) tile[sub * (64 * 65) + nn * 65 + kk + 8 * r] = v[sub * 8 + r]; }
          bf16_t* dcur = dstp; const int Kd = Kd_c, nd0 = nd0_c, k0 = k0_c;
          PREP_ISSUE(tt + (int)gridDim.x < TOTAL ? tt + (int)gridDim.x : TOTAL - 1);
          __syncthreads();
          { const int row = tid >> 3, kc = (tid & 7) * 8;
#pragma unroll
            for (int sub = 0; sub < 4; ++sub) { const float* tp = tile + sub * (64 * 65) + row * 65 + kc;
              u32x4 w; w.x = cvt_pk_bf16(tp[0], tp[1]); w.y = cvt_pk_bf16(tp[2], tp[3]); w.z = cvt_pk_bf16(tp[4], tp[5]); w.w = cvt_pk_bf16(tp[6], tp[7]);
              *(u32x4*)(dcur + (size_t)(nd0 + row) * Kd + k0 + sub * 64 + kc) = w; } }
          __syncthreads();
      } }
    { const float* x = p->in[0]; bf16_t* xb = (bf16_t*)(ws + OFF_XB); float* ssx = (float*)(ws + OFF_SSX);
      for (int rb = (opaque_bid() * 8 + wid) * 4; rb < NTOK; rb += gridDim.x * 32) {
          f32x4 v[4][4];
#pragma unroll
          for (int q = 0; q < 4; ++q)
#pragma unroll
              for (int i = 0; i < 4; ++i) v[q][i] = *(const f32x4*)(x + (size_t)(rb + q) * DM + lane * 16 + 4 * i);
#pragma unroll
          for (int q = 0; q < 4; ++q) { const int row = rb + q; float ss = 0.f;
#pragma unroll
              for (int i = 0; i < 4; ++i) ss += v[q][i][0] * v[q][i][0] + v[q][i][1] * v[q][i][1] + v[q][i][2] * v[q][i][2] + v[q][i][3] * v[q][i][3];
              u32x4 w0, w1; w0.x = cvt_pk_bf16(v[q][0][0], v[q][0][1]); w0.y = cvt_pk_bf16(v[q][0][2], v[q][0][3]); w0.z = cvt_pk_bf16(v[q][1][0], v[q][1][1]); w0.w = cvt_pk_bf16(v[q][1][2], v[q][1][3]);
              w1.x = cvt_pk_bf16(v[q][2][0], v[q][2][1]); w1.y = cvt_pk_bf16(v[q][2][2], v[q][2][3]); w1.z = cvt_pk_bf16(v[q][3][0], v[q][3][1]); w1.w = cvt_pk_bf16(v[q][3][2], v[q][3][3]);
              *(u32x4*)(xb + (size_t)row * DM + lane * 16) = w0; *(u32x4*)(xb + (size_t)row * DM + lane * 16 + 8) = w1;
              ss += __shfl_xor(ss, 1); ss += __shfl_xor(ss, 2);
              if ((lane & 3) == 0) ssx[(size_t)row * 16 + (lane >> 2)] = ss; }
      } }
    { float* rt = (float*)(ws + OFF_ROPE);
      for (int i = opaque_bid() * NTHR + tid; i < 8192 * 32; i += gridDim.x * NTHR) {
          const int pos = i >> 5, sx = i & 31; const float inv = __builtin_amdgcn_exp2f(-(float)sx * (13.287712379549449f / 32.0f));
          float rev = (float)pos * inv * 0.15915494309189535f; rev -= floorf(rev);
          rt[pos * 64 + sx] = cos_rev(rev); rt[pos * 64 + 32 + sx] = sin_rev(rev);
      } }
    { float* h2t = (float*)(ws + OFF_H2T); float* zs = lds; float* h1s = lds + 8 * 40;
      const int pp = tid >> 6, j = tid & 63;
      for (int l = 0; l < 2; ++l) {
          const float* w1 = p->in[9] + l * 33 * 64; const float* w2 = p->in[12] + l * 64 * 64;
          float w1c[33], w2c[64];
#pragma unroll
          for (int i = 0; i < 33; ++i) w1c[i] = w1[i * 64 + j];
#pragma unroll
          for (int i = 0; i < 64; ++i) w2c[i] = w2[i * 64 + j];
          const float b1 = p->in[10][l * 64 + j], f1 = p->in[11][l * 64 + j], b2 = p->in[13][l * 64 + j], f2 = p->in[14][l * 64 + j];
          for (int it = opaque_bid(); it < 1024; it += gridDim.x) {
              const int m0 = it * 8;
              __syncthreads();
              if (j < 33) { const int m = m0 + pp; float z;
                  if (j == 0) z = (float)m * (1.0f / 8191.0f);
                  else { const int bi = (j - 1) & 15; const float band = 1e-4f + (float)bi * ((15.0f - 1e-4f) / 15.0f); float rev = (float)m * band * (1.0f / 8192.0f); rev -= floorf(rev);
                         z = (j <= 16) ? cos_rev(rev) : -sin_rev(rev); }
                  zs[pp * 40 + j] = z; }
              __syncthreads();
              float a = b1;
#pragma unroll
              for (int i = 0; i < 33; ++i) a += zs[pp * 40 + i] * w1c[i];
              h1s[pp * 64 + j] = fast_sin(f1 * a);
              __syncthreads();
              float c = b2;
#pragma unroll
              for (int i = 0; i < 64; ++i) c += h1s[pp * 64 + i] * w2c[i];
              h2t[((size_t)l * 64 + j) * 8192 + m0 + pp] = fast_sin(f2 * c);
          }
      } }
}

namespace att {
constexpr float SCALE = 0.07216878364870322f;
constexpr float THR = 8.f;
constexpr int SHM_V = 64 * 128 * 2, SHM_K = 64 * 128 * 2, SHM_KR = 64 * 64 * 2;
constexpr int OFF_K = 2 * SHM_V, OFF_KR = OFF_K + 2 * SHM_K, OFF_QR = OFF_KR + 2 * SHM_KR, OFF_WS = OFF_QR + 8 * 8192, SHM_TOTAL = OFF_WS + 8 * 64 * 4;
static_assert(SHM_TOTAL <= LDS_BYTES, "attention LDS");
#define KSWZ(row, colB) ((row) * 256 + ((colB) ^ (((row) & 7) << 4)))
#define KRSWZ(row, chunk) ((row) * 128 + ((((chunk) ^ (((row) >> 1) & 7))) << 4))
#define SBAR() __builtin_amdgcn_sched_barrier(0)
__device__ __forceinline__ int crow(int r, int hi) { return (r & 3) + 8 * (r >> 2) + 4 * hi; }
__device__ __forceinline__ void partialSM(f32x16& p0, f32x16& p1, float& m_reg, float& mn, float& alpha) {
    constexpr float C = SCALE * 1.4426950408889634f;
    float pmax = p0[0];
#pragma unroll
    for (int r = 1; r < 16; ++r) pmax = fmaxf(pmax, p0[r]);
#pragma unroll
    for (int r = 0; r < 16; ++r) pmax = fmaxf(pmax, p1[r]);
    { auto rr = __builtin_amdgcn_permlane32_swap(__float_as_uint(pmax), __float_as_uint(pmax), false, false); pmax = fmaxf(__uint_as_float(rr[0]), __uint_as_float(rr[1])); }
    if (__builtin_expect(__all(pmax - m_reg <= THR / SCALE), 1)) { mn = m_reg; alpha = 1.f; }
    else { mn = fmaxf(m_reg, pmax); alpha = __builtin_amdgcn_exp2f((m_reg - mn) * C); m_reg = mn; }
    const float mnC = -mn * C;
#pragma unroll
    for (int r = 0; r < 16; ++r) p0[r] = fmaf(p0[r], C, mnC);
#pragma unroll
    for (int r = 0; r < 16; ++r) p1[r] = fmaf(p1[r], C, mnC);
#pragma unroll
    for (int r = 0; r < 16; ++r) p0[r] = __builtin_amdgcn_exp2f(p0[r]);
}
__device__ __forceinline__ void finishSM(f32x16& p0, f32x16& p1, float alpha, float& l_reg, bf16x8& pa0, bf16x8& pa1, bf16x8& pa2, bf16x8& pa3) {
#pragma unroll
    for (int r = 0; r < 16; ++r) p1[r] = __builtin_amdgcn_exp2f(p1[r]);
    float ps = 0;
#pragma unroll
    for (int r = 0; r < 16; ++r) ps += p0[r];
#pragma unroll
    for (int r = 0; r < 16; ++r) ps += p1[r];
    { auto rr = __builtin_amdgcn_permlane32_swap(__float_as_uint(ps), __float_as_uint(ps), false, false); ps = __uint_as_float(rr[0]) + __uint_as_float(rr[1]); }
    l_reg = l_reg * alpha + ps;
#define PK4(P, BASE, OUT) do { unsigned a0 = cvt_pk_bf16(P[BASE + 0], P[BASE + 1]), a1 = cvt_pk_bf16(P[BASE + 2], P[BASE + 3]);   \
    unsigned b0 = cvt_pk_bf16(P[BASE + 4], P[BASE + 5]), b1 = cvt_pk_bf16(P[BASE + 6], P[BASE + 7]);                              \
    auto r0 = __builtin_amdgcn_permlane32_swap(a0, b0, false, false); auto r1 = __builtin_amdgcn_permlane32_swap(a1, b1, false, false); \
    u32x4 w = {r0[0], r1[0], r0[1], r1[1]}; OUT = *reinterpret_cast<bf16x8*>(&w); } while (0)
    PK4(p0, 0, pa0); PK4(p0, 8, pa1); PK4(p1, 0, pa2); PK4(p1, 8, pa3);
#undef PK4
}
__device__ __forceinline__ void qkt(f32x16& p0, f32x16& p1, const char* Ks, const char* Krs, const bf16x8* qr, const char* qrl, int r32, int hi) {
    p0 = f32x16{}; p1 = f32x16{};
#pragma unroll
    for (int d0 = 0; d0 < 8; ++d0) { const int cb = (d0 * 16 + hi * 8) * 2;
        const bf16x8 b0 = *reinterpret_cast<const bf16x8*>(Ks + KSWZ(r32, cb));
        const bf16x8 b1 = *reinterpret_cast<const bf16x8*>(Ks + KSWZ(32 + r32, cb));
        const bf16x8 q = d0 < 4 ? qr[d0 & 3] : *reinterpret_cast<const bf16x8*>(qrl + d0 * 1024);
        p0 = __builtin_amdgcn_mfma_f32_32x32x16_bf16(b0, q, p0, 0, 0, 0);
        p1 = __builtin_amdgcn_mfma_f32_32x32x16_bf16(b1, q, p1, 0, 0, 0); }
#pragma unroll
    for (int d0 = 0; d0 < 4; ++d0) { const int ch = d0 * 2 + hi;
        const bf16x8 b0 = *reinterpret_cast<const bf16x8*>(Krs + KRSWZ(r32, ch));
        const bf16x8 b1 = *reinterpret_cast<const bf16x8*>(Krs + KRSWZ(32 + r32, ch));
        const bf16x8 q = *reinterpret_cast<const bf16x8*>(qrl + d0 * 1024);
        p0 = __builtin_amdgcn_mfma_f32_32x32x16_bf16(b0, q, p0, 0, 0, 0);
        p1 = __builtin_amdgcn_mfma_f32_32x32x16_bf16(b1, q, p1, 0, 0, 0); }
}
__device__ __forceinline__ int v_st(int k, int c) { const int kk = (k & ~0xC) | ((k & 4) << 1) | ((k & 8) >> 1); return ((kk >> 3) * 4 + (c >> 5)) * 512 + ((kk & 7) * 32 + (c & 31)) * 2; }
__device__ __forceinline__ int v_rd_base(int lane) { return ((lane & 3) << 3) | (((lane >> 2) & 3) << 6) | (((lane >> 4) & 1) << 5) | (((lane >> 5) & 1) << 8); }
constexpr int v_rd_off(int d0, int ks, int half) { return d0 * 512 + ks * 4096 + half * 2048; }
template <int OFF> __device__ __forceinline__ s16x4 tr_read(int vb) { s16x4 r; asm volatile("ds_read_b64_tr_b16 %0, %1 offset:%2" : "=&v"(r) : "v"(vb), "i"(OFF) : "memory"); return r; }
template <int D0> __device__ __forceinline__ void pv_one(f32x16& od, int vb, bf16x8 pa0, bf16x8 pa1, bf16x8 pa2, bf16x8 pa3) {
    const s16x4 l0 = tr_read<v_rd_off(D0, 0, 0)>(vb), h0 = tr_read<v_rd_off(D0, 0, 1)>(vb), l1 = tr_read<v_rd_off(D0, 1, 0)>(vb), h1 = tr_read<v_rd_off(D0, 1, 1)>(vb);
    const s16x4 l2 = tr_read<v_rd_off(D0, 2, 0)>(vb), h2 = tr_read<v_rd_off(D0, 2, 1)>(vb), l3 = tr_read<v_rd_off(D0, 3, 0)>(vb), h3 = tr_read<v_rd_off(D0, 3, 1)>(vb);
    asm volatile("s_waitcnt lgkmcnt(0)" ::: "memory"); SBAR();
#define PK(L, H) (bf16x8){L[0], L[1], L[2], L[3], H[0], H[1], H[2], H[3]}
    od = __builtin_amdgcn_mfma_f32_32x32x16_bf16(pa0, PK(l0, h0), od, 0, 0, 0);
    od = __builtin_amdgcn_mfma_f32_32x32x16_bf16(pa1, PK(l1, h1), od, 0, 0, 0);
    od = __builtin_amdgcn_mfma_f32_32x32x16_bf16(pa2, PK(l2, h2), od, 0, 0, 0);
    od = __builtin_amdgcn_mfma_f32_32x32x16_bf16(pa3, PK(l3, h3), od, 0, 0, 0);
#undef PK
}
__device__ __forceinline__ void pv_d0(f32x16* o, int vb, bf16x8 pa0, bf16x8 pa1, bf16x8 pa2, bf16x8 pa3) {
    pv_one<0>(o[0], vb, pa0, pa1, pa2, pa3); pv_one<1>(o[1], vb, pa0, pa1, pa2, pa3); pv_one<2>(o[2], vb, pa0, pa1, pa2, pa3); pv_one<3>(o[3], vb, pa0, pa1, pa2, pa3);
}
__device__ __forceinline__ void attn_body(const bf16_t* __restrict__ Qb, const bf16_t* __restrict__ QRb, const bf16_t* __restrict__ Kh, const bf16_t* __restrict__ Krh,
                                          const bf16_t* __restrict__ Vh, bf16_t* __restrict__ Ob, int seq, char* lds) {
    const int tid = opaque_tid(), wid = tid >> 6, lane = tid & 63, r32 = lane & 31, hi = lane >> 5;
    char* V_lds = lds; char* K_lds = lds + OFF_K; char* Kr_lds = lds + OFF_KR; char* qrl = lds + OFF_QR + wid * 8192 + lane * 16;
    float* wsf = (float*)(lds + OFF_WS) + wid * 64; float* li_l = wsf; float* al_l = wsf + 32;
    float m_reg = -1e30f, l_reg = 0; f32x16 o[4] = {}; bf16x8 qr[4];
    __syncthreads();
    { const bf16_t* Qw = Qb + (long)(wid * 32 + r32) * 128 + hi * 8;
#pragma unroll
      for (int d0 = 0; d0 < 4; ++d0) qr[d0] = *reinterpret_cast<const bf16x8*>(Qw + d0 * 16);
#pragma unroll
      for (int d0 = 4; d0 < 8; ++d0) *reinterpret_cast<bf16x8*>(qrl + d0 * 1024) = *reinterpret_cast<const bf16x8*>(Qw + d0 * 16);
      const bf16_t* QRw = QRb + (long)(wid * 32 + r32) * 64 + hi * 8;
#pragma unroll
      for (int d0 = 0; d0 < 4; ++d0) *reinterpret_cast<bf16x8*>(qrl + d0 * 1024) = *reinterpret_cast<const bf16x8*>(QRw + d0 * 16); }
    const int sr = tid >> 4, sc = (tid & 15) * 8, vst0 = v_st(sr, sc), vst1 = v_st(32 + sr, sc);
    const int krr = tid >> 3, krc = tid & 7, krst = KRSWZ(krr, krc);
    const int vb0 = (int)(uintptr_t)V_lds + v_rd_base(lane);
    struct { bf16x8 vs0, vs1, ks0, ks1, kr; } sr_[1];
#define SLOAD(i, k0) do { sr_[i].vs0 = *reinterpret_cast<const bf16x8*>(&Vh[(long)((k0) + sr) * 128 + sc]); sr_[i].vs1 = *reinterpret_cast<const bf16x8*>(&Vh[(long)((k0) + 32 + sr) * 128 + sc]); \
    sr_[i].ks0 = *reinterpret_cast<const bf16x8*>(&Kh[(long)((k0) + sr) * 128 + sc]); sr_[i].ks1 = *reinterpret_cast<const bf16x8*>(&Kh[(long)((k0) + 32 + sr) * 128 + sc]); \
    sr_[i].kr = *reinterpret_cast<const bf16x8*>(&Krh[(long)((k0) + krr) * 64 + krc * 8]); } while (0)
#define SWRITE(b, i) do { *(bf16x8*)(V_lds + (b) * SHM_V + vst0) = sr_[i].vs0; *(bf16x8*)(V_lds + (b) * SHM_V + vst1) = sr_[i].vs1; const int kc = sc * 2; \
    *(bf16x8*)(K_lds + (b) * SHM_K + KSWZ(sr, kc)) = sr_[i].ks0; *(bf16x8*)(K_lds + (b) * SHM_K + KSWZ(32 + sr, kc)) = sr_[i].ks1; \
    *(bf16x8*)(Kr_lds + (b) * SHM_KR + krst) = sr_[i].kr; } while (0)
#define SWAIT() asm volatile("s_waitcnt vmcnt(0)" ::: "memory")
#define RESC(a) do { if (__any((a) < 1.f)) { if (hi == 0) al_l[r32] = (a); asm volatile("s_waitcnt lgkmcnt(0)" ::: "memory"); \
    _Pragma("unroll") for (int d = 0; d < 4; ++d) _Pragma("unroll") for (int r = 0; r < 16; ++r) o[d][r] *= al_l[crow(r, hi)]; } } while (0)
    f32x16 pA0, pA1, pB0, pB1; float mnA, mnB, alA, alB; bf16x8 pa0, pa1, pa2, pa3; const int NT = seq / 64;
    constexpr int SE = 0, SO = 0;
    SLOAD(SE, 0); asm volatile("s_waitcnt vmcnt(0)" ::: "memory"); SWRITE(0, SE); __syncthreads();
    qkt(pA0, pA1, K_lds, Kr_lds, qr, qrl, r32, hi); partialSM(pA0, pA1, m_reg, mnA, alA);
    SLOAD(SO, 64);
    SWAIT(); SWRITE(1, SO); __syncthreads();
    for (int j = 1; j + 1 < NT; j += 2) {
        SBAR(); qkt(pB0, pB1, K_lds + SHM_K, Kr_lds + SHM_KR, qr, qrl, r32, hi);
        finishSM(pA0, pA1, alA, l_reg, pa0, pa1, pa2, pa3); SBAR();
        SLOAD(SO, (j + 1) * 64); SBAR();
        pv_d0(o, vb0, pa0, pa1, pa2, pa3); partialSM(pB0, pB1, m_reg, mnB, alB);
        __syncthreads(); SWAIT(); SWRITE(0, SE);
        RESC(alB); __syncthreads();
        SBAR(); qkt(pA0, pA1, K_lds, Kr_lds, qr, qrl, r32, hi);
        finishSM(pB0, pB1, alB, l_reg, pa0, pa1, pa2, pa3); SBAR();
        SLOAD(SE, (j + 2) * 64); SBAR();
        pv_d0(o, vb0 + SHM_V, pa0, pa1, pa2, pa3); partialSM(pA0, pA1, m_reg, mnA, alA);
        __syncthreads(); SWAIT(); SWRITE(1, SO);
        RESC(alA); __syncthreads();
    }
    SBAR(); qkt(pB0, pB1, K_lds + SHM_K, Kr_lds + SHM_KR, qr, qrl, r32, hi);
    finishSM(pA0, pA1, alA, l_reg, pa0, pa1, pa2, pa3); SBAR();
    pv_d0(o, vb0, pa0, pa1, pa2, pa3); partialSM(pB0, pB1, m_reg, mnB, alB);
    __syncthreads(); RESC(alB);
    finishSM(pB0, pB1, alB, l_reg, pa0, pa1, pa2, pa3); SBAR();
    pv_d0(o, vb0 + SHM_V, pa0, pa1, pa2, pa3);
    if (hi == 0) li_l[r32] = l_reg; asm volatile("s_waitcnt lgkmcnt(0)" ::: "memory");
    float rli[16];
#pragma unroll
    for (int r = 0; r < 16; ++r) rli[r] = __builtin_amdgcn_rcpf(li_l[crow(r, hi)]);
    bf16_t* Ow = Ob + (long)(wid * 32) * 512;
#pragma unroll
    for (int r = 0; r < 16; ++r) { const int orow = crow(r, hi);
#pragma unroll
        for (int d0 = 0; d0 < 4; ++d0) Ow[(long)orow * 512 + d0 * 32 + r32] = f2bf(o[d0][r] * rli[r]); }
#undef SLOAD
#undef SWRITE
#undef SWAIT
#undef RESC
}
}

__device__ __forceinline__ float2 cmul(float2 a, float2 b) { return make_float2(a.x * b.x - a.y * b.y, a.x * b.y + a.y * b.x); }
template <bool LAST = true, bool FIRST = true> __device__ __forceinline__ void fft_dif(float2* d) {
    const int tid = opaque_tid();
    for (int s = FIRST ? 0 : 1; s < 6; ++s) {
        const int lg = 12 - 2 * s, span = 1 << lg; const float rs = 1.0f / (float)(4 << lg);
#pragma unroll 4
        for (int i = 0; i < 8; ++i) {
            const int bf = tid + 512 * i, j = bf & (span - 1), g = bf >> lg, base = ((g << 2) << lg) + j;
            const float2 a0 = d[base], a1 = d[base + span], a2 = d[base + 2 * span], a3 = d[base + 3 * span];
            const float2 b0 = make_float2(a0.x + a2.x, a0.y + a2.y), b1 = make_float2(a0.x - a2.x, a0.y - a2.y), b2 = make_float2(a1.x + a3.x, a1.y + a3.y), b3 = make_float2(a1.x - a3.x, a1.y - a3.y);
            const float2 y0 = make_float2(b0.x + b2.x, b0.y + b2.y), y2 = make_float2(b0.x - b2.x, b0.y - b2.y);
            const float2 y1 = make_float2(b1.x + b3.y, b1.y - b3.x), y3 = make_float2(b1.x - b3.y, b1.y + b3.x);
            const float r = (float)j * rs;
            const float2 w1 = make_float2(cos_rev(r), -sin_rev(r)), w2 = make_float2(cos_rev(2.f * r), -sin_rev(2.f * r)), w3 = make_float2(cos_rev(3.f * r), -sin_rev(3.f * r));
            d[base] = y0; d[base + span] = cmul(y1, w1); d[base + 2 * span] = cmul(y2, w2); d[base + 3 * span] = cmul(y3, w3);
        }
        __syncthreads();
    }
    if (!LAST) return;
#pragma unroll 4
    for (int i = 0; i < 8; ++i) {
        f32x4* q = (f32x4*)(d + 4 * (tid + 512 * i));
        const f32x4 A = q[0], B = q[1];
        const float b0x = A[0] + B[0], b0y = A[1] + B[1], b1x = A[0] - B[0], b1y = A[1] - B[1], b2x = A[2] + B[2], b2y = A[3] + B[3], b3x = A[2] - B[2], b3y = A[3] - B[3];
        q[0] = (f32x4){b0x + b2x, b0y + b2y, b1x + b3y, b1y - b3x};
        q[1] = (f32x4){b0x - b2x, b0y - b2y, b1x - b3y, b1y + b3x};
    }
    __syncthreads();
}
template <bool FIRST = true, bool LASTS = true> __device__ __forceinline__ void fft_dit_inv(float2* d) {
    const int tid = opaque_tid();
    if (FIRST) {
#pragma unroll 4
    for (int i = 0; i < 8; ++i) {
        f32x4* q = (f32x4*)(d + 4 * (tid + 512 * i));
        const f32x4 A = q[0], B = q[1];
        const float c0x = A[0] + B[0], c0y = A[1] + B[1], c1x = A[0] - B[0], c1y = A[1] - B[1], c2x = A[2] + B[2], c2y = A[3] + B[3], c3x = A[2] - B[2], c3y = A[3] - B[3];
        q[0] = (f32x4){c0x + c2x, c0y + c2y, c1x - c3y, c1y + c3x};
        q[1] = (f32x4){c0x - c2x, c0y - c2y, c1x + c3y, c1y - c3x};
    }
    __syncthreads();
    }
    for (int s = 5; s >= (LASTS ? 0 : 1); --s) {
        const int lg = 12 - 2 * s, span = 1 << lg; const float rs = 1.0f / (float)(4 << lg);
#pragma unroll 4
        for (int i = 0; i < 8; ++i) {
            const int bf = tid + 512 * i, j = bf & (span - 1), g = bf >> lg, base = ((g << 2) << lg) + j;
            const float r = (float)j * rs;
            const float2 w1 = make_float2(cos_rev(r), sin_rev(r)), w2 = make_float2(cos_rev(2.f * r), sin_rev(2.f * r)), w3 = make_float2(cos_rev(3.f * r), sin_rev(3.f * r));
            const float2 y0 = d[base], y1 = cmul(d[base + span], w1), y2 = cmul(d[base + 2 * span], w2), y3 = cmul(d[base + 3 * span], w3);
            const float2 c0 = make_float2(y0.x + y2.x, y0.y + y2.y), c1 = make_float2(y0.x - y2.x, y0.y - y2.y), c2 = make_float2(y1.x + y3.x, y1.y + y3.y), c3 = make_float2(y1.x - y3.x, y1.y - y3.y);
            d[base] = make_float2(c0.x + c2.x, c0.y + c2.y); d[base + 2 * span] = make_float2(c0.x - c2.x, c0.y - c2.y);
            d[base + span] = make_float2(c1.x - c3.y, c1.y + c3.x); d[base + 3 * span] = make_float2(c1.x + c3.y, c1.y - c3.x);
        }
        __syncthreads();
    }
}
__device__ __forceinline__ float sconv(const bf16_t* p, int t, float w0, float w1, float w2, float bias) {
    const float a = t > 0 ? bf2f(p[t - 1]) : 0.f, b = bf2f(p[t]), c = t < SEQ - 1 ? bf2f(p[t + 1]) : 0.f;
    return bias + w0 * a + w1 * b + w2 * c;
}
__device__ __forceinline__ float2 sconv2(const bf16_t* p, int m, float w0, float w1, float w2, float bias) {
    const unsigned* pw = (const unsigned*)p;
    const unsigned wm = m > 0 ? pw[m - 1] : 0u, wc = pw[m], wp = m < SEQ / 2 - 1 ? pw[m + 1] : 0u;
    const float a = bfhi(wm), b = bflo(wc), c = bfhi(wc), d = bflo(wp);
    return make_float2(bias + w0 * a + w1 * b + w2 * c, bias + w0 * b + w1 * c + w2 * d);
}
__device__ __forceinline__ int rev4_14(int x) { const unsigned b = __brev((unsigned)x) >> 18; return (int)(((b & 0x1555u) << 1) | ((b >> 1) & 0x1555u)); }
__device__ __forceinline__ void hyena_filter(KP p, int l, int c, float2* data, float2* Kd, float delta) {
    const int tid = opaque_tid(); unsigned char* ws = opaque_ptr(p->ws);
    const float* h2t = (const float*)(ws + OFF_H2T) + (size_t)l * 64 * 8192; const float* w3 = p->in[15] + (size_t)l * 64 * 1024;
    const int m0 = tid * 16;
    f32x4 af0[4], ab0[4], af1[4], ab1[4];
#pragma unroll
    for (int q = 0; q < 4; ++q) { af0[q] = (f32x4){0.f, 0.f, 0.f, 0.f}; ab0[q] = af0[q]; af1[q] = af0[q]; ab1[q] = af0[q]; }
#pragma unroll 2
    for (int j = 0; j < 64; ++j) {
        const float wf0 = w3[j * 1024 + c], wb0 = w3[j * 1024 + 256 + c], wf1 = w3[j * 1024 + 512 + c], wb1 = w3[j * 1024 + 768 + c];
        const f32x4* hp = (const f32x4*)(h2t + j * 8192 + m0);
#pragma unroll
        for (int q = 0; q < 4; ++q) { const f32x4 h = hp[q]; af0[q] += h * wf0; ab0[q] += h * wb0; af1[q] += h * wf1; ab1[q] += h * wb1; }
    }
#pragma unroll
    for (int q = 0; q < 4; ++q)
#pragma unroll
        for (int k = 0; k < 4; ++k) {
            const int m = m0 + q * 4 + k; const float win = __expf(-((float)m * (1.0f / 8191.0f)) * delta);
            data[m] = make_float2(af0[q][k] * win, af1[q][k] * win);
            if (m >= 1) data[16384 - m] = make_float2(ab0[q][k] * win, ab1[q][k] * win);
        }
    if (tid == 0) data[8192] = make_float2(0.f, 0.f);
    __syncthreads();
    fft_dif(data);
#pragma unroll 8
    for (int i = 0; i < 32; ++i) { const int q = tid + 512 * i; const float2 v = data[q]; Kd[q] = make_float2(v.x * (1.0f / 16384.0f), v.y * (1.0f / 16384.0f)); }
    __syncthreads();
}
template <int O> __device__ __forceinline__ void hyena_mid(float2* d, const float2* Z) {
    const int tid = opaque_tid();
#pragma unroll 4
    for (int i = 0; i < 8; ++i) {
        const int q0 = 4 * (tid + 512 * i);
        f32x4* qp = (f32x4*)(d + q0);
        const f32x4 A = qp[0], B = qp[1];
        const f32x4 ZA = *(const f32x4*)(Z + q0), ZB = *(const f32x4*)(Z + q0 + 2);
        float2 z2[4];
#pragma unroll
        for (int e = 0; e < 4; ++e) { const int f = rev4_14(q0 + e); z2[e] = Z[rev4_14((16384 - f) & 16383)]; }
        const float b0x = A[0] + B[0], b0y = A[1] + B[1], b1x = A[0] - B[0], b1y = A[1] - B[1], b2x = A[2] + B[2], b2y = A[3] + B[3], b3x = A[2] - B[2], b3y = A[3] - B[3];
        float2 y[4] = {make_float2(b0x + b2x, b0y + b2y), make_float2(b1x + b3y, b1y - b3x), make_float2(b0x - b2x, b0y - b2y), make_float2(b1x - b3y, b1y + b3x)};
        const float2 z[4] = {make_float2(ZA[0], ZA[1]), make_float2(ZA[2], ZA[3]), make_float2(ZB[0], ZB[1]), make_float2(ZB[2], ZB[3])};
#pragma unroll
        for (int e = 0; e < 4; ++e) {
            const float2 k = O == 0 ? make_float2(0.5f * (z[e].x + z2[e].x), 0.5f * (z[e].y - z2[e].y)) : make_float2(0.5f * (z[e].y + z2[e].y), -0.5f * (z[e].x - z2[e].x));
            y[e] = cmul(y[e], k);
        }
        const float c0x = y[0].x + y[2].x, c0y = y[0].y + y[2].y, c1x = y[0].x - y[2].x, c1y = y[0].y - y[2].y, c2x = y[1].x + y[3].x, c2y = y[1].y + y[3].y, c3x = y[1].x - y[3].x, c3y = y[1].y - y[3].y;
        qp[0] = (f32x4){c0x + c2x, c0y + c2y, c1x - c3y, c1y + c3x};
        qp[1] = (f32x4){c0x - c2x, c0y - c2y, c1x + c3y, c1y - c3x};
    }
    __syncthreads();
}
template <int O> __device__ __forceinline__ void hyena_mul(float2* data, const float2* Z) {
    const int tid = opaque_tid();
#pragma unroll 8
    for (int i = 0; i < 32; ++i) {
        const int q = tid + 512 * i, f = rev4_14(q), q2 = rev4_14((16384 - f) & 16383);
        const float2 z = Z[q], z2 = Z[q2];
        const float2 k = O == 0 ? make_float2(0.5f * (z.x + z2.x), 0.5f * (z.y - z2.y)) : make_float2(0.5f * (z.y + z2.y), -0.5f * (z.x - z2.x));
        data[q] = cmul(data[q], k);
    }
    __syncthreads();
}
__device__ __forceinline__ void dif0_pair(float2* d, int j, f32x4 in0, f32x4 in1) {
    f32x4 o0, o1, o2, o3;
#pragma unroll
    for (int e = 0; e < 2; ++e) {
        const float2 a0 = make_float2(in0[2 * e], in0[2 * e + 1]), a1 = make_float2(in1[2 * e], in1[2 * e + 1]);
        const float r = (float)(j + e) * (1.0f / 16384.0f);
        const float2 w1 = make_float2(cos_rev(r), -sin_rev(r)), w2 = make_float2(cos_rev(2.f * r), -sin_rev(2.f * r)), w3 = make_float2(cos_rev(3.f * r), -sin_rev(3.f * r));
        const float2 y0 = make_float2(a0.x + a1.x, a0.y + a1.y), y2 = cmul(make_float2(a0.x - a1.x, a0.y - a1.y), w2);
        const float2 y1 = cmul(make_float2(a0.x + a1.y, a0.y - a1.x), w1), y3 = cmul(make_float2(a0.x - a1.y, a0.y + a1.x), w3);
        o0[2 * e] = y0.x; o0[2 * e + 1] = y0.y; o1[2 * e] = y1.x; o1[2 * e + 1] = y1.y; o2[2 * e] = y2.x; o2[2 * e + 1] = y2.y; o3[2 * e] = y3.x; o3[2 * e + 1] = y3.y;
    }
    *(f32x4*)(d + j) = o0; *(f32x4*)(d + j + 4096) = o1; *(f32x4*)(d + j + 8192) = o2; *(f32x4*)(d + j + 12288) = o3;
}
__device__ __forceinline__ void dit0_pair(const float2* d, int j, f32x4& out0, f32x4& out1) {
    const f32x4 i0 = *(const f32x4*)(d + j), i1 = *(const f32x4*)(d + j + 4096), i2 = *(const f32x4*)(d + j + 8192), i3 = *(const f32x4*)(d + j + 12288);
#pragma unroll
    for (int e = 0; e < 2; ++e) {
        const float r = (float)(j + e) * (1.0f / 16384.0f);
        const float2 w1 = make_float2(cos_rev(r), sin_rev(r)), w2 = make_float2(cos_rev(2.f * r), sin_rev(2.f * r)), w3 = make_float2(cos_rev(3.f * r), sin_rev(3.f * r));
        const float2 y0 = make_float2(i0[2 * e], i0[2 * e + 1]), y1 = cmul(make_float2(i1[2 * e], i1[2 * e + 1]), w1), y2 = cmul(make_float2(i2[2 * e], i2[2 * e + 1]), w2), y3 = cmul(make_float2(i3[2 * e], i3[2 * e + 1]), w3);
        const float2 c0 = make_float2(y0.x + y2.x, y0.y + y2.y), c1 = make_float2(y0.x - y2.x, y0.y - y2.y), c2 = make_float2(y1.x + y3.x, y1.y + y3.y), c3 = make_float2(y1.x - y3.x, y1.y - y3.y);
        out0[2 * e] = c0.x + c2.x; out0[2 * e + 1] = c0.y + c2.y; out1[2 * e] = c1.x - c3.y; out1[2 * e + 1] = c1.y + c3.x;
    }
}
__device__ __forceinline__ void hyena_item(KP p, int l, int c, float2* data, bool do_store) {
    const int tid = opaque_tid(); unsigned char* ws = opaque_ptr(p->ws);
    bf16_t* hv = (bf16_t*)(ws + T_HYT) + (size_t)c * NTOK; const bf16_t* hx1 = (const bf16_t*)(ws + T_HYT) + (size_t)(256 + c) * NTOK; const bf16_t* hx2 = (const bf16_t*)(ws + T_HYT) + (size_t)(512 + c) * NTOK;
    float2* RA = (float2*)(ws + T_FK) + (size_t)c * 2 * 16384; float2* RB = RA + 16384;
    const float* cw = p->in[7] + l * 3 * 768; const float* cb = p->in[8] + l * 768;
    const float wv0 = cw[c], wv1 = cw[768 + c], wv2 = cw[1536 + c], bv = cb[c];
    const float wa0 = cw[256 + c], wa1 = cw[768 + 256 + c], wa2 = cw[1536 + 256 + c], ba = cb[256 + c];
    const float wb0 = cw[512 + c], wb1 = cw[768 + 512 + c], wb2 = cw[1536 + 512 + c], bb = cb[512 + c];
    const float skip0 = p->in[16][l * 512 + c], skip1 = p->in[16][l * 512 + 256 + c];
    const float mind = -3.0701134573253945f, maxd = -15.350567286626973f;
    const float delta = fabsf(mind + (float)c * ((maxd - mind) / 255.0f));
    __syncthreads();
    hyena_filter(p, l, c, data, RA, delta);
#pragma unroll 1
    for (int pr = 0; pr < 2; ++pr) {
        const int o0 = (2 * pr) * SEQ, o1 = (2 * pr + 1) * SEQ;
        { const int tq = opaque_tid();
#pragma unroll
          for (int i = 0; i < 4; ++i) { const int m = tq + 512 * i;
              const float2 a0 = sconv2(hv + o0, m, wv0, wv1, wv2, bv), a1 = sconv2(hv + o1, m, wv0, wv1, wv2, bv);
              const float2 b0 = sconv2(hv + o0, m + 2048, wv0, wv1, wv2, bv), b1 = sconv2(hv + o1, m + 2048, wv0, wv1, wv2, bv);
              dif0_pair(data, 2 * m, (f32x4){a0.x, a1.x, a0.y, a1.y}, (f32x4){b0.x, b1.x, b0.y, b1.y}); } }
        __syncthreads();
        fft_dif<false, false>(data);
        hyena_mid<0>(data, RA);
        fft_dit_inv<false, false>(data);
        { const int tq = opaque_tid();
#pragma unroll
          for (int i = 0; i < 4; ++i) { const int m = tq + 512 * i; f32x4 cva, cvb; dit0_pair(data, 2 * m, cva, cvb);
              { const float2 v0 = sconv2(hv + o0, m, wv0, wv1, wv2, bv), v1 = sconv2(hv + o1, m, wv0, wv1, wv2, bv);
                const float2 x0 = sconv2(hx1 + o0, m, wa0, wa1, wa2, ba), x1 = sconv2(hx1 + o1, m, wa0, wa1, wa2, ba);
                *(f32x4*)(RB + pr * 8192 + 2 * m) = (f32x4){x0.x * (cva[0] + skip0 * v0.x), x1.x * (cva[1] + skip0 * v1.x), x0.y * (cva[2] + skip0 * v0.y), x1.y * (cva[3] + skip0 * v1.y)}; }
              { const int mb = m + 2048;
                const float2 v0 = sconv2(hv + o0, mb, wv0, wv1, wv2, bv), v1 = sconv2(hv + o1, mb, wv0, wv1, wv2, bv);
                const float2 x0 = sconv2(hx1 + o0, mb, wa0, wa1, wa2, ba), x1 = sconv2(hx1 + o1, mb, wa0, wa1, wa2, ba);
                *(f32x4*)(RB + pr * 8192 + 2 * mb) = (f32x4){x0.x * (cvb[0] + skip0 * v0.x), x1.x * (cvb[1] + skip0 * v1.x), x0.y * (cvb[2] + skip0 * v0.y), x1.y * (cvb[3] + skip0 * v1.y)}; } } }
        __syncthreads();
    }
#pragma unroll 1
    for (int pr = 0; pr < 2; ++pr) {
        const int o0 = (2 * pr) * SEQ, o1 = (2 * pr + 1) * SEQ;
        { const int tq = opaque_tid();
#pragma unroll
          for (int i = 0; i < 4; ++i) { const int m = tq + 512 * i;
              dif0_pair(data, 2 * m, *(const f32x4*)(RB + pr * 8192 + 2 * m), *(const f32x4*)(RB + pr * 8192 + 2 * m + 4096)); } }
        __syncthreads();
        fft_dif<false, false>(data);
        hyena_mid<1>(data, RA);
        fft_dit_inv<false, false>(data);
        { const int tq = opaque_tid();
#pragma unroll
          for (int i = 0; i < 4; ++i) { const int m = tq + 512 * i; f32x4 cva, cvb; dit0_pair(data, 2 * m, cva, cvb);
              { const f32x4 y1 = *(const f32x4*)(RB + pr * 8192 + 2 * m);
                const float2 x0 = sconv2(hx2 + o0, m, wb0, wb1, wb2, bb), x1 = sconv2(hx2 + o1, m, wb0, wb1, wb2, bb);
                if (do_store) { *(unsigned*)(hv + o0 + 2 * m) = cvt_pk_bf16(x0.x * (cva[0] + skip1 * y1[0]), x0.y * (cva[2] + skip1 * y1[2]));
                                *(unsigned*)(hv + o1 + 2 * m) = cvt_pk_bf16(x1.x * (cva[1] + skip1 * y1[1]), x1.y * (cva[3] + skip1 * y1[3])); } }
              { const int mb = m + 2048; const f32x4 y1 = *(const f32x4*)(RB + pr * 8192 + 2 * mb);
                const float2 x0 = sconv2(hx2 + o0, mb, wb0, wb1, wb2, bb), x1 = sconv2(hx2 + o1, mb, wb0, wb1, wb2, bb);
                if (do_store) { *(unsigned*)(hv + o0 + 2 * mb) = cvt_pk_bf16(x0.x * (cvb[0] + skip1 * y1[0]), x0.y * (cvb[2] + skip1 * y1[2]));
                                *(unsigned*)(hv + o1 + 2 * mb) = cvt_pk_bf16(x1.x * (cvb[1] + skip1 * y1[1]), x1.y * (cvb[3] + skip1 * y1[3])); } } } }
        __syncthreads();
    }
}

constexpr int G_QF = 0, G_QB = G_QF + 64 * 33, G_KF = G_QB + 64 * 33, G_KB = G_KF + 32 * 68, G_V = G_KB + 32 * 68, G_A = G_V + 64 * 68, G_S = G_A + 64 * 68, G_T = G_S + 32 * 68,
              G_GF = G_T + 32 * 68, G_GB = G_GF + 64 * 33, G_O = G_GB + 64 * 33, G_O1 = G_O + 64 * 68, G_END = G_O1 + 64 * 68;
static_assert(G_END * 4 <= LDS_BYTES, "gla lds");
template <int CTRL, int ROW_MASK> __device__ __forceinline__ float dpp_add(float v) {
    const int s = __builtin_amdgcn_update_dpp(0, __float_as_int(v), CTRL, ROW_MASK, 0xf, true);
    return v + __int_as_float(s);
}
__device__ __forceinline__ float wave_incl_scan(float v) {
    v = dpp_add<0x111, 0xf>(v); v = dpp_add<0x112, 0xf>(v); v = dpp_add<0x114, 0xf>(v); v = dpp_add<0x118, 0xf>(v);
    v = dpp_add<0x142, 0xa>(v); v = dpp_add<0x143, 0xc>(v);
    return v;
}
struct GlaLoads { f32x4 gx[8]; u32x4 vw; u32x2 qw, kw; };
__device__ __forceinline__ GlaLoads gla_issue(KP p, int it) {
    const int tid = opaque_tid(), wid = __builtin_amdgcn_readfirstlane(tid >> 6), lane = tid & 63; unsigned char* ws = opaque_ptr(p->ws);
    const int h = it & 3, n = (it >> 2) & 127, b = it >> 9, row0 = b * SEQ + n * 64;
    const bf16_t* gin = (const bf16_t*)(ws + T_GIN); const float* gg = (const float*)(ws + T_GG);
    GlaLoads g;
    { const f32x4* gr = (const f32x4*)(gg + (size_t)(row0 + lane) * 32);
#pragma unroll
      for (int q = 0; q < 8; ++q) g.gx[q] = gr[q]; }
    g.vw = *(const u32x4*)(gin + (size_t)(row0 + (tid >> 3)) * 832 + 256 + h * 64 + (tid & 7) * 8);
    g.qw = *(const u32x2*)(gin + (size_t)(row0 + lane) * 832 + h * 32 + 4 * wid); g.kw = *(const u32x2*)(gin + (size_t)(row0 + lane) * 832 + 128 + h * 32 + 4 * wid);
    return g;
}
__device__ __forceinline__ void gla_prepare(KP p, int l, int h, const GlaLoads& g, float* L) {
    const int tid = opaque_tid(), wid = __builtin_amdgcn_readfirstlane(tid >> 6), lane = tid & 63;
    const float* wf = p->in[23] + l * 16 * 128 + h * 32 + 4 * wid; const float* wb = p->in[25] + l * 16 * 128 + h * 32 + 4 * wid;
    f32x4 af = *(const f32x4*)(p->in[24] + l * 128 + h * 32 + 4 * wid), ab = *(const f32x4*)(p->in[26] + l * 128 + h * 32 + 4 * wid);
#pragma unroll
    for (int r = 0; r < 16; ++r) { const float xf = g.gx[r >> 2][r & 3], xb = g.gx[4 + (r >> 2)][r & 3];
        af += *(const f32x4*)(wf + r * 128) * xf; ab += *(const f32x4*)(wb + r * 128) * xb; }
    float bb[4], cc[4];
#pragma unroll
    for (int k = 0; k < 4; ++k) {
        const float vf = (fminf(af[k], 0.f) - __logf(1.f + __expf(-fabsf(af[k])))) * (1.0f / 16.0f), vb = (fminf(ab[k], 0.f) - __logf(1.f + __expf(-fabsf(ab[k])))) * (1.0f / 16.0f);
        const float pf = wave_incl_scan(vf), pb = wave_incl_scan(vb);
        const float tot = __int_as_float(__builtin_amdgcn_readlane(__float_as_int(pb), 63));
        bb[k] = pf; cc[k] = tot - pb + vb; }
    __syncthreads();
    { float* vp = L + G_V + (tid >> 3) * 68 + (tid & 7) * 8; const u32x4 vw = g.vw;
      vp[0] = bflo(vw.x); vp[1] = bfhi(vw.x); vp[2] = bflo(vw.y); vp[3] = bfhi(vw.y); vp[4] = bflo(vw.z); vp[5] = bfhi(vw.z); vp[6] = bflo(vw.w); vp[7] = bfhi(vw.w); }
    { const u32x2 qw = g.qw, kw = g.kw; const float qv[4] = {bflo(qw.x), bfhi(qw.x), bflo(qw.y), bfhi(qw.y)}, kv[4] = {bflo(kw.x), bfhi(kw.x), bflo(kw.y), bfhi(kw.y)};
#pragma unroll
      for (int k = 0; k < 4; ++k) { const int d = 4 * wid + k; const float qs = qv[k] * 0.17677669529663687f;
          L[G_QF + lane * 33 + d] = qs * __expf(bb[k]); L[G_QB + lane * 33 + d] = qs * __expf(cc[k]); L[G_KF + d * 68 + lane] = kv[k] * __expf(-bb[k]); L[G_KB + d * 68 + lane] = kv[k] * __expf(-cc[k]);
          if (lane == 63) L[G_GF + 63 * 33 + d] = bb[k];
          if (lane == 0) L[G_GB + d] = cc[k]; } }
    __syncthreads();
}
__device__ __forceinline__ int crow32(int r, int hi) { return (r & 3) + 8 * (r >> 2) + 4 * hi; }
__device__ __forceinline__ void gla_pass1(KP p, int l, float* L) {
    const int tid = opaque_tid(), wid = tid >> 6, lane = tid & 63, c = lane & 31, kh = lane >> 5; unsigned char* ws = opaque_ptr(p->ws);
    float* SF = (float*)(ws + T_SF); float* SB = (float*)(ws + T_SB); float* DF = (float*)(ws + T_DF); float* DB = (float*)(ws + T_DB);
    int it = opaque_bid(); if (it >= 2048) return;
    GlaLoads cur = gla_issue(p, it);
    for (; it < 2048; it += gridDim.x) {
        const int h = it & 3, n = (it >> 2) & 127, b = it >> 9;
        const int itn = it + (int)gridDim.x < 2048 ? it + (int)gridDim.x : it;
        const GlaLoads nxt = gla_issue(p, itn);
        gla_prepare(p, l, h, cur, L);
        cur = nxt;
        if (wid < 4) {
            const int te = wid & 1, dir = wid >> 1; const float* Kx = L + (dir ? G_KB : G_KF) + c * 68 + kh; const float* Vx = L + G_V + kh * 68 + 32 * te + c;
            f32x16 acc = {};
#pragma unroll 8
            for (int kk = 0; kk < 32; ++kk) acc = __builtin_amdgcn_mfma_f32_32x32x2f32(Kx[2 * kk], Vx[2 * kk * 68], acc, 0, 0, 0);
            float* Sx = (dir ? SB : SF) + ((size_t)((b * 4 + h) * 128 + n)) * 2048 + 32 * te + c;
#pragma unroll
            for (int r = 0; r < 16; ++r) { const int d = crow32(r, kh); const float sc = __expf(dir ? L[G_GB + d] : L[G_GF + 63 * 33 + d]); Sx[d * 64] = acc[r] * sc; }
        }
        if (tid < 32) { DF[((b * 4 + h) * 128 + n) * 32 + tid] = __expf(L[G_GF + 63 * 33 + tid]); DB[((b * 4 + h) * 128 + n) * 32 + tid] = __expf(L[G_GB + tid]); }
    }
}
__device__ __forceinline__ void gla_pass2(KP p) {
    unsigned char* ws = opaque_ptr(p->ws); const int gid = opaque_bid() * NTHR + opaque_tid();
    if (gid >= 65536) return;
    const int bh = gid >> 12, dir = (gid >> 11) & 1, el = gid & 2047, d = el >> 6;
    float* S = (float*)(ws + (dir ? T_SB : T_SF)) + (size_t)bh * 128 * 2048 + el; const float* Dc = (const float*)(ws + (dir ? T_DB : T_DF)) + bh * 128 * 32 + d;
    float st = 0.f;
    for (int n0 = 0; n0 < 128; n0 += 32) {
        float Lv[32], Dv[32];
#pragma unroll
        for (int k = 0; k < 32; ++k) { const int n = dir ? 127 - (n0 + k) : n0 + k; Lv[k] = S[(size_t)n * 2048]; Dv[k] = Dc[n * 32]; }
#pragma unroll
        for (int k = 0; k < 32; ++k) { const int n = dir ? 127 - (n0 + k) : n0 + k; S[(size_t)n * 2048] = st; st = Dv[k] * st + Lv[k]; }
    }
}
__device__ __forceinline__ void gla_pass3(KP p, int l, float* L) {
    const int tid = opaque_tid(), wid = tid >> 6, lane = tid & 63, c = lane & 31, kh = lane >> 5; unsigned char* ws = opaque_ptr(p->ws);
    const float* SF = (const float*)(ws + T_SF); const float* SB = (const float*)(ws + T_SB);
    const bf16_t* gin = (const bf16_t*)(ws + T_GIN); bf16_t* mixb = (bf16_t*)(ws + T_MIXB);
    int it = opaque_bid(); if (it >= 2048) return;
    GlaLoads cur = gla_issue(p, it);
    for (; it < 2048; it += gridDim.x) {
        const int h = it & 3, n = (it >> 2) & 127, b = it >> 9;
        const size_t so = ((size_t)((b * 4 + h) * 128 + n)) * 2048 + tid * 4;
        const f32x4 sreg = *(const f32x4*)(SF + so), treg = *(const f32x4*)(SB + so);
        const int i0 = (tid >> 4) * 2, e0 = (tid & 15) * 4;
        const u32x2 rw0 = *(const u32x2*)(gin + (size_t)(b * SEQ + n * 64 + i0) * 832 + 544 + h * 64 + e0), rw1 = *(const u32x2*)(gin + (size_t)(b * SEQ + n * 64 + i0 + 1) * 832 + 544 + h * 64 + e0);
        const f32x4 gn = *(const f32x4*)(p->in[27] + l * 64 + e0);
        const int itn = it + (int)gridDim.x < 2048 ? it + (int)gridDim.x : it;
        const GlaLoads nxt = gla_issue(p, itn);
        gla_prepare(p, l, h, cur, L);
        cur = nxt;
        { const int d = tid >> 4; *(f32x4*)(L + G_S + d * 68 + e0) = sreg; *(f32x4*)(L + G_T + d * 68 + e0) = treg; }
        { const int ti = (wid >> 1) & 1, tj = wid & 1, dir = wid >> 2;
          const float* Qx = L + (dir ? G_QB : G_QF) + (32 * ti + c) * 33 + kh; const float* Kx = L + (dir ? G_KB : G_KF) + kh * 68 + 32 * tj + c;
          f32x16 acc = {};
#pragma unroll
          for (int kk = 0; kk < 16; ++kk) acc = __builtin_amdgcn_mfma_f32_32x32x2f32(Qx[2 * kk], Kx[2 * kk * 68], acc, 0, 0, 0);
          const int j = 32 * tj + c;
#pragma unroll
          for (int r = 0; r < 16; ++r) { const int i = 32 * ti + crow32(r, kh); const bool mine = dir ? (j > i) : (j <= i); if (mine) L[G_A + i * 65 + j] = acc[r]; } }
        __syncthreads();
        { const int ti = (wid >> 1) & 1, te = wid & 1, half = wid >> 2; f32x16 acc = {};
          if (half == 0) {
              const float* Ax = L + G_A + (32 * ti + c) * 65 + kh; const float* Vx = L + G_V + kh * 68 + 32 * te + c;
#pragma unroll 8
              for (int kk = 0; kk < 32; ++kk) acc = __builtin_amdgcn_mfma_f32_32x32x2f32(Ax[2 * kk], Vx[2 * kk * 68], acc, 0, 0, 0);
          } else {
              const float* Qf = L + G_QF + (32 * ti + c) * 33 + kh; const float* Qb = L + G_QB + (32 * ti + c) * 33 + kh;
              const float* Sx = L + G_S + kh * 68 + 32 * te + c; const float* Tx = L + G_T + kh * 68 + 32 * te + c;
#pragma unroll
              for (int kk = 0; kk < 16; ++kk) acc = __builtin_amdgcn_mfma_f32_32x32x2f32(Qf[2 * kk], Sx[2 * kk * 68], acc, 0, 0, 0);
#pragma unroll
              for (int kk = 0; kk < 16; ++kk) acc = __builtin_amdgcn_mfma_f32_32x32x2f32(Qb[2 * kk], Tx[2 * kk * 68], acc, 0, 0, 0);
#pragma unroll
              for (int r = 0; r < 16; ++r) L[G_O1 + (32 * ti + crow32(r, kh)) * 68 + 32 * te + c] = acc[r];
          }
          __syncthreads();
          if (half == 0) {
#pragma unroll
              for (int r = 0; r < 16; ++r) { const int o = (32 * ti + crow32(r, kh)) * 68 + 32 * te + c; L[G_O + o] = acc[r] + L[G_O1 + o]; }
          } }
        __syncthreads();
        const f32x4 o0 = *(const f32x4*)(L + G_O + i0 * 68 + e0), o1 = *(const f32x4*)(L + G_O + (i0 + 1) * 68 + e0);
        float s0 = o0[0] * o0[0] + o0[1] * o0[1] + o0[2] * o0[2] + o0[3] * o0[3], s1 = o1[0] * o1[0] + o1[1] * o1[1] + o1[2] * o1[2] + o1[3] * o1[3];
        s0 = dpp_add<0x128, 0xf>(s0); s0 = dpp_add<0x124, 0xf>(s0); s0 = dpp_add<0x122, 0xf>(s0); s0 = dpp_add<0x121, 0xf>(s0);
        s1 = dpp_add<0x128, 0xf>(s1); s1 = dpp_add<0x124, 0xf>(s1); s1 = dpp_add<0x122, 0xf>(s1); s1 = dpp_add<0x121, 0xf>(s1);
        const float r0 = rsqrtf(s0 * (1.0f / 64.0f) + 1e-6f), r1 = rsqrtf(s1 * (1.0f / 64.0f) + 1e-6f);
#pragma unroll
        for (int rr = 0; rr < 2; ++rr) { const int row = b * SEQ + n * 64 + i0 + rr; const f32x4 ov = rr ? o1 : o0; const float rs = rr ? r1 : r0;
            const u32x2 rw = rr ? rw1 : rw0; const float rv[4] = {bflo(rw.x), bfhi(rw.x), bflo(rw.y), bfhi(rw.y)};
            float ot[4];
#pragma unroll
            for (int k = 0; k < 4; ++k) ot[k] = ov[k] * rs * gn[k] * (rv[k] * __builtin_amdgcn_rcpf(1.f + __expf(-rv[k])));
            u32x2 w; w.x = cvt_pk_bf16(ot[0], ot[1]); w.y = cvt_pk_bf16(ot[2], ot[3]); *(u32x2*)(mixb + (size_t)row * DM + 768 + h * 64 + e0) = w; }
    }
}

__device__ __forceinline__ void mix_assemble(KP p, int l, float* L) {
    const int tid = opaque_tid(), wid = tid >> 6, lane = tid & 63; unsigned char* ws = opaque_ptr(p->ws);
    const bf16_t* hy = (const bf16_t*)(ws + T_HYT); bf16_t* mixb = (bf16_t*)(ws + T_MIXB); const bf16_t* atto = (const bf16_t*)(ws + T_ATTO);
    const float* gh = p->in[17] + l * 256; const float* gm = p->in[22] + l * 512;
    float* tile = L; float* red = L + 256 * 65;
    for (int it = opaque_bid(); it < NTOK / 64; it += gridDim.x) {
        const int row0 = it * 64;
        __syncthreads();
        { const int c = tid >> 1, t0 = (tid & 1) * 32; const bf16_t* sp = hy + (size_t)c * NTOK + row0 + t0;
#pragma unroll
          for (int q = 0; q < 4; ++q) { const u32x4 w = *(const u32x4*)(sp + q * 8); float* tp = tile + c * 65 + t0 + q * 8;
              tp[0] = bflo(w.x); tp[1] = bfhi(w.x); tp[2] = bflo(w.y); tp[3] = bfhi(w.y); tp[4] = bflo(w.z); tp[5] = bfhi(w.z); tp[6] = bflo(w.w); tp[7] = bfhi(w.w); } }
        __syncthreads();
        { const int t = tid & 63, part = tid >> 6; float ss = 0.f;
#pragma unroll 8
          for (int cc = 0; cc < 32; ++cc) { const float v = tile[(part * 32 + cc) * 65 + t]; ss += v * v; }
          red[part * 64 + t] = ss; }
        __syncthreads();
        { const int t = tid >> 3, cg8 = (tid & 7) * 32; float ss = 0.f;
#pragma unroll
          for (int q = 0; q < 8; ++q) ss += red[q * 64 + t];
          const float rs = rsqrtf(ss * (1.0f / 256.0f) + 1e-6f); bf16_t* op = mixb + (size_t)(row0 + t) * DM + cg8;
#pragma unroll
          for (int q = 0; q < 4; ++q) { float v[8];
#pragma unroll
              for (int k = 0; k < 8; ++k) v[k] = tile[(cg8 + q * 8 + k) * 65 + t] * rs * gh[cg8 + q * 8 + k];
              u32x4 w; w.x = cvt_pk_bf16(v[0], v[1]); w.y = cvt_pk_bf16(v[2], v[3]); w.z = cvt_pk_bf16(v[4], v[5]); w.w = cvt_pk_bf16(v[6], v[7]);
              *(u32x4*)(op + q * 8) = w; } }
    }
    for (int rb = (opaque_bid() * 8 + wid) * 4; rb < NTOK; rb += gridDim.x * 32) {
        u32x4 w[4];
#pragma unroll
        for (int q = 0; q < 4; ++q) w[q] = *(const u32x4*)(atto + (size_t)(rb + q) * 512 + lane * 8);
        const f32x4 g0 = *(const f32x4*)(gm + lane * 8), g1 = *(const f32x4*)(gm + lane * 8 + 4);
#pragma unroll
        for (int q = 0; q < 4; ++q) {
            float v[8] = {bflo(w[q].x), bfhi(w[q].x), bflo(w[q].y), bfhi(w[q].y), bflo(w[q].z), bfhi(w[q].z), bflo(w[q].w), bfhi(w[q].w)}; float ss = 0.f;
#pragma unroll
            for (int k = 0; k < 8; ++k) ss += v[k] * v[k];
#pragma unroll
            for (int sft = 1; sft < 64; sft <<= 1) ss += __shfl_xor(ss, sft);
            const float rs = rsqrtf(ss * (1.0f / 512.0f) + 1e-6f);
#pragma unroll
            for (int k = 0; k < 8; ++k) v[k] *= rs * (k < 4 ? g0[k & 3] : g1[k & 3]);
            u32x4 o; o.x = cvt_pk_bf16(v[0], v[1]); o.y = cvt_pk_bf16(v[2], v[3]); o.z = cvt_pk_bf16(v[4], v[5]); o.w = cvt_pk_bf16(v[6], v[7]);
            *(u32x4*)(mixb + (size_t)(rb + q) * DM + 256 + lane * 8) = o;
        }
    }
}

#define XB_TMO      128
#define XB_XCNT(j)  (256  + 64 * (j))
#define XB_XSUB(j)  (1280 + 64 * (j))
#define XB_XGEN(j)  (2304 + 64 * (j))
#define XB_TOP      3328
#define XB_TOPGEN   3392
#define XCD_BAR_WORDS 3456
#define XB_SPIN_CAP (1u << 20)
__device__ __forceinline__ unsigned xb_ld(unsigned* p)              { return __hip_atomic_load(p, __ATOMIC_RELAXED, __HIP_MEMORY_SCOPE_AGENT); }
__device__ __forceinline__ unsigned xb_add(unsigned* p, unsigned v) { return __hip_atomic_fetch_add(p, v, __ATOMIC_RELAXED, __HIP_MEMORY_SCOPE_AGENT); }
__device__ __forceinline__ unsigned xb_xcc_id() { return (unsigned)__builtin_amdgcn_s_getreg((3 << 11) | 20) & 0xFu; }
#define XB_SPIN(cond, bar) do { unsigned _sp = 0; while (cond) { __builtin_amdgcn_s_sleep(1); \
    if ((++_sp & 255u) == 0u) { if (xb_ld(&(bar)[XB_TMO])) break; if (_sp > XB_SPIN_CAP) { atomicAdd(&(bar)[XB_TMO], 1u); break; } } } } while (0)
struct XcdBarrier { unsigned* bar; unsigned x; volatile LAS unsigned* st; };
__device__ __forceinline__ XcdBarrier xcd_barrier_post(unsigned* bar, volatile LAS unsigned* st) {
    XcdBarrier b; b.bar = bar; b.x = xb_xcc_id(); b.st = st;
    if (threadIdx.x == 0) (void)xb_add(&bar[XB_XCNT(b.x)], 1u);
    return b;
}
__device__ __forceinline__ void xcd_barrier_complete(unsigned* bar, unsigned x, unsigned& nloc, unsigned& nx) {
    const unsigned G = gridDim.x * gridDim.y * gridDim.z;
    unsigned sum, cnt, mine, sp = 0u;
    for (;;) {
        sum = 0u; cnt = 0u; mine = 0u;
#pragma unroll
        for (unsigned j = 0; j < 16; ++j) { const unsigned c = xb_ld(&bar[XB_XCNT(j)]); sum += c; cnt += (c > 0u) ? 1u : 0u; mine = (j == x) ? c : mine; }
        if (sum == G) break;
        __builtin_amdgcn_s_sleep(1);
        if ((++sp & 255u) == 0u) { if (xb_ld(&bar[XB_TMO])) break; if (sp > XB_SPIN_CAP) { atomicAdd(&bar[XB_TMO], 1u); break; } }
    }
    nloc = mine > 0u ? mine : 1u; nx = cnt > 0u ? cnt : 1u;
}
__device__ __forceinline__ void xcd_barrier(const XcdBarrier& b) {
    asm volatile("s_waitcnt vmcnt(0)" ::: "memory");
    __syncthreads();
    if (threadIdx.x == 0) {
        unsigned* bar = b.bar;
        __builtin_amdgcn_s_waitcnt(0);
        unsigned nloc = b.st[0], nx = b.st[1];
        if (nloc == 0u) { xcd_barrier_complete(bar, b.x, nloc, nx); b.st[0] = nloc; b.st[1] = nx; }
        const unsigned old = xb_add(&bar[XB_XSUB(b.x)], 1u);
        const unsigned gen = old / nloc;
        if (old + 1u == (gen + 1u) * nloc) {
            __builtin_amdgcn_fence(__ATOMIC_RELEASE, "agent");
            asm volatile("s_waitcnt vmcnt(0)" ::: "memory");
            const unsigned og = xb_add(&bar[XB_TOP], 1u);
            const unsigned tg = og / nx;
            if (og + 1u == (tg + 1u) * nx) xb_add(&bar[XB_TOPGEN], 1u);
            else XB_SPIN(xb_ld(&bar[XB_TOPGEN]) == tg, bar);
            __builtin_amdgcn_fence(__ATOMIC_ACQUIRE, "agent");
            xb_add(&bar[XB_XGEN(b.x)], 1u);
            asm volatile("s_waitcnt vmcnt(0)" ::: "memory");
        } else {
            XB_SPIN(xb_ld(&bar[XB_XGEN(b.x)]) == gen, bar);
            __builtin_amdgcn_fence(__ATOMIC_ACQUIRE, "agent");
            asm volatile("s_waitcnt vmcnt(0)" ::: "memory");
        }
    }
    __syncthreads();
}

template <int SEL> __global__ __launch_bounds__(NTHR, 2) void mega_t(Params pv) {
    extern __shared__ __attribute__((aligned(16))) unsigned char shm[];
    cg::grid_group grid = cg::this_grid();
    __shared__ uint4 xb_words;
    if (threadIdx.x == 0) xb_words = make_uint4(0u, 0u, 0u, 0u);
    __syncthreads();
    const XcdBarrier xb = xcd_barrier_post((unsigned*)(pv.ws + OFF_BAR), (volatile LAS unsigned*)&xb_words);
    const KP kp = (KP)__builtin_amdgcn_kernarg_segment_ptr();
    unsigned char* ws = pv.ws;
    float* X = pv.out; bf16_t* XB = (bf16_t*)(ws + OFF_XB); float* SSX = (float*)(ws + OFF_SSX);
    for (int ph = pv.ph_lo; ph < pv.ph_hi; ++ph) {
        KP p = kp; asm volatile("" : "+s"(p));
        if (ph == 0) { if constexpr (SEL < 0 || SEL == 100) for (int r0 = 0; r0 < (PROBE_REP == 100 ? 2 : 1); ++r0) phase_prep(p, (float*)shm); }
        else if (ph == 19) { if constexpr (SEL < 0 || SEL == 101) {
            const float* g = p->in[33]; const int tid = opaque_tid(), wid = tid >> 6, lane = tid & 63;
            f32x4 gv[4];
#pragma unroll
            for (int i = 0; i < 4; ++i) gv[i] = *(const f32x4*)(g + lane * 16 + 4 * i);
            for (int rb = (opaque_bid() * 8 + wid) * 4; rb < NTOK; rb += gridDim.x * 32) {
                u32x4 w0[4], w1[4]; float rs[4];
#pragma unroll
                for (int q = 0; q < 4; ++q) { const bf16_t* bp = XB + (size_t)(rb + q) * DM + lane * 16; w0[q] = *(const u32x4*)bp; w1[q] = *(const u32x4*)(bp + 8); rs[q] = rstd16(SSX, rb + q); }
#pragma unroll
                for (int q = 0; q < 4; ++q) { float* xp = X + (size_t)(rb + q) * DM + lane * 16;
                    const float xv[16] = {bflo(w0[q].x), bfhi(w0[q].x), bflo(w0[q].y), bfhi(w0[q].y), bflo(w0[q].z), bfhi(w0[q].z), bflo(w0[q].w), bfhi(w0[q].w), bflo(w1[q].x), bfhi(w1[q].x), bflo(w1[q].y), bfhi(w1[q].y), bflo(w1[q].z), bfhi(w1[q].z), bflo(w1[q].w), bfhi(w1[q].w)};
#pragma unroll
                    for (int i = 0; i < 4; ++i) { f32x4 v = {xv[4 * i], xv[4 * i + 1], xv[4 * i + 2], xv[4 * i + 3]}; v = v * rs[q] * gv[i]; *(f32x4*)(xp + 4 * i) = v; } }
            } }
        } else {
            const int l = (ph - 1) / 9, sp = (ph - 1) % 9;
            pg8::StaticOrder S;
            if constexpr (SEL < 0 || SEL == 0) if (sp == 0 || sp == 7) {
                const int f = sp == 0 ? 0 : 1;
                pg8::Gemm g{XB, (const bf16_t*)(ws + OFF_WUP + (l * 2 + f) * SZ_WUP), NTOK, 5632, 1024, 1024}; S.init(g.M, g.N, gridDim.x, opaque_bid());
                EpiFfnUp E{ws, -1, {0.f, 0.f, 0.f, 0.f, 0.f, 0.f, 0.f, 0.f}};
                for (int r1 = 0; r1 < (PROBE_REP == 0 ? 2 : 1); ++r1) pg8::gemm_phase(( LAS unsigned char*)shm, g, S, E);
            }
            if constexpr (SEL < 0 || SEL == 1) if (sp == 1 || sp == 8) {
                const int f = sp == 1 ? 0 : 1;
                pg8::Gemm g{(const bf16_t*)(ws + T_ACT), (const bf16_t*)(ws + OFF_WDN + (l * 2 + f) * SZ_WDN), NTOK, 1024, FF, FF}; S.init(g.M, g.N, gridDim.x, opaque_bid());
                for (int r1 = (PROBE_REP == 1 ? 0 : 1); r1 < 2; ++r1) { EpiResid E{ws, r1 == 0 ? 0.f : 0.5f};
                pg8::gemm_phase((LAS unsigned char*)shm, g, S, E); }
            }
            if constexpr (SEL < 0 || SEL == 2) if (sp == 2) {
                pg8::Gemm g{XB, (const bf16_t*)(ws + OFF_WIN + l * SZ_WIN), NTOK, 2048, 1024, 1024}; S.init(g.M, g.N, gridDim.x, opaque_bid());
                EpiWin E{ws};
                for (int r1 = 0; r1 < (PROBE_REP == 2 ? 2 : 1); ++r1) pg8::gemm_phase((LAS unsigned char*)shm, g, S, E);
            }
            if constexpr (SEL < 0 || SEL == 30 || SEL == 31 || SEL == 32) if (sp == 3) {
                if constexpr (SEL < 0 || SEL == 30) for (int r3 = 0; r3 < (PROBE_REP == 30 ? 2 : 1); ++r3) {
                { pg8::Gemm g{(const bf16_t*)(ws + T_CQB), (const bf16_t*)(ws + OFF_WUQ + l * SZ_WUQ), NTOK, 768, 256, 256}; S.init(g.M, g.N, gridDim.x, opaque_bid());
                  EpiUq E{ws};
                  pg8::gemm_phase((LAS unsigned char*)shm, g, S, E); }
                { pg8::Gemm g{(const bf16_t*)(ws + T_CKVB), (const bf16_t*)(ws + OFF_WUKV + l * SZ_WUKV), NTOK, 1024, 256, 256}; S.init(g.M, g.N, gridDim.x, opaque_bid());
                  EpiUkv E{ws};
                  pg8::gemm_phase((LAS unsigned char*)shm, g, S, E); }
                }
                if constexpr (SEL < 0 || SEL == 31) for (int r3 = (PROBE_REP == 31 ? 0 : 1); r3 < 2; ++r3) for (int c = opaque_bid(); c < 256; c += gridDim.x) hyena_item(p, l, c, (float2*)shm, r3 == 1);
                if constexpr (SEL < 0 || SEL == 32) for (int r3 = 0; r3 < (PROBE_REP == 32 ? 2 : 1); ++r3) gla_pass1(p, l, (float*)shm);
            }
            if constexpr (SEL < 0 || SEL == 4) if (sp == 4) {
                gla_pass2(p);
                const bf16_t* QN = (const bf16_t*)(ws + T_QN); const bf16_t* QR = (const bf16_t*)(ws + T_QR); const bf16_t* KN = (const bf16_t*)(ws + T_KN);
                const bf16_t* KR = (const bf16_t*)(ws + T_KR); const bf16_t* VV = (const bf16_t*)(ws + T_V); bf16_t* AO = (bf16_t*)(ws + T_ATTO);
                const int nper = (512 * 8) / (int)gridDim.x;
                (void)nper;
                for (int r4 = 0; r4 < (PROBE_REP == 4 ? 2 : 1); ++r4)
                for (int it = opaque_bid(); it < 512; it += gridDim.x) {
                    const int x = it & 7, y = it >> 3;
                    const int bh = x + 8 * (y >> 5), qb = y & 31;
                    const int b = bh >> 2, h = bh & 3;
                    const size_t hoff = ((size_t)bh * SEQ) * 128;
                    att::attn_body(QN + hoff + (size_t)qb * 256 * 128, QR + ((size_t)bh * SEQ + qb * 256) * 64, KN + hoff, KR + (size_t)b * SEQ * 64, VV + hoff,
                                   AO + ((size_t)b * SEQ + qb * 256) * 512 + h * 128, SEQ, (char*)shm);
                }
            }
            if constexpr (SEL < 0 || SEL == 5) if (sp == 5) {
                for (int r5 = 0; r5 < (PROBE_REP == 50 ? 2 : 1); ++r5) mix_assemble(p, l, (float*)shm);
                for (int r5 = 0; r5 < (PROBE_REP == 51 ? 2 : 1); ++r5) gla_pass3(p, l, (float*)shm);
            }
            if constexpr (SEL < 0 || SEL == 6) if (sp == 6) {
                pg8::Gemm g{(const bf16_t*)(ws + T_MIXB), (const bf16_t*)(ws + OFF_WOUT + l * SZ_WOUT), NTOK, 1024, 1024, 1024}; S.init(g.M, g.N, gridDim.x, opaque_bid());
                for (int r1 = (PROBE_REP == 6 ? 0 : 1); r1 < 2; ++r1) { EpiResid E{ws, r1 == 0 ? 0.f : 1.0f};
                pg8::gemm_phase((LAS unsigned char*)shm, g, S, E); }
            }
        }
        if (ph + 1 < pv.ph_hi) { if (pv.ph_hi > 1000) grid.sync(); else xcd_barrier(xb); }
    }
}

#if MK_COOP
#define MEGA_MAIN mega_t<-1>
#else
#define MEGA_MAIN mega_t<0>
#endif
extern "C" void kernel_launch(void* const* d_in, const int* in_sizes, int n_in, void* d_out, int out_size, void* d_ws, size_t ws_size, hipStream_t stream) {
    static int grid_blocks = 0;
    if (grid_blocks == 0) {
        if (n_in != 34 || out_size != NTOK * DM || ws_size < WS_END) { fprintf(stderr, "kernel_launch: unexpected shapes n_in %d out %d ws %zu (need %zu)\n", n_in, out_size, ws_size, (size_t)WS_END); grid_blocks = -1; return; }
        if (hipFuncSetAttribute((const void*)MEGA_MAIN, hipFuncAttributeMaxDynamicSharedMemorySize, LDS_BYTES) != hipSuccess) { fprintf(stderr, "kernel_launch: hipFuncSetAttribute failed\n"); grid_blocks = -1; return; }
        int dev = 0, cus = 0, per_cu = 0;
        (void)hipGetDevice(&dev); (void)hipDeviceGetAttribute(&cus, hipDeviceAttributeMultiprocessorCount, dev);
        (void)hipOccupancyMaxActiveBlocksPerMultiprocessor(&per_cu, (const void*)MEGA_MAIN, NTHR, LDS_BYTES);
        if (per_cu < 1) { fprintf(stderr, "kernel_launch: occupancy query says %d blocks/CU\n", per_cu); per_cu = 1; }
        (void)hipGetLastError();
        grid_blocks = cus * per_cu;
        fprintf(stderr, "kernel_launch: grid %d (cus %d x %d)\n", grid_blocks, cus, per_cu);
    }
    if (grid_blocks < 0) return;
    Params p{};
    for (int i = 0; i < 34; ++i) p.in[i] = (const float*)d_in[i];
    p.out = (float*)d_out; p.ws = (unsigned char*)d_ws;
    if (hipMemsetAsync((unsigned char*)d_ws + OFF_BAR, 0, 16384, stream) != hipSuccess) { fprintf(stderr, "kernel_launch: memset of barrier words failed\n"); return; }
#if MK_COOP == 2
    for (int ph = 0; ph < 20; ++ph) { p.ph_lo = ph; p.ph_hi = ph + 1; hipLaunchKernelGGL(mega_t<-1>, dim3(grid_blocks), dim3(NTHR), LDS_BYTES, stream, p); }
#elif MK_COOP
    p.ph_lo = 0; p.ph_hi = 20;
    void* args[] = {&p};
    hipError_t e = hipLaunchCooperativeKernel((const void*)mega_t<-1>, dim3(grid_blocks), dim3(NTHR), args, LDS_BYTES, stream);
    if (e != hipSuccess) fprintf(stderr, "cooperative launch failed: %s (grid %d)\n", hipGetErrorString(e), grid_blocks);
#else
    static int attr_done = 0;
    if (!attr_done) {
        attr_done = 1;
        (void)hipFuncSetAttribute((const void*)mega_t<0>, hipFuncAttributeMaxDynamicSharedMemorySize, LDS_BYTES); (void)hipFuncSetAttribute((const void*)mega_t<1>, hipFuncAttributeMaxDynamicSharedMemorySize, LDS_BYTES);
        (void)hipFuncSetAttribute((const void*)mega_t<2>, hipFuncAttributeMaxDynamicSharedMemorySize, LDS_BYTES); (void)hipFuncSetAttribute((const void*)mega_t<30>, hipFuncAttributeMaxDynamicSharedMemorySize, LDS_BYTES); (void)hipFuncSetAttribute((const void*)mega_t<31>, hipFuncAttributeMaxDynamicSharedMemorySize, LDS_BYTES); (void)hipFuncSetAttribute((const void*)mega_t<32>, hipFuncAttributeMaxDynamicSharedMemorySize, LDS_BYTES);
        (void)hipFuncSetAttribute((const void*)mega_t<4>, hipFuncAttributeMaxDynamicSharedMemorySize, LDS_BYTES); (void)hipFuncSetAttribute((const void*)mega_t<5>, hipFuncAttributeMaxDynamicSharedMemorySize, LDS_BYTES);
        (void)hipFuncSetAttribute((const void*)mega_t<6>, hipFuncAttributeMaxDynamicSharedMemorySize, LDS_BYTES); (void)hipFuncSetAttribute((const void*)mega_t<100>, hipFuncAttributeMaxDynamicSharedMemorySize, LDS_BYTES);
        (void)hipFuncSetAttribute((const void*)mega_t<101>, hipFuncAttributeMaxDynamicSharedMemorySize, LDS_BYTES);
    }
    for (int ph = 0; ph < 20; ++ph) {
        p.ph_lo = ph; p.ph_hi = ph + 1;
        const int sp = (ph == 0) ? 100 : (ph == 19) ? 101 : (ph - 1) % 9;
        switch (sp) {
            case 0: case 7: hipLaunchKernelGGL(mega_t<0>, dim3(grid_blocks), dim3(NTHR), LDS_BYTES, stream, p); break;
            case 1: case 8: hipLaunchKernelGGL(mega_t<1>, dim3(grid_blocks), dim3(NTHR), LDS_BYTES, stream, p); break;
            case 2: hipLaunchKernelGGL(mega_t<2>, dim3(grid_blocks), dim3(NTHR), LDS_BYTES, stream, p); break;
            case 3: hipLaunchKernelGGL(mega_t<30>, dim3(grid_blocks), dim3(NTHR), LDS_BYTES, stream, p); hipLaunchKernelGGL(mega_t<31>, dim3(grid_blocks), dim3(NTHR), LDS_BYTES, stream, p);
                    hipLaunchKernelGGL(mega_t<32>, dim3(grid_blocks), dim3(NTHR), LDS_BYTES, stream, p); break;
            case 4: hipLaunchKernelGGL(mega_t<4>, dim3(grid_blocks), dim3(NTHR), LDS_BYTES, stream, p); break;
            case 5: hipLaunchKernelGGL(mega_t<5>, dim3(grid_blocks), dim3(NTHR), LDS_BYTES, stream, p); break;
            case 6: hipLaunchKernelGGL(mega_t<6>, dim3(grid_blocks), dim3(NTHR), LDS_BYTES, stream, p); break;
            case 100: hipLaunchKernelGGL(mega_t<100>, dim3(grid_blocks), dim3(NTHR), LDS_BYTES, stream, p); break;
            default: hipLaunchKernelGGL(mega_t<101>, dim3(grid_blocks), dim3(NTHR), LDS_BYTES, stream, p); break;
        }
    }
#endif
}
```

```cpp
#include <hip/hip_runtime.h>
#include <hip/hip_cooperative_groups.h>
#include <cstdio>
#include <cstdint>
namespace cg = cooperative_groups;

#ifndef MK_COOP
#define MK_COOP 1
#endif
#ifndef PROBE_REP
#define PROBE_REP -1
#endif

typedef unsigned short bf16_t;
typedef short bf16x8 __attribute__((ext_vector_type(8)));
typedef short s16x4 __attribute__((ext_vector_type(4)));
typedef float f32x4 __attribute__((ext_vector_type(4)));
typedef float f32x16 __attribute__((ext_vector_type(16)));
typedef unsigned u32x4 __attribute__((ext_vector_type(4)));
typedef unsigned u32x2 __attribute__((ext_vector_type(2)));
#define LAS __attribute__((address_space(3)))

constexpr int NTOK = 32768, DM = 1024, FF = 2816, SEQ = 8192, NB = 4;
constexpr int NTHR = 512;
constexpr int LDS_BYTES = 149504;

constexpr size_t SZ_WUP = (size_t)5632 * 1024 * 2, SZ_WDN = (size_t)1024 * 2816 * 2, SZ_WIN = (size_t)2048 * 1024 * 2, SZ_WOUT = (size_t)1024 * 1024 * 2,
                 SZ_WUQ = (size_t)768 * 256 * 2, SZ_WUKV = (size_t)1024 * 256 * 2;
constexpr size_t OFF_WUP = 0, OFF_WDN = OFF_WUP + 4 * SZ_WUP, OFF_WIN = OFF_WDN + 4 * SZ_WDN, OFF_WOUT = OFF_WIN + 2 * SZ_WIN, OFF_WUQ = OFF_WOUT + 2 * SZ_WOUT,
                 OFF_WUKV = OFF_WUQ + 2 * SZ_WUQ, OFF_XB = OFF_WUKV + 2 * SZ_WUKV, OFF_SSX = OFF_XB + (size_t)NTOK * DM * 2, OFF_H2T = OFF_SSX + (size_t)NTOK * 16 * 4,
                 OFF_ROPE = OFF_H2T + (size_t)2 * 64 * 8192 * 4, OFF_BAR = OFF_ROPE + (size_t)8192 * 64 * 4, OFF_TR = OFF_BAR + 16384;
constexpr size_t T_ACT = OFF_TR;
constexpr size_t T_HYT = OFF_TR;
constexpr size_t T_CQB = T_HYT + (size_t)768 * NTOK * 2;
constexpr size_t T_CKVB = T_CQB + (size_t)NTOK * 256 * 2;
constexpr size_t T_SSCQ = T_CKVB + (size_t)NTOK * 256 * 2;
constexpr size_t T_SSCKV = T_SSCQ + (size_t)NTOK * 4 * 4;
constexpr size_t T_KR = T_SSCKV + (size_t)NTOK * 4 * 4;
constexpr size_t T_GIN = T_KR + (size_t)NTOK * 64 * 2;
constexpr size_t T_GG = T_GIN + (size_t)NTOK * 832 * 2;
constexpr size_t T_FK = T_GG + (size_t)NTOK * 32 * 4;
constexpr size_t T_ATTO = T_FK;
constexpr size_t T_SF = T_FK + (size_t)256 * 2 * 16384 * 8;
constexpr size_t T_SB = T_SF + (size_t)16 * 128 * 2048 * 4;
constexpr size_t T_DF = T_SB + (size_t)16 * 128 * 2048 * 4;
constexpr size_t T_DB = T_DF + (size_t)16 * 128 * 32 * 4;
constexpr size_t T_QN = T_DB + (size_t)16 * 128 * 32 * 4;
constexpr size_t T_MIXB = T_QN;
constexpr size_t T_QR = T_QN + (size_t)NTOK * 4 * 128 * 2;
constexpr size_t T_KN = T_QR + (size_t)NTOK * 4 * 64 * 2;
constexpr size_t T_V = T_KN + (size_t)NTOK * 4 * 128 * 2;
constexpr size_t WS_END = T_V + (size_t)NTOK * 4 * 128 * 2;
static_assert(WS_END <= (size_t)536870912, "workspace over 512 MiB");
static_assert(T_ACT + (size_t)NTOK * FF * 2 <= WS_END, "act");
static_assert((size_t)NTOK * DM * 2 <= (T_KN + (size_t)NTOK * 4 * 128 * 2) - T_QN, "mixb alias");

struct Params {
    const float* in[34];
    float* out;
    unsigned char* ws;
    int ph_lo, ph_hi;
};

typedef const Params __attribute__((address_space(4)))* KP;
__device__ __forceinline__ int opaque_tid() { int t = threadIdx.x; asm volatile("" : "+v"(t)); return t; }
__device__ __forceinline__ unsigned char* opaque_ptr(unsigned char* q) { return q; }
__device__ __forceinline__ int opaque_bid() { int t = blockIdx.x; asm volatile("" : "+s"(t)); return t; }
__device__ __forceinline__ unsigned cvt_pk_bf16(float lo, float hi) { unsigned r; asm volatile("v_cvt_pk_bf16_f32 %0, %1, %2" : "=v"(r) : "v"(lo), "v"(hi)); return r; }
__device__ __forceinline__ bf16_t f2bf(float f) { return (bf16_t)(cvt_pk_bf16(f, 0.f) & 0xffffu); }
__device__ __forceinline__ float bf2f(bf16_t b) { return __uint_as_float(((unsigned)b) << 16); }
__device__ __forceinline__ float bflo(unsigned w) { return __uint_as_float(w << 16); }
__device__ __forceinline__ float bfhi(unsigned w) { return __uint_as_float(w & 0xffff0000u); }
__device__ __forceinline__ float sin_rev(float r) { return __builtin_amdgcn_sinf(r); }
__device__ __forceinline__ float cos_rev(float r) { return __builtin_amdgcn_cosf(r); }
__device__ __forceinline__ float fast_sin(float x) { float r = x * 0.15915494309189535f; r = r - floorf(r); return __builtin_amdgcn_sinf(r); }
__device__ __forceinline__ float quad_sum(float s) {
    auto a = __builtin_amdgcn_permlane16_swap(__float_as_uint(s), __float_as_uint(s), false, false); s = __uint_as_float(a[0]) + __uint_as_float(a[1]);
    auto b = __builtin_amdgcn_permlane32_swap(__float_as_uint(s), __float_as_uint(s), false, false); return __uint_as_float(b[0]) + __uint_as_float(b[1]);
}
__device__ __forceinline__ float rstd16(const float* ss, int row) {
    const f32x4* p = (const f32x4*)(ss + (size_t)row * 16); const f32x4 a = p[0], b = p[1], c = p[2], d = p[3];
    const float s = ((a.x + a.y) + (a.z + a.w)) + ((b.x + b.y) + (b.z + b.w)) + ((c.x + c.y) + (c.z + c.w)) + ((d.x + d.y) + (d.z + d.w));
    return rsqrtf(s * (1.0f / 1024.0f) + 1e-6f);
}
__device__ __forceinline__ float rstd16q(const float* ss, int row, int fq) {
    const f32x4 a = *(const f32x4*)(ss + (size_t)row * 16 + 4 * fq); float s = (a.x + a.y) + (a.z + a.w);
    s = quad_sum(s);
    return rsqrtf(s * (1.0f / 1024.0f) + 1e-6f);
}
__device__ __forceinline__ float rstd4(const float* ss, int row, float invn) {
    const f32x4 a = *(const f32x4*)(ss + (size_t)row * 4); return rsqrtf(((a.x + a.y) + (a.z + a.w)) * invn + 1e-6f);
}

namespace pg8 {
constexpr int BM = 256, BK = 64, HALF = 128, HTB = HALF * BK * 2, NXCD = 8, WGM = 8;
__host__ __device__ __forceinline__ int lds_byte(int r, int c) { const int st = (r >> 4) * 2 + (c >> 5), rr = r & 15, cc = c & 31, ob = rr * 64 + cc * 2; return st * 1024 + (ob ^ (((ob >> 9) & 1) << 5)); }
__host__ __device__ __forceinline__ void stage_rc(int b, int& R, int& C) { const int st = b / 1024, sb = b % 1024, swz = sb ^ (((sb >> 9) & 1) << 5); R = (st >> 1) * 16 + swz / 64; C = (st & 1) * 32 + (swz % 64) / 2; }
__host__ __device__ __forceinline__ int perm32(int rho) { const int n = rho >> 4, i = rho & 15; return 8 * (i >> 2) + 4 * n + (i & 3); }
struct Unit { int pm, pn; };
struct Gemm { const bf16_t* A; const bf16_t* Bt; int M, N, K, lda; };
struct StaticOrder {
    int nM, nN, nwg, G, c;
    __device__ void init(int M, int N, int G_, int c_) { nM = M / BM; nN = N / BM; nwg = nM * nN; G = G_; c = c_; }
    __device__ bool next(int i, Unit& u) const {
        const long L = (long)i * G + c; if (L >= nwg) return false;
        int wgid = (int)L; { const int q = nwg / NXCD, r = nwg % NXCD, xcd = wgid % NXCD, off = wgid / NXCD; wgid = (xcd < r ? xcd * (q + 1) : r * (q + 1) + (xcd - r) * q) + off; }
        const int nig = WGM * nN, gid = wgid / nig, fm = gid * WGM, gsz = (nM - fm) < WGM ? (nM - fm) : WGM;
        u.pm = fm + ((wgid % nig) % gsz); u.pn = (wgid % nig) / gsz; return true;
    }
};
template <class Epi>
__device__ __forceinline__ void gemm_phase(LAS unsigned char* lds, const Gemm g, const StaticOrder& S, Epi& E) {
    const int tid = opaque_tid(), wid = __builtin_amdgcn_readfirstlane(tid >> 6), lane = tid & 63, wr = wid >> 2, wc = wid & 3, fr = lane & 15, fq = lane >> 4;
    int K = g.K, lda = g.lda; asm volatile("" : "+s"(K), "+s"(lda));
    const int nt = K / BK;
    unsigned voffA[2], voffB[2];
#pragma unroll
    for (int i = 0; i < 2; ++i) { int R, C; stage_rc(tid * 16 + i * 8192, R, C); const int Rb = Epi::PERM ? ((R & ~31) + perm32(R & 31)) : R; voffA[i] = (unsigned)(R * lda + C) * 2u; voffB[i] = (unsigned)(Rb * K + C) * 2u; }
    const size_t kstep = (size_t)(BK * 2);
    const size_t hstepA = (size_t)HALF * lda * 2, hstepB = (size_t)HALF * K * 2;
    const size_t tstepA = 2 * hstepA, tstepB = 2 * hstepB;
    const unsigned ldsw = (unsigned)wid * 1024u;
    const int aoff = lds_byte(wr * 64 + fr, fq * 8), boff = lds_byte(wc * 32 + fr, fq * 8);
#define PG8_SA(b, h) (((b) * 2 + (h)) * HTB)
#define PG8_SB(b, h) ((4 + (b) * 2 + (h)) * HTB)
#define PG8_STAGE(bufoff, gbase, voff) do { _Pragma("unroll") for (int _i = 0; _i < 2; ++_i) \
        __builtin_amdgcn_global_load_lds((const unsigned*)((const char*)(gbase) + (voff)[_i]), (LAS unsigned*)(lds + (bufoff) + ldsw + _i * 8192), 16, 0, 0); } while (0)
#define PG8_LDA(dst, b, h) do { _Pragma("unroll") for (int m = 0; m < 4; ++m) _Pragma("unroll") for (int k = 0; k < 2; ++k) dst[m][k] = *(const LAS bf16x8*)(lds + PG8_SA(b, h) + aoff + m * 2048 + k * 1024); } while (0)
#define PG8_LDB(dst, b, h) do { _Pragma("unroll") for (int n = 0; n < 2; ++n) _Pragma("unroll") for (int k = 0; k < 2; ++k) dst[n][k] = *(const LAS bf16x8*)(lds + PG8_SB(b, h) + boff + n * 2048 + k * 1024); } while (0)
#define PG8_MMA(ai, bj, At, Bt) do { __builtin_amdgcn_s_setprio(1); _Pragma("unroll") for (int m = 0; m < 4; ++m) _Pragma("unroll") for (int n = 0; n < 2; ++n) _Pragma("unroll") for (int k = 0; k < 2; ++k) \
        acc[ai][bj][m][n] = __builtin_amdgcn_mfma_f32_16x16x32_bf16(Bt[n][k], At[m][k], acc[ai][bj][m][n], 0, 0, 0); __builtin_amdgcn_s_setprio(0); } while (0)
#define PG8_WAIT_V(n) asm volatile("s_waitcnt vmcnt(" #n ")" ::: "memory")
#define PG8_WAIT_L(n) asm volatile("s_waitcnt lgkmcnt(" #n ")" ::: "memory")
#define PG8_BAR __builtin_amdgcn_s_barrier()
#define PG8_SCHED __builtin_amdgcn_sched_barrier(0)
    Unit cur, nxt; int ui = 0;
    if (!S.next(0, cur)) return;
    f32x4 acc[2][2][4][2];
#pragma unroll
    for (int a = 0; a < 2; ++a)
#pragma unroll
        for (int b = 0; b < 2; ++b)
#pragma unroll
            for (int m = 0; m < 4; ++m)
#pragma unroll
                for (int n = 0; n < 2; ++n) acc[a][b][m][n] = (f32x4){0.f, 0.f, 0.f, 0.f};
    bf16x8 At[4][2], B0[2][2], B1[2][2];
    const char* cA = (const char*)g.A + (size_t)cur.pm * tstepA; const char* cB = (const char*)g.Bt + (size_t)cur.pn * tstepB;
    PG8_STAGE(PG8_SB(0, 0), cB, voffB); PG8_STAGE(PG8_SA(0, 0), cA, voffA); PG8_STAGE(PG8_SB(0, 1), cB + hstepB, voffB); PG8_STAGE(PG8_SA(0, 1), cA + hstepA, voffA);
    if (wr == 1) PG8_BAR;
    PG8_WAIT_V(4); PG8_BAR;
    PG8_STAGE(PG8_SB(1, 0), cB + kstep, voffB); PG8_STAGE(PG8_SA(1, 0), cA + kstep, voffA); PG8_STAGE(PG8_SB(1, 1), cB + hstepB + kstep, voffB);
    PG8_WAIT_V(6); PG8_BAR;
    for (;;) {
        const bool has_next = S.next(ui + 1, nxt);
        const char* nA = has_next ? (const char*)g.A + (size_t)nxt.pm * tstepA : cA; const char* nB = has_next ? (const char*)g.Bt + (size_t)nxt.pn * tstepB : cB;
        for (int t = 0; t < nt; t += 2) {
            const bool last = (t == nt - 2);
            const char* a1 = cA + (size_t)(t + 1) * kstep;
            const char* a2 = last ? nA : cA + (size_t)(t + 2) * kstep; const char* b2 = last ? nB : cB + (size_t)(t + 2) * kstep;
            const char* a3 = a2 + kstep; const char* b3 = b2 + kstep;
            PG8_LDB(B0, 0, 0); PG8_SCHED; PG8_LDA(At, 0, 0); PG8_STAGE(PG8_SA(1, 1), a1 + hstepA, voffA);
            PG8_WAIT_L(8); PG8_BAR; PG8_WAIT_L(0); PG8_MMA(0, 0, At, B0); PG8_BAR; PG8_SCHED;
            PG8_LDB(B1, 0, 1); PG8_STAGE(PG8_SB(0, 0), b2, voffB);
            PG8_BAR; PG8_WAIT_L(0); PG8_MMA(0, 1, At, B1); PG8_BAR;
            PG8_LDA(At, 0, 1); PG8_STAGE(PG8_SA(0, 0), a2, voffA);
            PG8_BAR; PG8_WAIT_L(0); PG8_MMA(1, 0, At, B0); PG8_BAR; PG8_SCHED;
            PG8_STAGE(PG8_SB(0, 1), b2 + hstepB, voffB);
            PG8_WAIT_V(6); PG8_BAR; PG8_MMA(1, 1, At, B1); PG8_BAR;
            PG8_LDB(B0, 1, 0); PG8_SCHED; PG8_LDA(At, 1, 0); PG8_STAGE(PG8_SA(0, 1), a2 + hstepA, voffA);
            PG8_WAIT_L(8); PG8_BAR; PG8_WAIT_L(0); PG8_MMA(0, 0, At, B0); PG8_BAR; PG8_SCHED;
            PG8_LDB(B1, 1, 1); PG8_STAGE(PG8_SB(1, 0), b3, voffB);
            PG8_BAR; PG8_WAIT_L(0); PG8_MMA(0, 1, At, B1); PG8_BAR;
            PG8_LDA(At, 1, 1); PG8_STAGE(PG8_SA(1, 0), a3, voffA);
            PG8_BAR; PG8_WAIT_L(0); PG8_MMA(1, 0, At, B0); PG8_BAR; PG8_SCHED;
            PG8_STAGE(PG8_SB(1, 1), b3 + hstepB, voffB);
            PG8_WAIT_V(6); PG8_BAR; PG8_MMA(1, 1, At, B1); PG8_BAR;
        }
        { int fr2 = fr, fq2 = fq, wr2 = wr, wc2 = wc; asm volatile("" : "+v"(fr2), "+v"(fq2), "+s"(wr2), "+s"(wc2));
          E(acc, cur, wr2, wc2, fr2, fq2); }
        if (!has_next) break;
#pragma unroll
        for (int a = 0; a < 2; ++a)
#pragma unroll
            for (int b = 0; b < 2; ++b)
#pragma unroll
                for (int m = 0; m < 4; ++m)
#pragma unroll
                    for (int n = 0; n < 2; ++n) acc[a][b][m][n] = (f32x4){0.f, 0.f, 0.f, 0.f};
        cur = nxt; cA = nA; cB = nB; ++ui;
    }
    PG8_WAIT_V(0);
    if (wr == 0) PG8_BAR;
    PG8_BAR;
#undef PG8_SA
#undef PG8_SB
#undef PG8_STAGE
#undef PG8_LDA
#undef PG8_LDB
#undef PG8_MMA
#undef PG8_WAIT_V
#undef PG8_WAIT_L
#undef PG8_BAR
#undef PG8_SCHED
}
}
using pg8::Unit;
typedef f32x4 AccT[2][2][4][2];

struct EpiFfnUp {
    static constexpr bool PERM = true;
    unsigned char* ws; int last_pm; float rsc[8];
    __device__ __forceinline__ void operator()(const AccT& acc, const Unit& u, int wr, int wc, int fr, int fq) {
        bf16_t* act = (bf16_t*)(ws + T_ACT); const float* ssx = (const float*)(ws + OFF_SSX);
        const int row0 = u.pm * 256 + wr * 64 + fr, col0 = u.pn * 128 + wc * 32 + 8 * fq;
        if (u.pm != last_pm) {
            last_pm = u.pm;
#pragma unroll
            for (int ai = 0; ai < 2; ++ai)
#pragma unroll
                for (int m = 0; m < 4; ++m) rsc[ai * 4 + m] = rstd16q(ssx, row0 + ai * 128 + m * 16, fq);
        }
#pragma unroll
        for (int ai = 0; ai < 2; ++ai)
#pragma unroll
            for (int m = 0; m < 4; ++m) {
                const int row = row0 + ai * 128 + m * 16; const float rs = rsc[ai * 4 + m];
                float o[8];
#pragma unroll
                for (int n = 0; n < 2; ++n)
#pragma unroll
                    for (int j = 0; j < 4; ++j) { const float gv = acc[ai][0][m][n][j] * rs, uv = acc[ai][1][m][n][j] * rs; o[4 * n + j] = gv * __builtin_amdgcn_rcpf(1.f + __expf(-gv)) * uv; }
                u32x4 w; w.x = cvt_pk_bf16(o[0], o[1]); w.y = cvt_pk_bf16(o[2], o[3]); w.z = cvt_pk_bf16(o[4], o[5]); w.w = cvt_pk_bf16(o[6], o[7]);
                *(u32x4*)(act + (size_t)row * FF + col0) = w;
            }
    }
};
struct EpiResid {
    static constexpr bool PERM = true;
    unsigned char* ws; float alpha;
    __device__ __forceinline__ void operator()(const AccT& acc, const Unit& u, int wr, int wc, int fr, int fq) const {
        bf16_t* xb = (bf16_t*)(ws + OFF_XB); float* ssx = (float*)(ws + OFF_SSX);
        const int row0 = u.pm * 256 + wr * 64 + fr, col0 = u.pn * 256 + wc * 32 + 8 * fq;
#pragma unroll
        for (int ai = 0; ai < 2; ++ai) {
            u32x4 xo[4][2];
#pragma unroll
            for (int m = 0; m < 4; ++m)
#pragma unroll
                for (int bj = 0; bj < 2; ++bj) xo[m][bj] = *(const u32x4*)(xb + (size_t)(row0 + ai * 128 + m * 16) * DM + col0 + bj * 128);
#pragma unroll
            for (int m = 0; m < 4; ++m) {
                const int row = row0 + ai * 128 + m * 16; float ss = 0.f;
#pragma unroll
                for (int bj = 0; bj < 2; ++bj) {
                    const size_t idx = (size_t)row * DM + col0 + bj * 128;
                    const u32x4 xw = xo[m][bj];
                    const f32x4 xo0 = {bflo(xw.x), bfhi(xw.x), bflo(xw.y), bfhi(xw.y)}, xo1 = {bflo(xw.z), bfhi(xw.z), bflo(xw.w), bfhi(xw.w)};
                    const f32x4 x0 = xo0 + acc[ai][bj][m][0] * alpha, x1 = xo1 + acc[ai][bj][m][1] * alpha;
                    u32x4 w; w.x = cvt_pk_bf16(x0[0], x0[1]); w.y = cvt_pk_bf16(x0[2], x0[3]); w.z = cvt_pk_bf16(x1[0], x1[1]); w.w = cvt_pk_bf16(x1[2], x1[3]); *(u32x4*)(xb + idx) = w;
                    ss += x0[0] * x0[0] + x0[1] * x0[1] + x0[2] * x0[2] + x0[3] * x0[3] + x1[0] * x1[0] + x1[1] * x1[1] + x1[2] * x1[2] + x1[3] * x1[3];
                }
                ss = quad_sum(ss);
                if (fq == 0) ssx[(size_t)row * 16 + u.pn * 4 + wc] = ss;
            }
        }
    }
};
struct EpiWin {
    static constexpr bool PERM = false;
    unsigned char* ws;
    __device__ __forceinline__ void operator()(const AccT& acc, const Unit& u, int wr, int wc, int fr, int fq) const {
        const float* ssx = (const float*)(ws + OFF_SSX); bf16_t* hyt = (bf16_t*)(ws + T_HYT); bf16_t* cqb = (bf16_t*)(ws + T_CQB); bf16_t* ckvb = (bf16_t*)(ws + T_CKVB);
        float* sscq = (float*)(ws + T_SSCQ); float* ssckv = (float*)(ws + T_SSCKV); bf16_t* kr = (bf16_t*)(ws + T_KR); bf16_t* gin = (bf16_t*)(ws + T_GIN); float* gg = (float*)(ws + T_GG); const float* rope = (const float*)(ws + OFF_ROPE);
        const int row0 = u.pm * 256 + wr * 64 + fr, pn = u.pn;
        if (pn < 3) {
#pragma unroll
            for (int ai = 0; ai < 2; ++ai)
#pragma unroll
                for (int m = 0; m < 4; ++m) {
                    const int row = row0 + ai * 128 + m * 16; const float rs = rstd16q(ssx, row, fq);
#pragma unroll
                    for (int bj = 0; bj < 2; ++bj)
#pragma unroll
                        for (int n = 0; n < 2; ++n)
#pragma unroll
                            for (int j = 0; j < 4; ++j) { const int col = pn * 256 + bj * 128 + wc * 32 + n * 16 + 4 * fq + j; hyt[(size_t)col * NTOK + row] = f2bf(acc[ai][bj][m][n][j] * rs); }
                }
        } else if (pn == 3 || pn == 4) {
            bf16_t* dst = pn == 3 ? cqb : ckvb; float* sdst = pn == 3 ? sscq : ssckv;
#pragma unroll
            for (int ai = 0; ai < 2; ++ai)
#pragma unroll
                for (int m = 0; m < 4; ++m) {
                    const int row = row0 + ai * 128 + m * 16; const float rs = rstd16q(ssx, row, fq);
                    float ss = 0.f;
#pragma unroll
                    for (int bj = 0; bj < 2; ++bj)
#pragma unroll
                        for (int n = 0; n < 2; ++n) {
                            const f32x4 v = acc[ai][bj][m][n] * rs; const float q = v[0] * v[0] + v[1] * v[1] + v[2] * v[2] + v[3] * v[3];
                            if (bj == 0 || pn == 3) ss += q;
                            u32x2 w; w.x = cvt_pk_bf16(v[0], v[1]); w.y = cvt_pk_bf16(v[2], v[3]);
                            *(u32x2*)(dst + (size_t)row * 256 + bj * 128 + wc * 32 + n * 16 + 4 * fq) = w;
                        }
                    ss = quad_sum(ss);
                    if (fq == 0) sdst[(size_t)row * 4 + wc] = ss;
                    if (pn == 4) {
                        if (wc < 2) {
                            const int s0 = 16 * wc + 4 * fq; const float* rp = rope + (size_t)(row & (SEQ - 1)) * 64 + s0;
                            const f32x4 cs = *(const f32x4*)rp, sn = *(const f32x4*)(rp + 32);
                            const f32x4 a = acc[ai][1][m][0] * rs, b = acc[ai][1][m][1] * rs;
                            const f32x4 oa = a * cs - b * sn, ob = a * sn + b * cs;
                            u32x2 w; w.x = cvt_pk_bf16(oa[0], oa[1]); w.y = cvt_pk_bf16(oa[2], oa[3]); *(u32x2*)(kr + (size_t)row * 64 + s0) = w;
                            w.x = cvt_pk_bf16(ob[0], ob[1]); w.y = cvt_pk_bf16(ob[2], ob[3]); *(u32x2*)(kr + (size_t)row * 64 + s0 + 32) = w;
                        } else {
#pragma unroll
                            for (int n = 0; n < 2; ++n) {
                                const f32x4 v = acc[ai][1][m][n] * rs; u32x2 w; w.x = cvt_pk_bf16(v[0], v[1]); w.y = cvt_pk_bf16(v[2], v[3]);
                                *(u32x2*)(gin + (size_t)row * 832 + (1152 + wc * 32 + n * 16 + 4 * fq - 1216)) = w;
                            }
                        }
                    }
                }
        } else {
#pragma unroll
            for (int ai = 0; ai < 2; ++ai)
#pragma unroll
                for (int m = 0; m < 4; ++m) {
                    const int row = row0 + ai * 128 + m * 16; const float rs = rstd16q(ssx, row, fq);
#pragma unroll
                    for (int bj = 0; bj < 2; ++bj)
#pragma unroll
                        for (int n = 0; n < 2; ++n) {
                            const f32x4 v = acc[ai][bj][m][n] * rs; const int col = pn * 256 + bj * 128 + wc * 32 + n * 16 + 4 * fq;
                            if (pn == 6 && bj == 1 && wc == 2) *(f32x4*)(gg + (size_t)row * 32 + n * 16 + 4 * fq) = v;
                            u32x2 w; w.x = cvt_pk_bf16(v[0], v[1]); w.y = cvt_pk_bf16(v[2], v[3]);
                            *(u32x2*)(gin + (size_t)row * 832 + (col - 1216)) = w;
                        }
                }
        }
    }
};
struct EpiUq {
    static constexpr bool PERM = false;
    unsigned char* ws;
    __device__ __forceinline__ void operator()(const AccT& acc, const Unit& u, int wr, int wc, int fr, int fq) const {
        const float* sscq = (const float*)(ws + T_SSCQ); bf16_t* qn = (bf16_t*)(ws + T_QN); bf16_t* qr = (bf16_t*)(ws + T_QR); const float* rope = (const float*)(ws + OFF_ROPE);
        const int row0 = u.pm * 256 + wr * 64 + fr, pn = u.pn;
        if (pn < 2) {
#pragma unroll
            for (int ai = 0; ai < 2; ++ai)
#pragma unroll
                for (int m = 0; m < 4; ++m) {
                    const int row = row0 + ai * 128 + m * 16; const float rs = rstd4(sscq, row, 1.0f / 256.0f);
                    const int b = row >> 13, s = row & (SEQ - 1);
#pragma unroll
                    for (int bj = 0; bj < 2; ++bj) { const int h = 2 * pn + bj; bf16_t* rp = qn + ((size_t)(b * 4 + h) * SEQ + s) * 128 + wc * 32 + 4 * fq;
#pragma unroll
                        for (int n = 0; n < 2; ++n) { const f32x4 v = acc[ai][bj][m][n] * rs; u32x2 w; w.x = cvt_pk_bf16(v[0], v[1]); w.y = cvt_pk_bf16(v[2], v[3]); *(u32x2*)(rp + n * 16) = w; } }
                }
        } else {
            const int s0 = 16 * (wc & 1) + 4 * fq;
#pragma unroll
            for (int ai = 0; ai < 2; ++ai)
#pragma unroll
                for (int m = 0; m < 4; ++m) {
                    const int row = row0 + ai * 128 + m * 16; const float rs = rstd4(sscq, row, 1.0f / 256.0f);
                    const int b = row >> 13, s = row & (SEQ - 1);
                    const float* rt = rope + (size_t)s * 64 + s0; const f32x4 cs = *(const f32x4*)rt, sn = *(const f32x4*)(rt + 32);
#pragma unroll
                    for (int bj = 0; bj < 2; ++bj) { const int h = 2 * bj + (wc >> 1); bf16_t* rp = qr + ((size_t)(b * 4 + h) * SEQ + s) * 64 + s0;
                        const f32x4 a = acc[ai][bj][m][0] * rs, bb = acc[ai][bj][m][1] * rs;
                        const f32x4 oa = a * cs - bb * sn, ob = a * sn + bb * cs;
                        u32x2 w; w.x = cvt_pk_bf16(oa[0], oa[1]); w.y = cvt_pk_bf16(oa[2], oa[3]); *(u32x2*)rp = w;
                        w.x = cvt_pk_bf16(ob[0], ob[1]); w.y = cvt_pk_bf16(ob[2], ob[3]); *(u32x2*)(rp + 32) = w; }
                }
        }
    }
};
struct EpiUkv {
    static constexpr bool PERM = true;
    unsigned char* ws;
    __device__ __forceinline__ void operator()(const AccT& acc, const Unit& u, int wr, int wc, int fr, int fq) const {
        const float* ssckv = (const float*)(ws + T_SSCKV); bf16_t* kn = (bf16_t*)(ws + T_KN); bf16_t* vv = (bf16_t*)(ws + T_V);
        const int row0 = u.pm * 256 + wr * 64 + fr, h = u.pn;
#pragma unroll
        for (int ai = 0; ai < 2; ++ai)
#pragma unroll
            for (int m = 0; m < 4; ++m) {
                const int row = row0 + ai * 128 + m * 16; const float rs = rstd4(ssckv, row, 1.0f / 128.0f);
                const int b = row >> 13, s = row & (SEQ - 1); const size_t base = ((size_t)(b * 4 + h) * SEQ + s) * 128 + wc * 32 + 8 * fq;
#pragma unroll
                for (int bj = 0; bj < 2; ++bj) { bf16_t* rp = (bj == 0 ? kn : vv) + base;
                    const f32x4 v0 = acc[ai][bj][m][0] * rs, v1 = acc[ai][bj][m][1] * rs;
                    u32x4 w; w.x = cvt_pk_bf16(v0[0], v0[1]); w.y = cvt_pk_bf16(v0[2], v0[3]); w.z = cvt_pk_bf16(v1[0], v1[1]); w.w = cvt_pk_bf16(v1[2], v1[3]);
                    *(u32x4*)rp = w; }
            }
    }
};
__device__ __forceinline__ int map_col(int type, int nd, int& which) {
    which = 0;
    if (type == 1) { const int t = nd >> 8, r = nd & 255; which = r >> 7; return t * 128 + (r & 127); }
    if (type == 2) { if (nd >= 2016) return -1; if (nd >= 1152 && nd < 1216) { const int P = nd - 1152, w = P >> 5, n = (P >> 4) & 1, i = P & 15; return 1152 + 16 * w + i + 32 * n; } return nd; }
    if (type == 3) { if (nd < 512) { const int h = nd >> 7, d = nd & 127; return h * 192 + d; } const int Pp = nd - 512, h = Pp >> 6, P = Pp & 63; const int s = 16 * (P >> 5) + (P & 15) + 32 * ((P >> 4) & 1); return h * 192 + 128 + s; }
    return nd;
}
struct PrepJob { const float* src; const float* src2; const float* gain; bf16_t* dst; int Ks, Kd, Nsrc, Nd, type; };
__device__ __forceinline__ PrepJob prep_job(KP p, unsigned char* ws, int j) {
    const int l = j >> 3;
    switch (j & 7) {
        case 0: return PrepJob{p->in[2] + (size_t)l * DM * FF, p->in[3] + (size_t)l * DM * FF, p->in[1] + l * DM, (bf16_t*)(ws + OFF_WUP + (l * 2 + 0) * SZ_WUP), 1024, 1024, FF, 5632, 1};
        case 1: return PrepJob{p->in[30] + (size_t)l * DM * FF, p->in[31] + (size_t)l * DM * FF, p->in[29] + l * DM, (bf16_t*)(ws + OFF_WUP + (l * 2 + 1) * SZ_WUP), 1024, 1024, FF, 5632, 1};
        case 2: return PrepJob{p->in[4] + (size_t)l * FF * DM, nullptr, nullptr, (bf16_t*)(ws + OFF_WDN + (l * 2 + 0) * SZ_WDN), FF, FF, DM, DM, 0};
        case 3: return PrepJob{p->in[32] + (size_t)l * FF * DM, nullptr, nullptr, (bf16_t*)(ws + OFF_WDN + (l * 2 + 1) * SZ_WDN), FF, FF, DM, DM, 0};
        case 4: return PrepJob{p->in[6] + (size_t)l * DM * 2016, nullptr, p->in[5] + l * DM, (bf16_t*)(ws + OFF_WIN + l * SZ_WIN), 1024, 1024, 2016, 2048, 2};
        case 5: return PrepJob{p->in[28] + (size_t)l * DM * DM, nullptr, nullptr, (bf16_t*)(ws + OFF_WOUT + l * SZ_WOUT), 1024, 1024, 1024, 1024, 0};
        case 6: return PrepJob{p->in[19] + (size_t)l * 256 * 768, nullptr, p->in[18] + l * 256, (bf16_t*)(ws + OFF_WUQ + l * SZ_WUQ), 256, 256, 768, 768, 3};
        default: return PrepJob{p->in[21] + (size_t)l * 128 * 1024, nullptr, p->in[20] + l * 128, (bf16_t*)(ws + OFF_WUKV + l * SZ_WUKV), 128, 256, 1024, 1024, 0};
    }
}
__device__ __forceinline__ int prep_job_tiles(int j) { const int k = j & 7; return k < 2 ? 352 : k < 4 ? 176 : k == 4 ? 128 : k == 5 ? 64 : k == 6 ? 12 : 16; }
__device__ __forceinline__ void phase_prep(KP p, float* lds) {
    unsigned char* ws = opaque_ptr(p->ws); const int tid = opaque_tid(), wid = tid >> 6, lane = tid & 63;
    { float* tile = lds; constexpr int TOTAL = 2 * (352 * 2 + 176 * 2 + 128 + 64 + 12 + 16);
      float v[32]; bf16_t* dstp = nullptr; int Kd_c = 0, nd0_c = 0, k0_c = 0;
#define PREP_ISSUE(TT) do { int j_ = 0, t_ = (TT); \
          while (t_ >= prep_job_tiles(j_)) { t_ -= prep_job_tiles(j_); ++j_; } \
          const PrepJob J = prep_job(p, ws, j_); \
          const int ntk_ = J.Kd / 256, nd0_ = (t_ / ntk_) * 64, k0_ = (t_ % ntk_) * 256; \
          const int nn_ = tid & 63, kk_ = tid >> 6; int which_; const int ns_ = map_col(J.type, nd0_ + nn_, which_); const float* sp_ = which_ ? J.src2 : J.src; \
          _Pragma("unroll") for (int sub = 0; sub < 4; ++sub) _Pragma("unroll") for (int r = 0; r < 8; ++r) { const int k_ = k0_ + sub * 64 + kk_ + 8 * r; float x_ = 0.f; \
              if (ns_ >= 0 && k_ < J.Ks) { x_ = sp_[(size_t)k_ * J.Nsrc + ns_]; if (J.gain) x_ *= J.gain[k_]; } v[sub * 8 + r] = x_; } \
          dstp = J.dst; Kd_c = J.Kd; nd0_c = nd0_; k0_c = k0_; } while (0)
      int tt = opaque_bid();
      PREP_ISSUE(tt < TOTAL ? tt : TOTAL - 1);
      for (; tt < TOTAL; tt += gridDim.x) {
          { const int nn = tid & 63, kk = tid >> 6;
#pragma unroll
            for (int sub = 0; sub < 4; ++sub)
#pragma unroll
                for (int r = 0; r < 8; ++r) tile[sub * (64 * 65) + nn * 65 + kk + 8 * r] = v[sub * 8 + r]; }
          bf16_t* dcur = dstp; const int Kd = Kd_c, nd0 = nd0_c, k0 = k0_c;
          PREP_ISSUE(tt + (int)gridDim.x < TOTAL ? tt + (int)gridDim.x : TOTAL - 1);
          __syncthreads();
          { const int row = tid >> 3, kc = (tid & 7) * 8;
#pragma unroll
            for (int sub = 0; sub < 4; ++sub) { const float* tp = tile + sub * (64 * 65) + row * 65 + kc;
              u32x4 w; w.x = cvt_pk_bf16(tp[0], tp[1]); w.y = cvt_pk_bf16(tp[2], tp[3]); w.z = cvt_pk_bf16(tp[4], tp[5]); w.w = cvt_pk_bf16(tp[6], tp[7]);
              *(u32x4*)(dcur + (size_t)(nd0 + row) * Kd + k0 + sub * 64 + kc) = w; } }
          __syncthreads();
      } }
    { const float* x = p->in[0]; bf16_t* xb = (bf16_t*)(ws + OFF_XB); float* ssx = (float*)(ws + OFF_SSX);
      for (int rb = (opaque_bid() * 8 + wid) * 4; rb < NTOK; rb += gridDim.x * 32) {
          f32x4 v[4][4];
#pragma unroll
          for (int q = 0; q < 4; ++q)
#pragma unroll
              for (int i = 0; i < 4; ++i) v[q][i] = *(const f32x4*)(x + (size_t)(rb + q) * DM + lane * 16 + 4 * i);
#pragma unroll
          for (int q = 0; q < 4; ++q) { const int row = rb + q; float ss = 0.f;
#pragma unroll
              for (int i = 0; i < 4; ++i) ss += v[q][i][0] * v[q][i][0] + v[q][i][1] * v[q][i][1] + v[q][i][2] * v[q][i][2] + v[q][i][3] * v[q][i][3];
              u32x4 w0, w1; w0.x = cvt_pk_bf16(v[q][0][0], v[q][0][1]); w0.y = cvt_pk_bf16(v[q][0][2], v[q][0][3]); w0.z = cvt_pk_bf16(v[q][1][0], v[q][1][1]); w0.w = cvt_pk_bf16(v[q][1][2], v[q][1][3]);
              w1.x = cvt_pk_bf16(v[q][2][0], v[q][2][1]); w1.y = cvt_pk_bf16(v[q][2][2], v[q][2][3]); w1.z = cvt_pk_bf16(v[q][3][0], v[q][3][1]); w1.w = cvt_pk_bf16(v[q][3][2], v[q][3][3]);
              *(u32x4*)(xb + (size_t)row * DM + lane * 16) = w0; *(u32x4*)(xb + (size_t)row * DM + lane * 16 + 8) = w1;
              ss += __shfl_xor(ss, 1); ss += __shfl_xor(ss, 2);
              if ((lane & 3) == 0) ssx[(size_t)row * 16 + (lane >> 2)] = ss; }
      } }
    { float* rt = (float*)(ws + OFF_ROPE);
      for (int i = opaque_bid() * NTHR + tid; i < 8192 * 32; i += gridDim.x * NTHR) {
          const int pos = i >> 5, sx = i & 31; const float inv = __builtin_amdgcn_exp2f(-(float)sx * (13.287712379549449f / 32.0f));
          float rev = (float)pos * inv * 0.15915494309189535f; rev -= floorf(rev);
          rt[pos * 64 + sx] = cos_rev(rev); rt[pos * 64 + 32 + sx] = sin_rev(rev);
      } }
    { float* h2t = (float*)(ws + OFF_H2T); float* zs = lds; float* h1s = lds + 8 * 40;
      const int pp = tid >> 6, j = tid & 63;
      for (int l = 0; l < 2; ++l) {
          const float* w1 = p->in[9] + l * 33 * 64; const float* w2 = p->in[12] + l * 64 * 64;
          float w1c[33], w2c[64];
#pragma unroll
          for (int i = 0; i < 33; ++i) w1c[i] = w1[i * 64 + j];
#pragma unroll
          for (int i = 0; i < 64; ++i) w2c[i] = w2[i * 64 + j];
          const float b1 = p->in[10][l * 64 + j], f1 = p->in[11][l * 64 + j], b2 = p->in[13][l * 64 + j], f2 = p->in[14][l * 64 + j];
          for (int it = opaque_bid(); it < 1024; it += gridDim.x) {
              const int m0 = it * 8;
              __syncthreads();
              if (j < 33) { const int m = m0 + pp; float z;
                  if (j == 0) z = (float)m * (1.0f / 8191.0f);
                  else { const int bi = (j - 1) & 15; const float band = 1e-4f + (float)bi * ((15.0f - 1e-4f) / 15.0f); float rev = (float)m * band * (1.0f / 8192.0f); rev -= floorf(rev);
                         z = (j <= 16) ? cos_rev(rev) : -sin_rev(rev); }
                  zs[pp * 40 + j] = z; }
              __syncthreads();
              float a = b1;
#pragma unroll
              for (int i = 0; i < 33; ++i) a += zs[pp * 40 + i] * w1c[i];
              h1s[pp * 64 + j] = fast_sin(f1 * a);
              __syncthreads();
              float c = b2;
#pragma unroll
              for (int i = 0; i < 64; ++i) c += h1s[pp * 64 + i] * w2c[i];
              h2t[((size_t)l * 64 + j) * 8192 + m0 + pp] = fast_sin(f2 * c);
          }
      } }
}

namespace att {
constexpr float SCALE = 0.07216878364870322f;
constexpr float THR = 8.f;
constexpr int SHM_V = 64 * 128 * 2, SHM_K = 64 * 128 * 2, SHM_KR = 64 * 64 * 2;
constexpr int OFF_K = 2 * SHM_V, OFF_KR = OFF_K + 2 * SHM_K, OFF_QR = OFF_KR + 2 * SHM_KR, OFF_WS = OFF_QR + 8 * 8192, SHM_TOTAL = OFF_WS + 8 * 64 * 4;
static_assert(SHM_TOTAL <= LDS_BYTES, "attention LDS");
#define KSWZ(row, colB) ((row) * 256 + ((colB) ^ (((row) & 7) << 4)))
#define KRSWZ(row, chunk) ((row) * 128 + ((((chunk) ^ (((row) >> 1) & 7))) << 4))
#define SBAR() __builtin_amdgcn_sched_barrier(0)
__device__ __forceinline__ int crow(int r, int hi) { return (r & 3) + 8 * (r >> 2) + 4 * hi; }
__device__ __forceinline__ void partialSM(f32x16& p0, f32x16& p1, float& m_reg, float& mn, float& alpha) {
    constexpr float C = SCALE * 1.4426950408889634f;
    float pmax = p0[0];
#pragma unroll
    for (int r = 1; r < 16; ++r) pmax = fmaxf(pmax, p0[r]);
#pragma unroll
    for (int r = 0; r < 16; ++r) pmax = fmaxf(pmax, p1[r]);
    { auto rr = __builtin_amdgcn_permlane32_swap(__float_as_uint(pmax), __float_as_uint(pmax), false, false); pmax = fmaxf(__uint_as_float(rr[0]), __uint_as_float(rr[1])); }
    if (__builtin_expect(__all(pmax - m_reg <= THR / SCALE), 1)) { mn = m_reg; alpha = 1.f; }
    else { mn = fmaxf(m_reg, pmax); alpha = __builtin_amdgcn_exp2f((m_reg - mn) * C); m_reg = mn; }
    const float mnC = -mn * C;
#pragma unroll
    for (int r = 0; r < 16; ++r) p0[r] = fmaf(p0[r], C, mnC);
#pragma unroll
    for (int r = 0; r < 16; ++r) p1[r] = fmaf(p1[r], C, mnC);
#pragma unroll
    for (int r = 0; r < 16; ++r) p0[r] = __builtin_amdgcn_exp2f(p0[r]);
}
__device__ __forceinline__ void finishSM(f32x16& p0, f32x16& p1, float alpha, float& l_reg, bf16x8& pa0, bf16x8& pa1, bf16x8& pa2, bf16x8& pa3) {
#pragma unroll
    for (int r = 0; r < 16; ++r) p1[r] = __builtin_amdgcn_exp2f(p1[r]);
    float ps = 0;
#pragma unroll
    for (int r = 0; r < 16; ++r) ps += p0[r];
#pragma unroll
    for (int r = 0; r < 16; ++r) ps += p1[r];
    { auto rr = __builtin_amdgcn_permlane32_swap(__float_as_uint(ps), __float_as_uint(ps), false, false); ps = __uint_as_float(rr[0]) + __uint_as_float(rr[1]); }
    l_reg = l_reg * alpha + ps;
#define PK4(P, BASE, OUT) do { unsigned a0 = cvt_pk_bf16(P[BASE + 0], P[BASE + 1]), a1 = cvt_pk_bf16(P[BASE + 2], P[BASE + 3]);   \
    unsigned b0 = cvt_pk_bf16(P[BASE + 4], P[BASE + 5]), b1 = cvt_pk_bf16(P[BASE + 6], P[BASE + 7]);                              \
    auto r0 = __builtin_amdgcn_permlane32_swap(a0, b0, false, false); auto r1 = __builtin_amdgcn_permlane32_swap(a1, b1, false, false); \
    u32x4 w = {r0[0], r1[0], r0[1], r1[1]}; OUT = *reinterpret_cast<bf16x8*>(&w); } while (0)
    PK4(p0, 0, pa0); PK4(p0, 8, pa1); PK4(p1, 0, pa2); PK4(p1, 8, pa3);
#undef PK4
}
__device__ __forceinline__ void qkt(f32x16& p0, f32x16& p1, const char* Ks, const char* Krs, const bf16x8* qr, const char* qrl, int r32, int hi) {
    p0 = f32x16{}; p1 = f32x16{};
#pragma unroll
    for (int d0 = 0; d0 < 8; ++d0) { const int cb = (d0 * 16 + hi * 8) * 2;
        const bf16x8 b0 = *reinterpret_cast<const bf16x8*>(Ks + KSWZ(r32, cb));
        const bf16x8 b1 = *reinterpret_cast<const bf16x8*>(Ks + KSWZ(32 + r32, cb));
        const bf16x8 q = d0 < 4 ? qr[d0 & 3] : *reinterpret_cast<const bf16x8*>(qrl + d0 * 1024);
        p0 = __builtin_amdgcn_mfma_f32_32x32x16_bf16(b0, q, p0, 0, 0, 0);
        p1 = __builtin_amdgcn_mfma_f32_32x32x16_bf16(b1, q, p1, 0, 0, 0); }
#pragma unroll
    for (int d0 = 0; d0 < 4; ++d0) { const int ch = d0 * 2 + hi;
        const bf16x8 b0 = *reinterpret_cast<const bf16x8*>(Krs + KRSWZ(r32, ch));
        const bf16x8 b1 = *reinterpret_cast<const bf16x8*>(Krs + KRSWZ(32 + r32, ch));
        const bf16x8 q = *reinterpret_cast<const bf16x8*>(qrl + d0 * 1024);
        p0 = __builtin_amdgcn_mfma_f32_32x32x16_bf16(b0, q, p0, 0, 0, 0);
        p1 = __builtin_amdgcn_mfma_f32_32x32x16_bf16(b1, q, p1, 0, 0, 0); }
}
__device__ __forceinline__ int v_st(int k, int c) { const int kk = (k & ~0xC) | ((k & 4) << 1) | ((k & 8) >> 1); return ((kk >> 3) * 4 + (c >> 5)) * 512 + ((kk & 7) * 32 + (c & 31)) * 2; }
__device__ __forceinline__ int v_rd_base(int lane) { return ((lane & 3) << 3) | (((lane >> 2) & 3) << 6) | (((lane >> 4) & 1) << 5) | (((lane >> 5) & 1) << 8); }
constexpr int v_rd_off(int d0, int ks, int half) { return d0 * 512 + ks * 4096 + half * 2048; }
template <int OFF> __device__ __forceinline__ s16x4 tr_read(int vb) { s16x4 r; asm volatile("ds_read_b64_tr_b16 %0, %1 offset:%2" : "=&v"(r) : "v"(vb), "i"(OFF) : "memory"); return r; }
template <int D0> __device__ __forceinline__ void pv_one(f32x16& od, int vb, bf16x8 pa0, bf16x8 pa1, bf16x8 pa2, bf16x8 pa3) {
    const s16x4 l0 = tr_read<v_rd_off(D0, 0, 0)>(vb), h0 = tr_read<v_rd_off(D0, 0, 1)>(vb), l1 = tr_read<v_rd_off(D0, 1, 0)>(vb), h1 = tr_read<v_rd_off(D0, 1, 1)>(vb);
    const s16x4 l2 = tr_read<v_rd_off(D0, 2, 0)>(vb), h2 = tr_read<v_rd_off(D0, 2, 1)>(vb), l3 = tr_read<v_rd_off(D0, 3, 0)>(vb), h3 = tr_read<v_rd_off(D0, 3, 1)>(vb);
    asm volatile("s_waitcnt lgkmcnt(0)" ::: "memory"); SBAR();
#define PK(L, H) (bf16x8){L[0], L[1], L[2], L[3], H[0], H[1], H[2], H[3]}
    od = __builtin_amdgcn_mfma_f32_32x32x16_bf16(pa0, PK(l0, h0), od, 0, 0, 0);
    od = __builtin_amdgcn_mfma_f32_32x32x16_bf16(pa1, PK(l1, h1), od, 0, 0, 0);
    od = __builtin_amdgcn_mfma_f32_32x32x16_bf16(pa2, PK(l2, h2), od, 0, 0, 0);
    od = __builtin_amdgcn_mfma_f32_32x32x16_bf16(pa3, PK(l3, h3), od, 0, 0, 0);
#undef PK
}
__device__ __forceinline__ void pv_d0(f32x16* o, int vb, bf16x8 pa0, bf16x8 pa1, bf16x8 pa2, bf16x8 pa3) {
    pv_one<0>(o[0], vb, pa0, pa1, pa2, pa3); pv_one<1>(o[1], vb, pa0, pa1, pa2, pa3); pv_one<2>(o[2], vb, pa0, pa1, pa2, pa3); pv_one<3>(o[3], vb, pa0, pa1, pa2, pa3);
}
__device__ __forceinline__ void attn_body(const bf16_t* __restrict__ Qb, const bf16_t* __restrict__ QRb, const bf16_t* __restrict__ Kh, const bf16_t* __restrict__ Krh,
                                          const bf16_t* __restrict__ Vh, bf16_t* __restrict__ Ob, int seq, char* lds) {
    const int tid = opaque_tid(), wid = tid >> 6, lane = tid & 63, r32 = lane & 31, hi = lane >> 5;
    char* V_lds = lds; char* K_lds = lds + OFF_K; char* Kr_lds = lds + OFF_KR; char* qrl = lds + OFF_QR + wid * 8192 + lane * 16;
    float* wsf = (float*)(lds + OFF_WS) + wid * 64; float* li_l = wsf; float* al_l = wsf + 32;
    float m_reg = -1e30f, l_reg = 0; f32x16 o[4] = {}; bf16x8 qr[4];
    __syncthreads();
    { const bf16_t* Qw = Qb + (long)(wid * 32 + r32) * 128 + hi * 8;
#pragma unroll
      for (int d0 = 0; d0 < 4; ++d0) qr[d0] = *reinterpret_cast<const bf16x8*>(Qw + d0 * 16);
#pragma unroll
      for (int d0 = 4; d0 < 8; ++d0) *reinterpret_cast<bf16x8*>(qrl + d0 * 1024) = *reinterpret_cast<const bf16x8*>(Qw + d0 * 16);
      const bf16_t* QRw = QRb + (long)(wid * 32 + r32) * 64 + hi * 8;
#pragma unroll
      for (int d0 = 0; d0 < 4; ++d0) *reinterpret_cast<bf16x8*>(qrl + d0 * 1024) = *reinterpret_cast<const bf16x8*>(QRw + d0 * 16); }
    const int sr = tid >> 4, sc = (tid & 15) * 8, vst0 = v_st(sr, sc), vst1 = v_st(32 + sr, sc);
    const int krr = tid >> 3, krc = tid & 7, krst = KRSWZ(krr, krc);
    const int vb0 = (int)(uintptr_t)V_lds + v_rd_base(lane);
    struct { bf16x8 vs0, vs1, ks0, ks1, kr; } sr_[1];
#define SLOAD(i, k0) do { sr_[i].vs0 = *reinterpret_cast<const bf16x8*>(&Vh[(long)((k0) + sr) * 128 + sc]); sr_[i].vs1 = *reinterpret_cast<const bf16x8*>(&Vh[(long)((k0) + 32 + sr) * 128 + sc]); \
    sr_[i].ks0 = *reinterpret_cast<const bf16x8*>(&Kh[(long)((k0) + sr) * 128 + sc]); sr_[i].ks1 = *reinterpret_cast<const bf16x8*>(&Kh[(long)((k0) + 32 + sr) * 128 + sc]); \
    sr_[i].kr = *reinterpret_cast<const bf16x8*>(&Krh[(long)((k0) + krr) * 64 + krc * 8]); } while (0)
#define SWRITE(b, i) do { *(bf16x8*)(V_lds + (b) * SHM_V + vst0) = sr_[i].vs0; *(bf16x8*)(V_lds + (b) * SHM_V + vst1) = sr_[i].vs1; const int kc = sc * 2; \
    *(bf16x8*)(K_lds + (b) * SHM_K + KSWZ(sr, kc)) = sr_[i].ks0; *(bf16x8*)(K_lds + (b) * SHM_K + KSWZ(32 + sr, kc)) = sr_[i].ks1; \
    *(bf16x8*)(Kr_lds + (b) * SHM_KR + krst) = sr_[i].kr; } while (0)
#define SWAIT() asm volatile("s_waitcnt vmcnt(0)" ::: "memory")
#define RESC(a) do { if (__any((a) < 1.f)) { if (hi == 0) al_l[r32] = (a); asm volatile("s_waitcnt lgkmcnt(0)" ::: "memory"); \
    _Pragma("unroll") for (int d = 0; d < 4; ++d) _Pragma("unroll") for (int r = 0; r < 16; ++r) o[d][r] *= al_l[crow(r, hi)]; } } while (0)
    f32x16 pA0, pA1, pB0, pB1; float mnA, mnB, alA, alB; bf16x8 pa0, pa1, pa2, pa3; const int NT = seq / 64;
    constexpr int SE = 0, SO = 0;
    SLOAD(SE, 0); asm volatile("s_waitcnt vmcnt(0)" ::: "memory"); SWRITE(0, SE); __syncthreads();
    qkt(pA0, pA1, K_lds, Kr_lds, qr, qrl, r32, hi); partialSM(pA0, pA1, m_reg, mnA, alA);
    SLOAD(SO, 64);
    SWAIT(); SWRITE(1, SO); __syncthreads();
    for (int j = 1; j + 1 < NT; j += 2) {
        SBAR(); qkt(pB0, pB1, K_lds + SHM_K, Kr_lds + SHM_KR, qr, qrl, r32, hi);
        finishSM(pA0, pA1, alA, l_reg, pa0, pa1, pa2, pa3); SBAR();
        SLOAD(SO, (j + 1) * 64); SBAR();
        pv_d0(o, vb0, pa0, pa1, pa2, pa3); partialSM(pB0, pB1, m_reg, mnB, alB);
        __syncthreads(); SWAIT(); SWRITE(0, SE);
        RESC(alB); __syncthreads();
        SBAR(); qkt(pA0, pA1, K_lds, Kr_lds, qr, qrl, r32, hi);
        finishSM(pB0, pB1, alB, l_reg, pa0, pa1, pa2, pa3); SBAR();
        SLOAD(SE, (j + 2) * 64); SBAR();
        pv_d0(o, vb0 + SHM_V, pa0, pa1, pa2, pa3); partialSM(pA0, pA1, m_reg, mnA, alA);
        __syncthreads(); SWAIT(); SWRITE(1, SO);
        RESC(alA); __syncthreads();
    }
    SBAR(); qkt(pB0, pB1, K_lds + SHM_K, Kr_lds + SHM_KR, qr, qrl, r32, hi);
    finishSM(pA0, pA1, alA, l_reg, pa0, pa1, pa2, pa3); SBAR();
    pv_d0(o, vb0, pa0, pa1, pa2, pa3); partialSM(pB0, pB1, m_reg, mnB, alB);
    __syncthreads(); RESC(alB);
    finishSM(pB0, pB1, alB, l_reg, pa0, pa1, pa2, pa3); SBAR();
    pv_d0(o, vb0 + SHM_V, pa0, pa1, pa2, pa3);
    if (hi == 0) li_l[r32] = l_reg; asm volatile("s_waitcnt lgkmcnt(0)" ::: "memory");
    float rli[16];
#pragma unroll
    for (int r = 0; r < 16; ++r) rli[r] = __builtin_amdgcn_rcpf(li_l[crow(r, hi)]);
    bf16_t* Ow = Ob + (long)(wid * 32) * 512;
#pragma unroll
    for (int r = 0; r < 16; ++r) { const int orow = crow(r, hi);
#pragma unroll
        for (int d0 = 0; d0 < 4; ++d0) Ow[(long)orow * 512 + d0 * 32 + r32] = f2bf(o[d0][r] * rli[r]); }
#undef SLOAD
#undef SWRITE
#undef SWAIT
#undef RESC
}
}

__device__ __forceinline__ float2 cmul(float2 a, float2 b) { return make_float2(a.x * b.x - a.y * b.y, a.x * b.y + a.y * b.x); }
template <bool LAST = true, bool FIRST = true> __device__ __forceinline__ void fft_dif(float2* d) {
    const int tid = opaque_tid();
    for (int s = FIRST ? 0 : 1; s < 6; ++s) {
        const int lg = 12 - 2 * s, span = 1 << lg; const float rs = 1.0f / (float)(4 << lg);
#pragma unroll 4
        for (int i = 0; i < 8; ++i) {
            const int bf = tid + 512 * i, j = bf & (span - 1), g = bf >> lg, base = ((g << 2) << lg) + j;
            const float2 a0 = d[base], a1 = d[base + span], a2 = d[base + 2 * span], a3 = d[base + 3 * span];
            const float2 b0 = make_float2(a0.x + a2.x, a0.y + a2.y), b1 = make_float2(a0.x - a2.x, a0.y - a2.y), b2 = make_float2(a1.x + a3.x, a1.y + a3.y), b3 = make_float2(a1.x - a3.x, a1.y - a3.y);
            const float2 y0 = make_float2(b0.x + b2.x, b0.y + b2.y), y2 = make_float2(b0.x - b2.x, b0.y - b2.y);
            const float2 y1 = make_float2(b1.x + b3.y, b1.y - b3.x), y3 = make_float2(b1.x - b3.y, b1.y + b3.x);
            const float r = (float)j * rs;
            const float2 w1 = make_float2(cos_rev(r), -sin_rev(r)), w2 = make_float2(cos_rev(2.f * r), -sin_rev(2.f * r)), w3 = make_float2(cos_rev(3.f * r), -sin_rev(3.f * r));
            d[base] = y0; d[base + span] = cmul(y1, w1); d[base + 2 * span] = cmul(y2, w2); d[base + 3 * span] = cmul(y3, w3);
        }
        __syncthreads();
    }
    if (!LAST) return;
#pragma unroll 4
    for (int i = 0; i < 8; ++i) {
        f32x4* q = (f32x4*)(d + 4 * (tid + 512 * i));
        const f32x4 A = q[0], B = q[1];
        const float b0x = A[0] + B[0], b0y = A[1] + B[1], b1x = A[0] - B[0], b1y = A[1] - B[1], b2x = A[2] + B[2], b2y = A[3] + B[3], b3x = A[2] - B[2], b3y = A[3] - B[3];
        q[0] = (f32x4){b0x + b2x, b0y + b2y, b1x + b3y, b1y - b3x};
        q[1] = (f32x4){b0x - b2x, b0y - b2y, b1x - b3y, b1y + b3x};
    }
    __syncthreads();
}
template <bool FIRST = true, bool LASTS = true> __device__ __forceinline__ void fft_dit_inv(float2* d) {
    const int tid = opaque_tid();
    if (FIRST) {
#pragma unroll 4
    for (int i = 0; i < 8; ++i) {
        f32x4* q = (f32x4*)(d + 4 * (tid + 512 * i));
        const f32x4 A = q[0], B = q[1];
        const float c0x = A[0] + B[0], c0y = A[1] + B[1], c1x = A[0] - B[0], c1y = A[1] - B[1], c2x = A[2] + B[2], c2y = A[3] + B[3], c3x = A[2] - B[2], c3y = A[3] - B[3];
        q[0] = (f32x4){c0x + c2x, c0y + c2y, c1x - c3y, c1y + c3x};
        q[1] = (f32x4){c0x - c2x, c0y - c2y, c1x + c3y, c1y - c3x};
    }
    __syncthreads();
    }
    for (int s = 5; s >= (LASTS ? 0 : 1); --s) {
        const int lg = 12 - 2 * s, span = 1 << lg; const float rs = 1.0f / (float)(4 << lg);
#pragma unroll 4
        for (int i = 0; i < 8; ++i) {
            const int bf = tid + 512 * i, j = bf & (span - 1), g = bf >> lg, base = ((g << 2) << lg) + j;
            const float r = (float)j * rs;
            const float2 w1 = make_float2(cos_rev(r), sin_rev(r)), w2 = make_float2(cos_rev(2.f * r), sin_rev(2.f * r)), w3 = make_float2(cos_rev(3.f * r), sin_rev(3.f * r));
            const float2 y0 = d[base], y1 = cmul(d[base + span], w1), y2 = cmul(d[base + 2 * span], w2), y3 = cmul(d[base + 3 * span], w3);
            const float2 c0 = make_float2(y0.x + y2.x, y0.y + y2.y), c1 = make_float2(y0.x - y2.x, y0.y - y2.y), c2 = make_float2(y1.x + y3.x, y1.y + y3.y), c3 = make_float2(y1.x - y3.x, y1.y - y3.y);
            d[base] = make_float2(c0.x + c2.x, c0.y + c2.y); d[base + 2 * span] = make_float2(c0.x - c2.x, c0.y - c2.y);
            d[base + span] = make_float2(c1.x - c3.y, c1.y + c3.x); d[base + 3 * span] = make_float2(c1.x + c3.y, c1.y - c3.x);
        }
        __syncthreads();
    }
}
__device__ __forceinline__ float sconv(const bf16_t* p, int t, float w0, float w1, float w2, float bias) {
    const float a = t > 0 ? bf2f(p[t - 1]) : 0.f, b = bf2f(p[t]), c = t < SEQ - 1 ? bf2f(p[t + 1]) : 0.f;
    return bias + w0 * a + w1 * b + w2 * c;
}
__device__ __forceinline__ float2 sconv2(const bf16_t* p, int m, float w0, float w1, float w2, float bias) {
    const unsigned* pw = (const unsigned*)p;
    const unsigned wm = m > 0 ? pw[m - 1] : 0u, wc = pw[m], wp = m < SEQ / 2 - 1 ? pw[m + 1] : 0u;
    const float a = bfhi(wm), b = bflo(wc), c = bfhi(wc), d = bflo(wp);
    return make_float2(bias + w0 * a + w1 * b + w2 * c, bias + w0 * b + w1 * c + w2 * d);
}
__device__ __forceinline__ int rev4_14(int x) { const unsigned b = __brev((unsigned)x) >> 18; return (int)(((b & 0x1555u) << 1) | ((b >> 1) & 0x1555u)); }
__device__ __forceinline__ void hyena_filter(KP p, int l, int c, float2* data, float2* Kd, float delta) {
    const int tid = opaque_tid(); unsigned char* ws = opaque_ptr(p->ws);
    const float* h2t = (const float*)(ws + OFF_H2T) + (size_t)l * 64 * 8192; const float* w3 = p->in[15] + (size_t)l * 64 * 1024;
    const int m0 = tid * 16;
    f32x4 af0[4], ab0[4], af1[4], ab1[4];
#pragma unroll
    for (int q = 0; q < 4; ++q) { af0[q] = (f32x4){0.f, 0.f, 0.f, 0.f}; ab0[q] = af0[q]; af1[q] = af0[q]; ab1[q] = af0[q]; }
#pragma unroll 2
    for (int j = 0; j < 64; ++j) {
        const float wf0 = w3[j * 1024 + c], wb0 = w3[j * 1024 + 256 + c], wf1 = w3[j * 1024 + 512 + c], wb1 = w3[j * 1024 + 768 + c];
        const f32x4* hp = (const f32x4*)(h2t + j * 8192 + m0);
#pragma unroll
        for (int q = 0; q < 4; ++q) { const f32x4 h = hp[q]; af0[q] += h * wf0; ab0[q] += h * wb0; af1[q] += h * wf1; ab1[q] += h * wb1; }
    }
#pragma unroll
    for (int q = 0; q < 4; ++q)
#pragma unroll
        for (int k = 0; k < 4; ++k) {
            const int m = m0 + q * 4 + k; const float win = __expf(-((float)m * (1.0f / 8191.0f)) * delta);
            data[m] = make_float2(af0[q][k] * win, af1[q][k] * win);
            if (m >= 1) data[16384 - m] = make_float2(ab0[q][k] * win, ab1[q][k] * win);
        }
    if (tid == 0) data[8192] = make_float2(0.f, 0.f);
    __syncthreads();
    fft_dif(data);
#pragma unroll 8
    for (int i = 0; i < 32; ++i) { const int q = tid + 512 * i; const float2 v = data[q]; Kd[q] = make_float2(v.x * (1.0f / 16384.0f), v.y * (1.0f / 16384.0f)); }
    __syncthreads();
}
template <int O> __device__ __forceinline__ void hyena_mid(float2* d, const float2* Z) {
    const int tid = opaque_tid();
#pragma unroll 4
    for (int i = 0; i < 8; ++i) {
        const int q0 = 4 * (tid + 512 * i);
        f32x4* qp = (f32x4*)(d + q0);
        const f32x4 A = qp[0], B = qp[1];
        const f32x4 ZA = *(const f32x4*)(Z + q0), ZB = *(const f32x4*)(Z + q0 + 2);
        float2 z2[4];
#pragma unroll
        for (int e = 0; e < 4; ++e) { const int f = rev4_14(q0 + e); z2[e] = Z[rev4_14((16384 - f) & 16383)]; }
        const float b0x = A[0] + B[0], b0y = A[1] + B[1], b1x = A[0] - B[0], b1y = A[1] - B[1], b2x = A[2] + B[2], b2y = A[3] + B[3], b3x = A[2] - B[2], b3y = A[3] - B[3];
        float2 y[4] = {make_float2(b0x + b2x, b0y + b2y), make_float2(b1x + b3y, b1y - b3x), make_float2(b0x - b2x, b0y - b2y), make_float2(b1x - b3y, b1y + b3x)};
        const float2 z[4] = {make_float2(ZA[0], ZA[1]), make_float2(ZA[2], ZA[3]), make_float2(ZB[0], ZB[1]), make_float2(ZB[2], ZB[3])};
#pragma unroll
        for (int e = 0; e < 4; ++e) {
            const float2 k = O == 0 ? make_float2(0.5f * (z[e].x + z2[e].x), 0.5f * (z[e].y - z2[e].y)) : make_float2(0.5f * (z[e].y + z2[e].y), -0.5f * (z[e].x - z2[e].x));
            y[e] = cmul(y[e], k);
        }
        const float c0x = y[0].x + y[2].x, c0y = y[0].y + y[2].y, c1x = y[0].x - y[2].x, c1y = y[0].y - y[2].y, c2x = y[1].x + y[3].x, c2y = y[1].y + y[3].y, c3x = y[1].x - y[3].x, c3y = y[1].y - y[3].y;
        qp[0] = (f32x4){c0x + c2x, c0y + c2y, c1x - c3y, c1y + c3x};
        qp[1] = (f32x4){c0x - c2x, c0y - c2y, c1x + c3y, c1y - c3x};
    }
    __syncthreads();
}
template <int O> __device__ __forceinline__ void hyena_mul(float2* data, const float2* Z) {
    const int tid = opaque_tid();
#pragma unroll 8
    for (int i = 0; i < 32; ++i) {
        const int q = tid + 512 * i, f = rev4_14(q), q2 = rev4_14((16384 - f) & 16383);
        const float2 z = Z[q], z2 = Z[q2];
        const float2 k = O == 0 ? make_float2(0.5f * (z.x + z2.x), 0.5f * (z.y - z2.y)) : make_float2(0.5f * (z.y + z2.y), -0.5f * (z.x - z2.x));
        data[q] = cmul(data[q], k);
    }
    __syncthreads();
}
__device__ __forceinline__ void dif0_pair(float2* d, int j, f32x4 in0, f32x4 in1) {
    f32x4 o0, o1, o2, o3;
#pragma unroll
    for (int e = 0; e < 2; ++e) {
        const float2 a0 = make_float2(in0[2 * e], in0[2 * e + 1]), a1 = make_float2(in1[2 * e], in1[2 * e + 1]);
        const float r = (float)(j + e) * (1.0f / 16384.0f);
        const float2 w1 = make_float2(cos_rev(r), -sin_rev(r)), w2 = make_float2(cos_rev(2.f * r), -sin_rev(2.f * r)), w3 = make_float2(cos_rev(3.f * r), -sin_rev(3.f * r));
        const float2 y0 = make_float2(a0.x + a1.x, a0.y + a1.y), y2 = cmul(make_float2(a0.x - a1.x, a0.y - a1.y), w2);
        const float2 y1 = cmul(make_float2(a0.x + a1.y, a0.y - a1.x), w1), y3 = cmul(make_float2(a0.x - a1.y, a0.y + a1.x), w3);
        o0[2 * e] = y0.x; o0[2 * e + 1] = y0.y; o1[2 * e] = y1.x; o1[2 * e + 1] = y1.y; o2[2 * e] = y2.x; o2[2 * e + 1] = y2.y; o3[2 * e] = y3.x; o3[2 * e + 1] = y3.y;
    }
    *(f32x4*)(d + j) = o0; *(f32x4*)(d + j + 4096) = o1; *(f32x4*)(d + j + 8192) = o2; *(f32x4*)(d + j + 12288) = o3;
}
__device__ __forceinline__ void dit0_pair(const float2* d, int j, f32x4& out0, f32x4& out1) {
    const f32x4 i0 = *(const f32x4*)(d + j), i1 = *(const f32x4*)(d + j + 4096), i2 = *(const f32x4*)(d + j + 8192), i3 = *(const f32x4*)(d + j + 12288);
#pragma unroll
    for (int e = 0; e < 2; ++e) {
        const float r = (float)(j + e) * (1.0f / 16384.0f);
        const float2 w1 = make_float2(cos_rev(r), sin_rev(r)), w2 = make_float2(cos_rev(2.f * r), sin_rev(2.f * r)), w3 = make_float2(cos_rev(3.f * r), sin_rev(3.f * r));
        const float2 y0 = make_float2(i0[2 * e], i0[2 * e + 1]), y1 = cmul(make_float2(i1[2 * e], i1[2 * e + 1]), w1), y2 = cmul(make_float2(i2[2 * e], i2[2 * e + 1]), w2), y3 = cmul(make_float2(i3[2 * e], i3[2 * e + 1]), w3);
        const float2 c0 = make_float2(y0.x + y2.x, y0.y + y2.y), c1 = make_float2(y0.x - y2.x, y0.y - y2.y), c2 = make_float2(y1.x + y3.x, y1.y + y3.y), c3 = make_float2(y1.x - y3.x, y1.y - y3.y);
        out0[2 * e] = c0.x + c2.x; out0[2 * e + 1] = c0.y + c2.y; out1[2 * e] = c1.x - c3.y; out1[2 * e + 1] = c1.y + c3.x;
    }
}
__device__ __forceinline__ void hyena_item(KP p, int l, int c, float2* data, bool do_store) {
    const int tid = opaque_tid(); unsigned char* ws = opaque_ptr(p->ws);
    bf16_t* hv = (bf16_t*)(ws + T_HYT) + (size_t)c * NTOK; const bf16_t* hx1 = (const bf16_t*)(ws + T_HYT) + (size_t)(256 + c) * NTOK; const bf16_t* hx2 = (const bf16_t*)(ws + T_HYT) + (size_t)(512 + c) * NTOK;
    float2* RA = (float2*)(ws + T_FK) + (size_t)c * 2 * 16384; float2* RB = RA + 16384;
    const float* cw = p->in[7] + l * 3 * 768; const float* cb = p->in[8] + l * 768;
    const float wv0 = cw[c], wv1 = cw[768 + c], wv2 = cw[1536 + c], bv = cb[c];
    const float wa0 = cw[256 + c], wa1 = cw[768 + 256 + c], wa2 = cw[1536 + 256 + c], ba = cb[256 + c];
    const float wb0 = cw[512 + c], wb1 = cw[768 + 512 + c], wb2 = cw[1536 + 512 + c], bb = cb[512 + c];
    const float skip0 = p->in[16][l * 512 + c], skip1 = p->in[16][l * 512 + 256 + c];
    const float mind = -3.0701134573253945f, maxd = -15.350567286626973f;
    const float delta = fabsf(mind + (float)c * ((maxd - mind) / 255.0f));
    __syncthreads();
    hyena_filter(p, l, c, data, RA, delta);
#pragma unroll 1
    for (int pr = 0; pr < 2; ++pr) {
        const int o0 = (2 * pr) * SEQ, o1 = (2 * pr + 1) * SEQ;
        { const int tq = opaque_tid();
#pragma unroll
          for (int i = 0; i < 4; ++i) { const int m = tq + 512 * i;
              const float2 a0 = sconv2(hv + o0, m, wv0, wv1, wv2, bv), a1 = sconv2(hv + o1, m, wv0, wv1, wv2, bv);
              const float2 b0 = sconv2(hv + o0, m + 2048, wv0, wv1, wv2, bv), b1 = sconv2(hv + o1, m + 2048, wv0, wv1, wv2, bv);
              dif0_pair(data, 2 * m, (f32x4){a0.x, a1.x, a0.y, a1.y}, (f32x4){b0.x, b1.x, b0.y, b1.y}); } }
        __syncthreads();
        fft_dif<false, false>(data);
        hyena_mid<0>(data, RA);
        fft_dit_inv<false, false>(data);
        { const int tq = opaque_tid();
#pragma unroll
          for (int i = 0; i < 4; ++i) { const int m = tq + 512 * i; f32x4 cva, cvb; dit0_pair(data, 2 * m, cva, cvb);
              { const float2 v0 = sconv2(hv + o0, m, wv0, wv1, wv2, bv), v1 = sconv2(hv + o1, m, wv0, wv1, wv2, bv);
                const float2 x0 = sconv2(hx1 + o0, m, wa0, wa1, wa2, ba), x1 = sconv2(hx1 + o1, m, wa0, wa1, wa2, ba);
                *(f32x4*)(RB + pr * 8192 + 2 * m) = (f32x4){x0.x * (cva[0] + skip0 * v0.x), x1.x * (cva[1] + skip0 * v1.x), x0.y * (cva[2] + skip0 * v0.y), x1.y * (cva[3] + skip0 * v1.y)}; }
              { const int mb = m + 2048;
                const float2 v0 = sconv2(hv + o0, mb, wv0, wv1, wv2, bv), v1 = sconv2(hv + o1, mb, wv0, wv1, wv2, bv);
                const float2 x0 = sconv2(hx1 + o0, mb, wa0, wa1, wa2, ba), x1 = sconv2(hx1 + o1, mb, wa0, wa1, wa2, ba);
                *(f32x4*)(RB + pr * 8192 + 2 * mb) = (f32x4){x0.x * (cvb[0] + skip0 * v0.x), x1.x * (cvb[1] + skip0 * v1.x), x0.y * (cvb[2] + skip0 * v0.y), x1.y * (cvb[3] + skip0 * v1.y)}; } } }
        __syncthreads();
    }
#pragma unroll 1
    for (int pr = 0; pr < 2; ++pr) {
        const int o0 = (2 * pr) * SEQ, o1 = (2 * pr + 1) * SEQ;
        { const int tq = opaque_tid();
#pragma unroll
          for (int i = 0; i < 4; ++i) { const int m = tq + 512 * i;
              dif0_pair(data, 2 * m, *(const f32x4*)(RB + pr * 8192 + 2 * m), *(const f32x4*)(RB + pr * 8192 + 2 * m + 4096)); } }
        __syncthreads();
        fft_dif<false, false>(data);
        hyena_mid<1>(data, RA);
        fft_dit_inv<false, false>(data);
        { const int tq = opaque_tid();
#pragma unroll
          for (int i = 0; i < 4; ++i) { const int m = tq + 512 * i; f32x4 cva, cvb; dit0_pair(data, 2 * m, cva, cvb);
              { const f32x4 y1 = *(const f32x4*)(RB + pr * 8192 + 2 * m);
                const float2 x0 = sconv2(hx2 + o0, m, wb0, wb1, wb2, bb), x1 = sconv2(hx2 + o1, m, wb0, wb1, wb2, bb);
                if (do_store) { *(unsigned*)(hv + o0 + 2 * m) = cvt_pk_bf16(x0.x * (cva[0] + skip1 * y1[0]), x0.y * (cva[2] + skip1 * y1[2]));
                                *(unsigned*)(hv + o1 + 2 * m) = cvt_pk_bf16(x1.x * (cva[1] + skip1 * y1[1]), x1.y * (cva[3] + skip1 * y1[3])); } }
              { const int mb = m + 2048; const f32x4 y1 = *(const f32x4*)(RB + pr * 8192 + 2 * mb);
                const float2 x0 = sconv2(hx2 + o0, mb, wb0, wb1, wb2, bb), x1 = sconv2(hx2 + o1, mb, wb0, wb1, wb2, bb);
                if (do_store) { *(unsigned*)(hv + o0 + 2 * mb) = cvt_pk_bf16(x0.x * (cvb[0] + skip1 * y1[0]), x0.y * (cvb[2] + skip1 * y1[2]));
                                *(unsigned*)(hv + o1 + 2 * mb) = cvt_pk_bf16(x1.x * (cvb[1] + skip1 * y1[1]), x1.y * (cvb[3] + skip1 * y1[3])); } } } }
        __syncthreads();
    }
}

constexpr int G_QF = 0, G_QB = G_QF + 64 * 33, G_KF = G_QB + 64 * 33, G_KB = G_KF + 32 * 68, G_V = G_KB + 32 * 68, G_A = G_V + 64 * 68, G_S = G_A + 64 * 68, G_T = G_S + 32 * 68,
              G_GF = G_T + 32 * 68, G_GB = G_GF + 64 * 33, G_O = G_GB + 64 * 33, G_O1 = G_O + 64 * 68, G_END = G_O1 + 64 * 68;
static_assert(G_END * 4 <= LDS_BYTES, "gla lds");
template <int CTRL, int ROW_MASK> __device__ __forceinline__ float dpp_add(float v) {
    const int s = __builtin_amdgcn_update_dpp(0, __float_as_int(v), CTRL, ROW_MASK, 0xf, true);
    return v + __int_as_float(s);
}
__device__ __forceinline__ float wave_incl_scan(float v) {
    v = dpp_add<0x111, 0xf>(v); v = dpp_add<0x112, 0xf>(v); v = dpp_add<0x114, 0xf>(v); v = dpp_add<0x118, 0xf>(v);
    v = dpp_add<0x142, 0xa>(v); v = dpp_add<0x143, 0xc>(v);
    return v;
}
struct GlaLoads { f32x4 gx[8]; u32x4 vw; u32x2 qw, kw; };
__device__ __forceinline__ GlaLoads gla_issue(KP p, int it) {
    const int tid = opaque_tid(), wid = __builtin_amdgcn_readfirstlane(tid >> 6), lane = tid & 63; unsigned char* ws = opaque_ptr(p->ws);
    const int h = it & 3, n = (it >> 2) & 127, b = it >> 9, row0 = b * SEQ + n * 64;
    const bf16_t* gin = (const bf16_t*)(ws + T_GIN); const float* gg = (const float*)(ws + T_GG);
    GlaLoads g;
    { const f32x4* gr = (const f32x4*)(gg + (size_t)(row0 + lane) * 32);
#pragma unroll
      for (int q = 0; q < 8; ++q) g.gx[q] = gr[q]; }
    g.vw = *(const u32x4*)(gin + (size_t)(row0 + (tid >> 3)) * 832 + 256 + h * 64 + (tid & 7) * 8);
    g.qw = *(const u32x2*)(gin + (size_t)(row0 + lane) * 832 + h * 32 + 4 * wid); g.kw = *(const u32x2*)(gin + (size_t)(row0 + lane) * 832 + 128 + h * 32 + 4 * wid);
    return g;
}
__device__ __forceinline__ void gla_prepare(KP p, int l, int h, const GlaLoads& g, float* L) {
    const int tid = opaque_tid(), wid = __builtin_amdgcn_readfirstlane(tid >> 6), lane = tid & 63;
    const float* wf = p->in[23] + l * 16 * 128 + h * 32 + 4 * wid; const float* wb = p->in[25] + l * 16 * 128 + h * 32 + 4 * wid;
    f32x4 af = *(const f32x4*)(p->in[24] + l * 128 + h * 32 + 4 * wid), ab = *(const f32x4*)(p->in[26] + l * 128 + h * 32 + 4 * wid);
#pragma unroll
    for (int r = 0; r < 16; ++r) { const float xf = g.gx[r >> 2][r & 3], xb = g.gx[4 + (r >> 2)][r & 3];
        af += *(const f32x4*)(wf + r * 128) * xf; ab += *(const f32x4*)(wb + r * 128) * xb; }
    float bb[4], cc[4];
#pragma unroll
    for (int k = 0; k < 4; ++k) {
        const float vf = (fminf(af[k], 0.f) - __logf(1.f + __expf(-fabsf(af[k])))) * (1.0f / 16.0f), vb = (fminf(ab[k], 0.f) - __logf(1.f + __expf(-fabsf(ab[k])))) * (1.0f / 16.0f);
        const float pf = wave_incl_scan(vf), pb = wave_incl_scan(vb);
        const float tot = __int_as_float(__builtin_amdgcn_readlane(__float_as_int(pb), 63));
        bb[k] = pf; cc[k] = tot - pb + vb; }
    __syncthreads();
    { float* vp = L + G_V + (tid >> 3) * 68 + (tid & 7) * 8; const u32x4 vw = g.vw;
      vp[0] = bflo(vw.x); vp[1] = bfhi(vw.x); vp[2] = bflo(vw.y); vp[3] = bfhi(vw.y); vp[4] = bflo(vw.z); vp[5] = bfhi(vw.z); vp[6] = bflo(vw.w); vp[7] = bfhi(vw.w); }
    { const u32x2 qw = g.qw, kw = g.kw; const float qv[4] = {bflo(qw.x), bfhi(qw.x), bflo(qw.y), bfhi(qw.y)}, kv[4] = {bflo(kw.x), bfhi(kw.x), bflo(kw.y), bfhi(kw.y)};
#pragma unroll
      for (int k = 0; k < 4; ++k) { const int d = 4 * wid + k; const float qs = qv[k] * 0.17677669529663687f;
          L[G_QF + lane * 33 + d] = qs * __expf(bb[k]); L[G_QB + lane * 33 + d] = qs * __expf(cc[k]); L[G_KF + d * 68 + lane] = kv[k] * __expf(-bb[k]); L[G_KB + d * 68 + lane] = kv[k] * __expf(-cc[k]);
          if (lane == 63) L[G_GF + 63 * 33 + d] = bb[k];
          if (lane == 0) L[G_GB + d] = cc[k]; } }
    __syncthreads();
}
__device__ __forceinline__ int crow32(int r, int hi) { return (r & 3) + 8 * (r >> 2) + 4 * hi; }
__device__ __forceinline__ void gla_pass1(KP p, int l, float* L) {
    const int tid = opaque_tid(), wid = tid >> 6, lane = tid & 63, c = lane & 31, kh = lane >> 5; unsigned char* ws = opaque_ptr(p->ws);
    float* SF = (float*)(ws + T_SF); float* SB = (float*)(ws + T_SB); float* DF = (float*)(ws + T_DF); float* DB = (float*)(ws + T_DB);
    int it = opaque_bid(); if (it >= 2048) return;
    GlaLoads cur = gla_issue(p, it);
    for (; it < 2048; it += gridDim.x) {
        const int h = it & 3, n = (it >> 2) & 127, b = it >> 9;
        const int itn = it + (int)gridDim.x < 2048 ? it + (int)gridDim.x : it;
        const GlaLoads nxt = gla_issue(p, itn);
        gla_prepare(p, l, h, cur, L);
        cur = nxt;
        if (wid < 4) {
            const int te = wid & 1, dir = wid >> 1; const float* Kx = L + (dir ? G_KB : G_KF) + c * 68 + kh; const float* Vx = L + G_V + kh * 68 + 32 * te + c;
            f32x16 acc = {};
#pragma unroll 8
            for (int kk = 0; kk < 32; ++kk) acc = __builtin_amdgcn_mfma_f32_32x32x2f32(Kx[2 * kk], Vx[2 * kk * 68], acc, 0, 0, 0);
            float* Sx = (dir ? SB : SF) + ((size_t)((b * 4 + h) * 128 + n)) * 2048 + 32 * te + c;
#pragma unroll
            for (int r = 0; r < 16; ++r) { const int d = crow32(r, kh); const float sc = __expf(dir ? L[G_GB + d] : L[G_GF + 63 * 33 + d]); Sx[d * 64] = acc[r] * sc; }
        }
        if (tid < 32) { DF[((b * 4 + h) * 128 + n) * 32 + tid] = __expf(L[G_GF + 63 * 33 + tid]); DB[((b * 4 + h) * 128 + n) * 32 + tid] = __expf(L[G_GB + tid]); }
    }
}
__device__ __forceinline__ void gla_pass2(KP p) {
    unsigned char* ws = opaque_ptr(p->ws); const int gid = opaque_bid() * NTHR + opaque_tid();
    if (gid >= 65536) return;
    const int bh = gid >> 12, dir = (gid >> 11) & 1, el = gid & 2047, d = el >> 6;
    float* S = (float*)(ws + (dir ? T_SB : T_SF)) + (size_t)bh * 128 * 2048 + el; const float* Dc = (const float*)(ws + (dir ? T_DB : T_DF)) + bh * 128 * 32 + d;
    float st = 0.f;
    for (int n0 = 0; n0 < 128; n0 += 32) {
        float Lv[32], Dv[32];
#pragma unroll
        for (int k = 0; k < 32; ++k) { const int n = dir ? 127 - (n0 + k) : n0 + k; Lv[k] = S[(size_t)n * 2048]; Dv[k] = Dc[n * 32]; }
#pragma unroll
        for (int k = 0; k < 32; ++k) { const int n = dir ? 127 - (n0 + k) : n0 + k; S[(size_t)n * 2048] = st; st = Dv[k] * st + Lv[k]; }
    }
}
__device__ __forceinline__ void gla_pass3(KP p, int l, float* L) {
    const int tid = opaque_tid(), wid = tid >> 6, lane = tid & 63, c = lane & 31, kh = lane >> 5; unsigned char* ws = opaque_ptr(p->ws);
    const float* SF = (const float*)(ws + T_SF); const float* SB = (const float*)(ws + T_SB);
    const bf16_t* gin = (const bf16_t*)(ws + T_GIN); bf16_t* mixb = (bf16_t*)(ws + T_MIXB);
    int it = opaque_bid(); if (it >= 2048) return;
    GlaLoads cur = gla_issue(p, it);
    for (; it < 2048; it += gridDim.x) {
        const int h = it & 3, n = (it >> 2) & 127, b = it >> 9;
        const size_t so = ((size_t)((b * 4 + h) * 128 + n)) * 2048 + tid * 4;
        const f32x4 sreg = *(const f32x4*)(SF + so), treg = *(const f32x4*)(SB + so);
        const int i0 = (tid >> 4) * 2, e0 = (tid & 15) * 4;
        const u32x2 rw0 = *(const u32x2*)(gin + (size_t)(b * SEQ + n * 64 + i0) * 832 + 544 + h * 64 + e0), rw1 = *(const u32x2*)(gin + (size_t)(b * SEQ + n * 64 + i0 + 1) * 832 + 544 + h * 64 + e0);
        const f32x4 gn = *(const f32x4*)(p->in[27] + l * 64 + e0);
        const int itn = it + (int)gridDim.x < 2048 ? it + (int)gridDim.x : it;
        const GlaLoads nxt = gla_issue(p, itn);
        gla_prepare(p, l, h, cur, L);
        cur = nxt;
        { const int d = tid >> 4; *(f32x4*)(L + G_S + d * 68 + e0) = sreg; *(f32x4*)(L + G_T + d * 68 + e0) = treg; }
        { const int ti = (wid >> 1) & 1, tj = wid & 1, dir = wid >> 2;
          const float* Qx = L + (dir ? G_QB : G_QF) + (32 * ti + c) * 33 + kh; const float* Kx = L + (dir ? G_KB : G_KF) + kh * 68 + 32 * tj + c;
          f32x16 acc = {};
#pragma unroll
          for (int kk = 0; kk < 16; ++kk) acc = __builtin_amdgcn_mfma_f32_32x32x2f32(Qx[2 * kk], Kx[2 * kk * 68], acc, 0, 0, 0);
          const int j = 32 * tj + c;
#pragma unroll
          for (int r = 0; r < 16; ++r) { const int i = 32 * ti + crow32(r, kh); const bool mine = dir ? (j > i) : (j <= i); if (mine) L[G_A + i * 65 + j] = acc[r]; } }
        __syncthreads();
        { const int ti = (wid >> 1) & 1, te = wid & 1, half = wid >> 2; f32x16 acc = {};
          if (half == 0) {
              const float* Ax = L + G_A + (32 * ti + c) * 65 + kh; const float* Vx = L + G_V + kh * 68 + 32 * te + c;
#pragma unroll 8
              for (int kk = 0; kk < 32; ++kk) acc = __builtin_amdgcn_mfma_f32_32x32x2f32(Ax[2 * kk], Vx[2 * kk * 68], acc, 0, 0, 0);
          } else {
              const float* Qf = L + G_QF + (32 * ti + c) * 33 + kh; const float* Qb = L + G_QB + (32 * ti + c) * 33 + kh;
              const float* Sx = L + G_S + kh * 68 + 32 * te + c; const float* Tx = L + G_T + kh * 68 + 32 * te + c;
#pragma unroll
              for (int kk = 0; kk < 16; ++kk) acc = __builtin_amdgcn_mfma_f32_32x32x2f32(Qf[2 * kk], Sx[2 * kk * 68], acc, 0, 0, 0);
#pragma unroll
              for (int kk = 0; kk < 16; ++kk) acc = __builtin_amdgcn_mfma_f32_32x32x2f32(Qb[2 * kk], Tx[2 * kk * 68], acc, 0, 0, 0);
#pragma unroll
              for (int r = 0; r < 16; ++r) L[G_O1 + (32 * ti + crow32(r, kh)) * 68 + 32 * te + c] = acc[r];
          }
          __syncthreads();
          if (half == 0) {
#pragma unroll
              for (int r = 0; r < 16; ++r) { const int o = (32 * ti + crow32(r, kh)) * 68 + 32 * te + c; L[G_O + o] = acc[r] + L[G_O1 + o]; }
          } }
        __syncthreads();
        const f32x4 o0 = *(const f32x4*)(L + G_O + i0 * 68 + e0), o1 = *(const f32x4*)(L + G_O + (i0 + 1) * 68 + e0);
        float s0 = o0[0] * o0[0] + o0[1] * o0[1] + o0[2] * o0[2] + o0[3] * o0[3], s1 = o1[0] * o1[0] + o1[1] * o1[1] + o1[2] * o1[2] + o1[3] * o1[3];
        s0 = dpp_add<0x128, 0xf>(s0); s0 = dpp_add<0x124, 0xf>(s0); s0 = dpp_add<0x122, 0xf>(s0); s0 = dpp_add<0x121, 0xf>(s0);
        s1 = dpp_add<0x128, 0xf>(s1); s1 = dpp_add<0x124, 0xf>(s1); s1 = dpp_add<0x122, 0xf>(s1); s1 = dpp_add<0x121, 0xf>(s1);
        const float r0 = rsqrtf(s0 * (1.0f / 64.0f) + 1e-6f), r1 = rsqrtf(s1 * (1.0f / 64.0f) + 1e-6f);
#pragma unroll
        for (int rr = 0; rr < 2; ++rr) { const int row = b * SEQ + n * 64 + i0 + rr; const f32x4 ov = rr ? o1 : o0; const float rs = rr ? r1 : r0;
            const u32x2 rw = rr ? rw1 : rw0; const float rv[4] = {bflo(rw.x), bfhi(rw.x), bflo(rw.y), bfhi(rw.y)};
            float ot[4];
#pragma unroll
            for (int k = 0; k < 4; ++k) ot[k] = ov[k] * rs * gn[k] * (rv[k] * __builtin_amdgcn_rcpf(1.f + __expf(-rv[k])));
            u32x2 w; w.x = cvt_pk_bf16(ot[0], ot[1]); w.y = cvt_pk_bf16(ot[2], ot[3]); *(u32x2*)(mixb + (size_t)row * DM + 768 + h * 64 + e0) = w; }
    }
}

__device__ __forceinline__ void mix_assemble(KP p, int l, float* L) {
    const int tid = opaque_tid(), wid = tid >> 6, lane = tid & 63; unsigned char* ws = opaque_ptr(p->ws);
    const bf16_t* hy = (const bf16_t*)(ws + T_HYT); bf16_t* mixb = (bf16_t*)(ws + T_MIXB); const bf16_t* atto = (const bf16_t*)(ws + T_ATTO);
    const float* gh = p->in[17] + l * 256; const float* gm = p->in[22] + l * 512;
    float* tile = L; float* red = L + 256 * 65;
    for (int it = opaque_bid(); it < NTOK / 64; it += gridDim.x) {
        const int row0 = it * 64;
        __syncthreads();
        { const int c = tid >> 1, t0 = (tid & 1) * 32; const bf16_t* sp = hy + (size_t)c * NTOK + row0 + t0;
#pragma unroll
          for (int q = 0; q < 4; ++q) { const u32x4 w = *(const u32x4*)(sp + q * 8); float* tp = tile + c * 65 + t0 + q * 8;
              tp[0] = bflo(w.x); tp[1] = bfhi(w.x); tp[2] = bflo(w.y); tp[3] = bfhi(w.y); tp[4] = bflo(w.z); tp[5] = bfhi(w.z); tp[6] = bflo(w.w); tp[7] = bfhi(w.w); } }
        __syncthreads();
        { const int t = tid & 63, part = tid >> 6; float ss = 0.f;
#pragma unroll 8
          for (int cc = 0; cc < 32; ++cc) { const float v = tile[(part * 32 + cc) * 65 + t]; ss += v * v; }
          red[part * 64 + t] = ss; }
        __syncthreads();
        { const int t = tid >> 3, cg8 = (tid & 7) * 32; float ss = 0.f;
#pragma unroll
          for (int q = 0; q < 8; ++q) ss += red[q * 64 + t];
          const float rs = rsqrtf(ss * (1.0f / 256.0f) + 1e-6f); bf16_t* op = mixb + (size_t)(row0 + t) * DM + cg8;
#pragma unroll
          for (int q = 0; q < 4; ++q) { float v[8];
#pragma unroll
              for (int k = 0; k < 8; ++k) v[k] = tile[(cg8 + q * 8 + k) * 65 + t] * rs * gh[cg8 + q * 8 + k];
              u32x4 w; w.x = cvt_pk_bf16(v[0], v[1]); w.y = cvt_pk_bf16(v[2], v[3]); w.z = cvt_pk_bf16(v[4], v[5]); w.w = cvt_pk_bf16(v[6], v[7]);
              *(u32x4*)(op + q * 8) = w; } }
    }
    for (int rb = (opaque_bid() * 8 + wid) * 4; rb < NTOK; rb += gridDim.x * 32) {
        u32x4 w[4];
#pragma unroll
        for (int q = 0; q < 4; ++q) w[q] = *(const u32x4*)(atto + (size_t)(rb + q) * 512 + lane * 8);
        const f32x4 g0 = *(const f32x4*)(gm + lane * 8), g1 = *(const f32x4*)(gm + lane * 8 + 4);
#pragma unroll
        for (int q = 0; q < 4; ++q) {
            float v[8] = {bflo(w[q].x), bfhi(w[q].x), bflo(w[q].y), bfhi(w[q].y), bflo(w[q].z), bfhi(w[q].z), bflo(w[q].w), bfhi(w[q].w)}; float ss = 0.f;
#pragma unroll
            for (int k = 0; k < 8; ++k) ss += v[k] * v[k];
#pragma unroll
            for (int sft = 1; sft < 64; sft <<= 1) ss += __shfl_xor(ss, sft);
            const float rs = rsqrtf(ss * (1.0f / 512.0f) + 1e-6f);
#pragma unroll
            for (int k = 0; k < 8; ++k) v[k] *= rs * (k < 4 ? g0[k & 3] : g1[k & 3]);
            u32x4 o; o.x = cvt_pk_bf16(v[0], v[1]); o.y = cvt_pk_bf16(v[2], v[3]); o.z = cvt_pk_bf16(v[4], v[5]); o.w = cvt_pk_bf16(v[6], v[7]);
            *(u32x4*)(mixb + (size_t)(rb + q) * DM + 256 + lane * 8) = o;
        }
    }
}

#define XB_TMO      128
#define XB_XCNT(j)  (256  + 64 * (j))
#define XB_XSUB(j)  (1280 + 64 * (j))
#define XB_XGEN(j)  (2304 + 64 * (j))
#define XB_TOP      3328
#define XB_TOPGEN   3392
#define XCD_BAR_WORDS 3456
#define XB_SPIN_CAP (1u << 20)
__device__ __forceinline__ unsigned xb_ld(unsigned* p)              { return __hip_atomic_load(p, __ATOMIC_RELAXED, __HIP_MEMORY_SCOPE_AGENT); }
__device__ __forceinline__ unsigned xb_add(unsigned* p, unsigned v) { return __hip_atomic_fetch_add(p, v, __ATOMIC_RELAXED, __HIP_MEMORY_SCOPE_AGENT); }
__device__ __forceinline__ unsigned xb_xcc_id() { return (unsigned)__builtin_amdgcn_s_getreg((3 << 11) | 20) & 0xFu; }
#define XB_SPIN(cond, bar) do { unsigned _sp = 0; while (cond) { __builtin_amdgcn_s_sleep(1); \
    if ((++_sp & 255u) == 0u) { if (xb_ld(&(bar)[XB_TMO])) break; if (_sp > XB_SPIN_CAP) { atomicAdd(&(bar)[XB_TMO], 1u); break; } } } } while (0)
struct XcdBarrier { unsigned* bar; unsigned x; volatile LAS unsigned* st; };
__device__ __forceinline__ XcdBarrier xcd_barrier_post(unsigned* bar, volatile LAS unsigned* st) {
    XcdBarrier b; b.bar = bar; b.x = xb_xcc_id(); b.st = st;
    if (threadIdx.x == 0) (void)xb_add(&bar[XB_XCNT(b.x)], 1u);
    return b;
}
__device__ __forceinline__ void xcd_barrier_complete(unsigned* bar, unsigned x, unsigned& nloc, unsigned& nx) {
    const unsigned G = gridDim.x * gridDim.y * gridDim.z;
    unsigned sum, cnt, mine, sp = 0u;
    for (;;) {
        sum = 0u; cnt = 0u; mine = 0u;
#pragma unroll
        for (unsigned j = 0; j < 16; ++j) { const unsigned c = xb_ld(&bar[XB_XCNT(j)]); sum += c; cnt += (c > 0u) ? 1u : 0u; mine = (j == x) ? c : mine; }
        if (sum == G) break;
        __builtin_amdgcn_s_sleep(1);
        if ((++sp & 255u) == 0u) { if (xb_ld(&bar[XB_TMO])) break; if (sp > XB_SPIN_CAP) { atomicAdd(&bar[XB_TMO], 1u); break; } }
    }
    nloc = mine > 0u ? mine : 1u; nx = cnt > 0u ? cnt : 1u;
}
__device__ __forceinline__ void xcd_barrier(const XcdBarrier& b) {
    asm volatile("s_waitcnt vmcnt(0)" ::: "memory");
    __syncthreads();
    if (threadIdx.x == 0) {
        unsigned* bar = b.bar;
        __builtin_amdgcn_s_waitcnt(0);
        unsigned nloc = b.st[0], nx = b.st[1];
        if (nloc == 0u) { xcd_barrier_complete(bar, b.x, nloc, nx); b.st[0] = nloc; b.st[1] = nx; }
        const unsigned old = xb_add(&bar[XB_XSUB(b.x)], 1u);
        const unsigned gen = old / nloc;
        if (old + 1u == (gen + 1u) * nloc) {
            __builtin_amdgcn_fence(__ATOMIC_RELEASE, "agent");
            asm volatile("s_waitcnt vmcnt(0)" ::: "memory");
            const unsigned og = xb_add(&bar[XB_TOP], 1u);
            const unsigned tg = og / nx;
            if (og + 1u == (tg + 1u) * nx) xb_add(&bar[XB_TOPGEN], 1u);
            else XB_SPIN(xb_ld(&bar[XB_TOPGEN]) == tg, bar);
            __builtin_amdgcn_fence(__ATOMIC_ACQUIRE, "agent");
            xb_add(&bar[XB_XGEN(b.x)], 1u);
            asm volatile("s_waitcnt vmcnt(0)" ::: "memory");
        } else {
            XB_SPIN(xb_ld(&bar[XB_XGEN(b.x)]) == gen, bar);
            __builtin_amdgcn_fence(__ATOMIC_ACQUIRE, "agent");
            asm volatile("s_waitcnt vmcnt(0)" ::: "memory");
        }
    }
    __syncthreads();
}

template <int SEL> __global__ __launch_bounds__(NTHR, 2) void mega_t(Params pv) {
    extern __shared__ __attribute__((aligned(16))) unsigned char shm[];
    cg::grid_group grid = cg::this_grid();
    __shared__ uint4 xb_words;
    if (threadIdx.x == 0) xb_words = make_uint4(0u, 0u, 0u, 0u);
    __syncthreads();
    const XcdBarrier xb = xcd_barrier_post((unsigned*)(pv.ws + OFF_BAR), (volatile LAS unsigned*)&xb_words);
    const KP kp = (KP)__builtin_amdgcn_kernarg_segment_ptr();
    unsigned char* ws = pv.ws;
    float* X = pv.out; bf16_t* XB = (bf16_t*)(ws + OFF_XB); float* SSX = (float*)(ws + OFF_SSX);
    for (int ph = pv.ph_lo; ph < pv.ph_hi; ++ph) {
        KP p = kp; asm volatile("" : "+s"(p));
        if (ph == 0) { if constexpr (SEL < 0 || SEL == 100) for (int r0 = 0; r0 < (PROBE_REP == 100 ? 2 : 1); ++r0) phase_prep(p, (float*)shm); }
        else if (ph == 19) { if constexpr (SEL < 0 || SEL == 101) {
            const float* g = p->in[33]; const int tid = opaque_tid(), wid = tid >> 6, lane = tid & 63;
            f32x4 gv[4];
#pragma unroll
            for (int i = 0; i < 4; ++i) gv[i] = *(const f32x4*)(g + lane * 16 + 4 * i);
            for (int rb = (opaque_bid() * 8 + wid) * 4; rb < NTOK; rb += gridDim.x * 32) {
                u32x4 w0[4], w1[4]; float rs[4];
#pragma unroll
                for (int q = 0; q < 4; ++q) { const bf16_t* bp = XB + (size_t)(rb + q) * DM + lane * 16; w0[q] = *(const u32x4*)bp; w1[q] = *(const u32x4*)(bp + 8); rs[q] = rstd16(SSX, rb + q); }
#pragma unroll
                for (int q = 0; q < 4; ++q) { float* xp = X + (size_t)(rb + q) * DM + lane * 16;
                    const float xv[16] = {bflo(w0[q].x), bfhi(w0[q].x), bflo(w0[q].y), bfhi(w0[q].y), bflo(w0[q].z), bfhi(w0[q].z), bflo(w0[q].w), bfhi(w0[q].w), bflo(w1[q].x), bfhi(w1[q].x), bflo(w1[q].y), bfhi(w1[q].y), bflo(w1[q].z), bfhi(w1[q].z), bflo(w1[q].w), bfhi(w1[q].w)};
#pragma unroll
                    for (int i = 0; i < 4; ++i) { f32x4 v = {xv[4 * i], xv[4 * i + 1], xv[4 * i + 2], xv[4 * i + 3]}; v = v * rs[q] * gv[i]; *(f32x4*)(xp + 4 * i) = v; } }
            } }
        } else {
            const int l = (ph - 1) / 9, sp = (ph - 1) % 9;
            pg8::StaticOrder S;
            if constexpr (SEL < 0 || SEL == 0) if (sp == 0 || sp == 7) {
                const int f = sp == 0 ? 0 : 1;
                pg8::Gemm g{XB, (const bf16_t*)(ws + OFF_WUP + (l * 2 + f) * SZ_WUP), NTOK, 5632, 1024, 1024}; S.init(g.M, g.N, gridDim.x, opaque_bid());
                EpiFfnUp E{ws, -1, {0.f, 0.f, 0.f, 0.f, 0.f, 0.f, 0.f, 0.f}};
                for (int r1 = 0; r1 < (PROBE_REP == 0 ? 2 : 1); ++r1) pg8::gemm_phase(( LAS unsigned char*)shm, g, S, E);
            }
            if constexpr (SEL < 0 || SEL == 1) if (sp == 1 || sp == 8) {
                const int f = sp == 1 ? 0 : 1;
                pg8::Gemm g{(const bf16_t*)(ws + T_ACT), (const bf16_t*)(ws + OFF_WDN + (l * 2 + f) * SZ_WDN), NTOK, 1024, FF, FF}; S.init(g.M, g.N, gridDim.x, opaque_bid());
                for (int r1 = (PROBE_REP == 1 ? 0 : 1); r1 < 2; ++r1) { EpiResid E{ws, r1 == 0 ? 0.f : 0.5f};
                pg8::gemm_phase((LAS unsigned char*)shm, g, S, E); }
            }
            if constexpr (SEL < 0 || SEL == 2) if (sp == 2) {
                pg8::Gemm g{XB, (const bf16_t*)(ws + OFF_WIN + l * SZ_WIN), NTOK, 2048, 1024, 1024}; S.init(g.M, g.N, gridDim.x, opaque_bid());
                EpiWin E{ws};
                for (int r1 = 0; r1 < (PROBE_REP == 2 ? 2 : 1); ++r1) pg8::gemm_phase((LAS unsigned char*)shm, g, S, E);
            }
            if constexpr (SEL < 0 || SEL == 30 || SEL == 31 || SEL == 32) if (sp == 3) {
                if constexpr (SEL < 0 || SEL == 30) for (int r3 = 0; r3 < (PROBE_REP == 30 ? 2 : 1); ++r3) {
                { pg8::Gemm g{(const bf16_t*)(ws + T_CQB), (const bf16_t*)(ws + OFF_WUQ + l * SZ_WUQ), NTOK, 768, 256, 256}; S.init(g.M, g.N, gridDim.x, opaque_bid());
                  EpiUq E{ws};
                  pg8::gemm_phase((LAS unsigned char*)shm, g, S, E); }
                { pg8::Gemm g{(const bf16_t*)(ws + T_CKVB), (const bf16_t*)(ws + OFF_WUKV + l * SZ_WUKV), NTOK, 1024, 256, 256}; S.init(g.M, g.N, gridDim.x, opaque_bid());
                  EpiUkv E{ws};
                  pg8::gemm_phase((LAS unsigned char*)shm, g, S, E); }
                }
                if constexpr (SEL < 0 || SEL == 31) for (int r3 = (PROBE_REP == 31 ? 0 : 1); r3 < 2; ++r3) for (int c = opaque_bid(); c < 256; c += gridDim.x) hyena_item(p, l, c, (float2*)shm, r3 == 1);
                if constexpr (SEL < 0 || SEL == 32) for (int r3 = 0; r3 < (PROBE_REP == 32 ? 2 : 1); ++r3) gla_pass1(p, l, (float*)shm);
            }
            if constexpr (SEL < 0 || SEL == 4) if (sp == 4) {
                gla_pass2(p);
                const bf16_t* QN = (const bf16_t*)(ws + T_QN); const bf16_t* QR = (const bf16_t*)(ws + T_QR); const bf16_t* KN = (const bf16_t*)(ws + T_KN);
                const bf16_t* KR = (const bf16_t*)(ws + T_KR); const bf16_t* VV = (const bf16_t*)(ws + T_V); bf16_t* AO = (bf16_t*)(ws + T_ATTO);
                const int nper = (512 * 8) / (int)gridDim.x;
                (void)nper;
                for (int r4 = 0; r4 < (PROBE_REP == 4 ? 2 : 1); ++r4)
                for (int it = opaque_bid(); it < 512; it += gridDim.x) {
                    const int x = it & 7, y = it >> 3;
                    const int bh = x + 8 * (y >> 5), qb = y & 31;
                    const int b = bh >> 2, h = bh & 3;
                    const size_t hoff = ((size_t)bh * SEQ) * 128;
                    att::attn_body(QN + hoff + (size_t)qb * 256 * 128, QR + ((size_t)bh * SEQ + qb * 256) * 64, KN + hoff, KR + (size_t)b * SEQ * 64, VV + hoff,
                                   AO + ((size_t)b * SEQ + qb * 256) * 512 + h * 128, SEQ, (char*)shm);
                }
            }
            if constexpr (SEL < 0 || SEL == 5) if (sp == 5) {
                for (int r5 = 0; r5 < (PROBE_REP == 50 ? 2 : 1); ++r5) mix_assemble(p, l, (float*)shm);
                for (int r5 = 0; r5 < (PROBE_REP == 51 ? 2 : 1); ++r5) gla_pass3(p, l, (float*)shm);
            }
            if constexpr (SEL < 0 || SEL == 6) if (sp == 6) {
                pg8::Gemm g{(const bf16_t*)(ws + T_MIXB), (const bf16_t*)(ws + OFF_WOUT + l * SZ_WOUT), NTOK, 1024, 1024, 1024}; S.init(g.M, g.N, gridDim.x, opaque_bid());
                for (int r1 = (PROBE_REP == 6 ? 0 : 1); r1 < 2; ++r1) { EpiResid E{ws, r1 == 0 ? 0.f : 1.0f};
                pg8::gemm_phase((LAS unsigned char*)shm, g, S, E); }
            }
        }
        if (ph + 1 < pv.ph_hi) { if (pv.ph_hi > 1000) grid.sync(); else xcd_barrier(xb); }
    }
}

#if MK_COOP
#define MEGA_MAIN mega_t<-1>
#else
#define MEGA_MAIN mega_t<0>
#endif
extern "C" void kernel_launch(void* const* d_in, const int* in_sizes, int n_in, void* d_out, int out_size, void* d_ws, size_t ws_size, hipStream_t stream) {
    static int grid_blocks = 0;
    if (grid_blocks == 0) {
        if (n_in != 34 || out_size != NTOK * DM || ws_size < WS_END) { fprintf(stderr, "kernel_launch: unexpected shapes n_in %d out %d ws %zu (need %zu)\n", n_in, out_size, ws_size, (size_t)WS_END); grid_blocks = -1; return; }
        if (hipFuncSetAttribute((const void*)MEGA_MAIN, hipFuncAttributeMaxDynamicSharedMemorySize, LDS_BYTES) != hipSuccess) { fprintf(stderr, "kernel_launch: hipFuncSetAttribute failed\n"); grid_blocks = -1; return; }
        int dev = 0, cus = 0, per_cu = 0;
        (void)hipGetDevice(&dev); (void)hipDeviceGetAttribute(&cus, hipDeviceAttributeMultiprocessorCount, dev);
        (void)hipOccupancyMaxActiveBlocksPerMultiprocessor(&per_cu, (const void*)MEGA_MAIN, NTHR, LDS_BYTES);
        if (per_cu < 1) { fprintf(stderr, "kernel_launch: occupancy query says %d blocks/CU\n", per_cu); per_cu = 1; }
        (void)hipGetLastError();
        grid_blocks = cus * per_cu;
        fprintf(stderr, "kernel_launch: grid %d (cus %d x %d)\n", grid_blocks, cus, per_cu);
    }
    if (grid_blocks < 0) return;
    Params p{};
    for (int i = 0; i < 34; ++i) p.in[i] = (const float*)d_in[i];
    p.out = (float*)d_out; p.ws = (unsigned char*)d_ws;
    if (hipMemsetAsync((unsigned char*)d_ws + OFF_BAR, 0, 16384, stream) != hipSuccess) { fprintf(stderr, "kernel_launch: memset of barrier words failed\n"); return; }
#if MK_COOP == 2
    for (int ph = 0; ph < 20; ++ph) { p.ph_lo = ph; p.ph_hi = ph + 1; hipLaunchKernelGGL(mega_t<-1>, dim3(grid_blocks), dim3(NTHR), LDS_BYTES, stream, p); }
#elif MK_COOP
    p.ph_lo = 0; p.ph_hi = 20;
    void* args[] = {&p};
    hipError_t e = hipLaunchCooperativeKernel((const void*)mega_t<-1>, dim3(grid_blocks), dim3(NTHR), args, LDS_BYTES, stream);
    if (e != hipSuccess) fprintf(stderr, "cooperative launch failed: %s (grid %d)\n", hipGetErrorString(e), grid_blocks);
#else
    static int attr_done = 0;
    if (!attr_done) {
        attr_done = 1;
        (void)hipFuncSetAttribute((const void*)mega_t<0>, hipFuncAttributeMaxDynamicSharedMemorySize, LDS_BYTES); (void)hipFuncSetAttribute((const void*)mega_t<1>, hipFuncAttributeMaxDynamicSharedMemorySize, LDS_BYTES);
        (void)hipFuncSetAttribute((const void*)mega_t<2>, hipFuncAttributeMaxDynamicSharedMemorySize, LDS_BYTES); (void)hipFuncSetAttribute((const void*)mega_t<30>, hipFuncAttributeMaxDynamicSharedMemorySize, LDS_BYTES); (void)hipFuncSetAttribute((const void*)mega_t<31>, hipFuncAttributeMaxDynamicSharedMemorySize, LDS_BYTES); (void)hipFuncSetAttribute((const void*)mega_t<32>, hipFuncAttributeMaxDynamicSharedMemorySize, LDS_BYTES);
        (void)hipFuncSetAttribute((const void*)mega_t<4>, hipFuncAttributeMaxDynamicSharedMemorySize, LDS_BYTES); (void)hipFuncSetAttribute((const void*)mega_t<5>, hipFuncAttributeMaxDynamicSharedMemorySize, LDS_BYTES);
        (void)hipFuncSetAttribute((const void*)mega_t<6>, hipFuncAttributeMaxDynamicSharedMemorySize, LDS_BYTES); (void)hipFuncSetAttribute((const void*)mega_t<100>, hipFuncAttributeMaxDynamicSharedMemorySize, LDS_BYTES);
        (void)hipFuncSetAttribute((const void*)mega_t<101>, hipFuncAttributeMaxDynamicSharedMemorySize, LDS_BYTES);
    }
    for (int ph = 0; ph < 20; ++ph) {
        p.ph_lo = ph; p.ph_hi = ph + 1;
        const int sp = (ph == 0) ? 100 : (ph == 19) ? 101 : (ph - 1) % 9;
        switch (sp) {
            case 0: case 7: hipLaunchKernelGGL(mega_t<0>, dim3(grid_blocks), dim3(NTHR), LDS_BYTES, stream, p); break;
            case 1: case 8: hipLaunchKernelGGL(mega_t<1>, dim3(grid_blocks), dim3(NTHR), LDS_BYTES, stream, p); break;
            case 2: hipLaunchKernelGGL(mega_t<2>, dim3(grid_blocks), dim3(NTHR), LDS_BYTES, stream, p); break;
            case 3: hipLaunchKernelGGL(mega_t<30>, dim3(grid_blocks), dim3(NTHR), LDS_BYTES, stream, p); hipLaunchKernelGGL(mega_t<31>, dim3(grid_blocks), dim3(NTHR), LDS_BYTES, stream, p);
                    hipLaunchKernelGGL(mega_t<32>, dim3(grid_blocks), dim3(NTHR), LDS_BYTES, stream, p); break;
            case 4: hipLaunchKernelGGL(mega_t<4>, dim3(grid_blocks), dim3(NTHR), LDS_BYTES, stream, p); break;
            case 5: hipLaunchKernelGGL(mega_t<5>, dim3(grid_blocks), dim3(NTHR), LDS_BYTES, stream, p); break;
            case 6: hipLaunchKernelGGL(mega_t<6>, dim3(grid_blocks), dim3(NTHR), LDS_BYTES, stream, p); break;
            case 100: hipLaunchKernelGGL(mega_t<100>, dim3(grid_blocks), dim3(NTHR), LDS_BYTES, stream, p); break;
            default: hipLaunchKernelGGL(mega_t<101>, dim3(grid_blocks), dim3(NTHR), LDS_BYTES, stream, p); break;
        }
    }
#endif
}
```

```cpp
#include <hip/hip_runtime.h>
#include <hip/hip_cooperative_groups.h>
#include <cstdio>
#include <cstdint>
namespace cg = cooperative_groups;

#ifndef MK_COOP
#define MK_COOP 1
#endif
#ifndef PROBE_REP
#define PROBE_REP -1
#endif

typedef unsigned short bf16_t;
typedef short bf16x8 __attribute__((ext_vector_type(8)));
typedef short s16x4 __attribute__((ext_vector_type(4)));
typedef float f32x4 __attribute__((ext_vector_type(4)));
typedef float f32x16 __attribute__((ext_vector_type(16)));
typedef unsigned u32x4 __attribute__((ext_vector_type(4)));
typedef unsigned u32x2 __attribute__((ext_vector_type(2)));
#define LAS __attribute__((address_space(3)))

constexpr int NTOK = 32768, DM = 1024, FF = 2816, SEQ = 8192, NB = 4;
constexpr int NTHR = 512;
constexpr int LDS_BYTES = 149504;

constexpr size_t SZ_WUP = (size_t)5632 * 1024 * 2, SZ_WDN = (size_t)1024 * 2816 * 2, SZ_WIN = (size_t)2048 * 1024 * 2, SZ_WOUT = (size_t)1024 * 1024 * 2,
                 SZ_WUQ = (size_t)768 * 256 * 2, SZ_WUKV = (size_t)1024 * 256 * 2;
constexpr size_t OFF_WUP = 0, OFF_WDN = OFF_WUP + 4 * SZ_WUP, OFF_WIN = OFF_WDN + 4 * SZ_WDN, OFF_WOUT = OFF_WIN + 2 * SZ_WIN, OFF_WUQ = OFF_WOUT + 2 * SZ_WOUT,
                 OFF_WUKV = OFF_WUQ + 2 * SZ_WUQ, OFF_XB = OFF_WUKV + 2 * SZ_WUKV, OFF_SSX = OFF_XB + (size_t)NTOK * DM * 2, OFF_H2T = OFF_SSX + (size_t)NTOK * 16 * 4,
                 OFF_ROPE = OFF_H2T + (size_t)2 * 64 * 8192 * 4, OFF_BAR = OFF_ROPE + (size_t)8192 * 64 * 4, OFF_TR = OFF_BAR + 16384;
constexpr size_t T_ACT = OFF_TR;
constexpr size_t T_HYT = OFF_TR;
constexpr size_t T_CQB = T_HYT + (size_t)768 * NTOK * 2;
constexpr size_t T_CKVB = T_CQB + (size_t)NTOK * 256 * 2;
constexpr size_t T_SSCQ = T_CKVB + (size_t)NTOK * 256 * 2;
constexpr size_t T_SSCKV = T_SSCQ + (size_t)NTOK * 4 * 4;
constexpr size_t T_KR = T_SSCKV + (size_t)NTOK * 4 * 4;
constexpr size_t T_GIN = T_KR + (size_t)NTOK * 64 * 2;
constexpr size_t T_GG = T_GIN + (size_t)NTOK * 832 * 2;
constexpr size_t T_FK = T_GG + (size_t)NTOK * 32 * 4;
constexpr size_t T_ATTO = T_FK;
constexpr size_t T_SF = T_FK + (size_t)256 * 2 * 16384 * 8;
constexpr size_t T_SB = T_SF + (size_t)16 * 128 * 2048 * 4;
constexpr size_t T_DF = T_SB + (size_t)16 * 128 * 2048 * 4;
constexpr size_t T_DB = T_DF + (size_t)16 * 128 * 32 * 4;
constexpr size_t T_QN = T_DB + (size_t)16 * 128 * 32 * 4;
constexpr size_t T_MIXB = T_QN;
constexpr size_t T_QR = T_QN + (size_t)NTOK * 4 * 128 * 2;
constexpr size_t T_KN = T_QR + (size_t)NTOK * 4 * 64 * 2;
constexpr size_t T_V = T_KN + (size_t)NTOK * 4 * 128 * 2;
constexpr size_t WS_END = T_V + (size_t)NTOK * 4 * 128 * 2;
static_assert(WS_END <= (size_t)536870912, "workspace over 512 MiB");
static_assert(T_ACT + (size_t)NTOK * FF * 2 <= WS_END, "act");
static_assert((size_t)NTOK * DM * 2 <= (T_KN + (size_t)NTOK * 4 * 128 * 2) - T_QN, "mixb alias");

struct Params {
    const float* in[34];
    float* out;
    unsigned char* ws;
    int ph_lo, ph_hi;
};

typedef const Params __attribute__((address_space(4)))* KP;
__device__ __forceinline__ int opaque_tid() { int t = threadIdx.x; asm volatile("" : "+v"(t)); return t; }
__device__ __forceinline__ unsigned char* opaque_ptr(unsigned char* q) { return q; }
__device__ __forceinline__ int opaque_bid() { int t = blockIdx.x; asm volatile("" : "+s"(t)); return t; }
__device__ __forceinline__ unsigned cvt_pk_bf16(float lo, float hi) { unsigned r; asm volatile("v_cvt_pk_bf16_f32 %0, %1, %2" : "=v"(r) : "v"(lo), "v"(hi)); return r; }
__device__ __forceinline__ bf16_t f2bf(float f) { return (bf16_t)(cvt_pk_bf16(f, 0.f) & 0xffffu); }
__device__ __forceinline__ float bf2f(bf16_t b) { return __uint_as_float(((unsigned)b) << 16); }
__device__ __forceinline__ float bflo(unsigned w) { return __uint_as_float(w << 16); }
__device__ __forceinline__ float bfhi(unsigned w) { return __uint_as_float(w & 0xffff0000u); }
__device__ __forceinline__ float sin_rev(float r) { return __builtin_amdgcn_sinf(r); }
__device__ __forceinline__ float cos_rev(float r) { return __builtin_amdgcn_cosf(r); }
__device__ __forceinline__ float fast_sin(float x) { float r = x * 0.15915494309189535f; r = r - floorf(r); return __builtin_amdgcn_sinf(r); }
__device__ __forceinline__ float quad_sum(float s) {
    auto a = __builtin_amdgcn_permlane16_swap(__float_as_uint(s), __float_as_uint(s), false, false); s = __uint_as_float(a[0]) + __uint_as_float(a[1]);
    auto b = __builtin_amdgcn_permlane32_swap(__float_as_uint(s), __float_as_uint(s), false, false); return __uint_as_float(b[0]) + __uint_as_float(b[1]);
}
__device__ __forceinline__ float rstd16(const float* ss, int row) {
    const f32x4* p = (const f32x4*)(ss + (size_t)row * 16); const f32x4 a = p[0], b = p[1], c = p[2], d = p[3];
    const float s = ((a.x + a.y) + (a.z + a.w)) + ((b.x + b.y) + (b.z + b.w)) + ((c.x + c.y) + (c.z + c.w)) + ((d.x + d.y) + (d.z + d.w));
    return rsqrtf(s * (1.0f / 1024.0f) + 1e-6f);
}
__device__ __forceinline__ float rstd16q(const float* ss, int row, int fq) {
    const f32x4 a = *(const f32x4*)(ss + (size_t)row * 16 + 4 * fq); float s = (a.x + a.y) + (a.z + a.w);
    s = quad_sum(s);
    return rsqrtf(s * (1.0f / 1024.0f) + 1e-6f);
}
__device__ __forceinline__ float rstd4(const float* ss, int row, float invn) {
    const f32x4 a = *(const f32x4*)(ss + (size_t)row * 4); return rsqrtf(((a.x + a.y) + (a.z + a.w)) * invn + 1e-6f);
}

namespace pg8 {
constexpr int BM = 256, BK = 64, HALF = 128, HTB = HALF * BK * 2, NXCD = 8, WGM = 8;
__host__ __device__ __forceinline__ int lds_byte(int r, int c) { const int st = (r >> 4) * 2 + (c >> 5), rr = r & 15, cc = c & 31, ob = rr * 64 + cc * 2; return st * 1024 + (ob ^ (((ob >> 9) & 1) << 5)); }
__host__ __device__ __forceinline__ void stage_rc(int b, int& R, int& C) { const int st = b / 1024, sb = b % 1024, swz = sb ^ (((sb >> 9) & 1) << 5); R = (st >> 1) * 16 + swz / 64; C = (st & 1) * 32 + (swz % 64) / 2; }
__host__ __device__ __forceinline__ int perm32(int rho) { const int n = rho >> 4, i = rho & 15; return 8 * (i >> 2) + 4 * n + (i & 3); }
struct Unit { int pm, pn; };
struct Gemm { const bf16_t* A; const bf16_t* Bt; int M, N, K, lda; };
struct StaticOrder {
    int nM, nN, nwg, G, c;
    __device__ void init(int M, int N, int G_, int c_) { nM = M / BM; nN = N / BM; nwg = nM * nN; G = G_; c = c_; }
    __device__ bool next(int i, Unit& u) const {
        const long L = (long)i * G + c; if (L >= nwg) return false;
        int wgid = (int)L; { const int q = nwg / NXCD, r = nwg % NXCD, xcd = wgid % NXCD, off = wgid / NXCD; wgid = (xcd < r ? xcd * (q + 1) : r * (q + 1) + (xcd - r) * q) + off; }
        const int nig = WGM * nN, gid = wgid / nig, fm = gid * WGM, gsz = (nM - fm) < WGM ? (nM - fm) : WGM;
        u.pm = fm + ((wgid % nig) % gsz); u.pn = (wgid % nig) / gsz; return true;
    }
};
template <class Epi>
__device__ __forceinline__ void gemm_phase(LAS unsigned char* lds, const Gemm g, const StaticOrder& S, Epi& E) {
    const int tid = opaque_tid(), wid = __builtin_amdgcn_readfirstlane(tid >> 6), lane = tid & 63, wr = wid >> 2, wc = wid & 3, fr = lane & 15, fq = lane >> 4;
    int K = g.K, lda = g.lda; asm volatile("" : "+s"(K), "+s"(lda));
    const int nt = K / BK;
    unsigned voffA[2], voffB[2];
#pragma unroll
    for (int i = 0; i < 2; ++i) { int R, C; stage_rc(tid * 16 + i * 8192, R, C); const int Rb = Epi::PERM ? ((R & ~31) + perm32(R & 31)) : R; voffA[i] = (unsigned)(R * lda + C) * 2u; voffB[i] = (unsigned)(Rb * K + C) * 2u; }
    const size_t kstep = (size_t)(BK * 2);
    const size_t hstepA = (size_t)HALF * lda * 2, hstepB = (size_t)HALF * K * 2;
    const size_t tstepA = 2 * hstepA, tstepB = 2 * hstepB;
    const unsigned ldsw = (unsigned)wid * 1024u;
    const int aoff = lds_byte(wr * 64 + fr, fq * 8), boff = lds_byte(wc * 32 + fr, fq * 8);
#define PG8_SA(b, h) (((b) * 2 + (h)) * HTB)
#define PG8_SB(b, h) ((4 + (b) * 2 + (h)) * HTB)
#define PG8_STAGE(bufoff, gbase, voff) do { _Pragma("unroll") for (int _i = 0; _i < 2; ++_i) \
        __builtin_amdgcn_global_load_lds((const unsigned*)((const char*)(gbase) + (voff)[_i]), (LAS unsigned*)(lds + (bufoff) + ldsw + _i * 8192), 16, 0, 0); } while (0)
#define PG8_LDA(dst, b, h) do { _Pragma("unroll") for (int m = 0; m < 4; ++m) _Pragma("unroll") for (int k = 0; k < 2; ++k) dst[m][k] = *(const LAS bf16x8*)(lds + PG8_SA(b, h) + aoff + m * 2048 + k * 1024); } while (0)
#define PG8_LDB(dst, b, h) do { _Pragma("unroll") for (int n = 0; n < 2; ++n) _Pragma("unroll") for (int k = 0; k < 2; ++k) dst[n][k] = *(const LAS bf16x8*)(lds + PG8_SB(b, h) + boff + n * 2048 + k * 1024); } while (0)
#define PG8_MMA(ai, bj, At, Bt) do { __builtin_amdgcn_s_setprio(1); _Pragma("unroll") for (int m = 0; m < 4; ++m) _Pragma("unroll") for (int n = 0; n < 2; ++n) _Pragma("unroll") for (int k = 0; k < 2; ++k) \
        acc[ai][bj][m][n] = __builtin_amdgcn_mfma_f32_16x16x32_bf16(Bt[n][k], At[m][k], acc[ai][bj][m][n], 0, 0, 0); __builtin_amdgcn_s_setprio(0); } while (0)
#define PG8_WAIT_V(n) asm volatile("s_waitcnt vmcnt(" #n ")" ::: "memory")
#define PG8_WAIT_L(n) asm volatile("s_waitcnt lgkmcnt(" #n ")" ::: "memory")
#define PG8_BAR __builtin_amdgcn_s_barrier()
#define PG8_SCHED __builtin_amdgcn_sched_barrier(0)
    Unit cur, nxt; int ui = 0;
    if (!S.next(0, cur)) return;
    f32x4 acc[2][2][4][2];
#pragma unroll
    for (int a = 0; a < 2; ++a)
#pragma unroll
        for (int b = 0; b < 2; ++b)
#pragma unroll
            for (int m = 0; m < 4; ++m)
#pragma unroll
                for (int n = 0; n < 2; ++n) acc[a][b][m][n] = (f32x4){0.f, 0.f, 0.f, 0.f};
    bf16x8 At[4][2], B0[2][2], B1[2][2];
    const char* cA = (const char*)g.A + (size_t)cur.pm * tstepA; const char* cB = (const char*)g.Bt + (size_t)cur.pn * tstepB;
    PG8_STAGE(PG8_SB(0, 0), cB, voffB); PG8_STAGE(PG8_SA(0, 0), cA, voffA); PG8_STAGE(PG8_SB(0, 1), cB + hstepB, voffB); PG8_STAGE(PG8_SA(0, 1), cA + hstepA, voffA);
    if (wr == 1) PG8_BAR;
    PG8_WAIT_V(4); PG8_BAR;
    PG8_STAGE(PG8_SB(1, 0), cB + kstep, voffB); PG8_STAGE(PG8_SA(1, 0), cA + kstep, voffA); PG8_STAGE(PG8_SB(1, 1), cB + hstepB + kstep, voffB);
    PG8_WAIT_V(6); PG8_BAR;
    for (;;) {
        const bool has_next = S.next(ui + 1, nxt);
        const char* nA = has_next ? (const char*)g.A + (size_t)nxt.pm * tstepA : cA; const char* nB = has_next ? (const char*)g.Bt + (size_t)nxt.pn * tstepB : cB;
        for (int t = 0; t < nt; t += 2) {
            const bool last = (t == nt - 2);
            const char* a1 = cA + (size_t)(t + 1) * kstep;
            const char* a2 = last ? nA : cA + (size_t)(t + 2) * kstep; const char* b2 = last ? nB : cB + (size_t)(t + 2) * kstep;
            const char* a3 = a2 + kstep; const char* b3 = b2 + kstep;
            PG8_LDB(B0, 0, 0); PG8_SCHED; PG8_LDA(At, 0, 0); PG8_STAGE(PG8_SA(1, 1), a1 + hstepA, voffA);
            PG8_WAIT_L(8); PG8_BAR; PG8_WAIT_L(0); PG8_MMA(0, 0, At, B0); PG8_BAR; PG8_SCHED;
            PG8_LDB(B1, 0, 1); PG8_STAGE(PG8_SB(0, 0), b2, voffB);
            PG8_BAR; PG8_WAIT_L(0); PG8_MMA(0, 1, At, B1); PG8_BAR;
            PG8_LDA(At, 0, 1); PG8_STAGE(PG8_SA(0, 0), a2, voffA);
            PG8_BAR; PG8_WAIT_L(0); PG8_MMA(1, 0, At, B0); PG8_BAR; PG8_SCHED;
            PG8_STAGE(PG8_SB(0, 1), b2 + hstepB, voffB);
            PG8_WAIT_V(6); PG8_BAR; PG8_MMA(1, 1, At, B1); PG8_BAR;
            PG8_LDB(B0, 1, 0); PG8_SCHED; PG8_LDA(At, 1, 0); PG8_STAGE(PG8_SA(0, 1), a2 + hstepA, voffA);
            PG8_WAIT_L(8); PG8_BAR; PG8_WAIT_L(0); PG8_MMA(0, 0, At, B0); PG8_BAR; PG8_SCHED;
            PG8_LDB(B1, 1, 1); PG8_STAGE(PG8_SB(1, 0), b3, voffB);
            PG8_BAR; PG8_WAIT_L(0); PG8_MMA(0, 1, At, B1); PG8_BAR;
            PG8_LDA(At, 1, 1); PG8_STAGE(PG8_SA(1, 0), a3, voffA);
            PG8_BAR; PG8_WAIT_L(0); PG8_MMA(1, 0, At, B0); PG8_BAR; PG8_SCHED;
            PG8_STAGE(PG8_SB(1, 1), b3 + hstepB, voffB);
            PG8_WAIT_V(6); PG8_BAR; PG8_MMA(1, 1, At, B1); PG8_BAR;
        }
        { int fr2 = fr, fq2 = fq, wr2 = wr, wc2 = wc; asm volatile("" : "+v"(fr2), "+v"(fq2), "+s"(wr2), "+s"(wc2));
          E(acc, cur, wr2, wc2, fr2, fq2); }
        if (!has_next) break;
#pragma unroll
        for (int a = 0; a < 2; ++a)
#pragma unroll
            for (int b = 0; b < 2; ++b)
#pragma unroll
                for (int m = 0; m < 4; ++m)
#pragma unroll
                    for (int n = 0; n < 2; ++n) acc[a][b][m][n] = (f32x4){0.f, 0.f, 0.f, 0.f};
        cur = nxt; cA = nA; cB = nB; ++ui;
    }
    PG8_WAIT_V(0);
    if (wr == 0) PG8_BAR;
    PG8_BAR;
#undef PG8_SA
#undef PG8_SB
#undef PG8_STAGE
#undef PG8_LDA
#undef PG8_LDB
#undef PG8_MMA
#undef PG8_WAIT_V
#undef PG8_WAIT_L
#undef PG8_BAR
#undef PG8_SCHED
}
}
using pg8::Unit;
typedef f32x4 AccT[2][2][4][2];

struct EpiFfnUp {
    static constexpr bool PERM = true;
    unsigned char* ws; int last_pm; float rsc[8];
    __device__ __forceinline__ void operator()(const AccT& acc, const Unit& u, int wr, int wc, int fr, int fq) {
        bf16_t* act = (bf16_t*)(ws + T_ACT); const float* ssx = (const float*)(ws + OFF_SSX);
        const int row0 = u.pm * 256 + wr * 64 + fr, col0 = u.pn * 128 + wc * 32 + 8 * fq;
        if (u.pm != last_pm) {
            last_pm = u.pm;
#pragma unroll
            for (int ai = 0; ai < 2; ++ai)
#pragma unroll
                for (int m = 0; m < 4; ++m) rsc[ai * 4 + m] = rstd16q(ssx, row0 + ai * 128 + m * 16, fq);
        }
#pragma unroll
        for (int ai = 0; ai < 2; ++ai)
#pragma unroll
            for (int m = 0; m < 4; ++m) {
                const int row = row0 + ai * 128 + m * 16; const float rs = rsc[ai * 4 + m];
                float o[8];
#pragma unroll
                for (int n = 0; n < 2; ++n)
#pragma unroll
                    for (int j = 0; j < 4; ++j) { const float gv = acc[ai][0][m][n][j] * rs, uv = acc[ai][1][m][n][j] * rs; o[4 * n + j] = gv * __builtin_amdgcn_rcpf(1.f + __expf(-gv)) * uv; }
                u32x4 w; w.x = cvt_pk_bf16(o[0], o[1]); w.y = cvt_pk_bf16(o[2], o[3]); w.z = cvt_pk_bf16(o[4], o[5]); w.w = cvt_pk_bf16(o[6], o[7]);
                *(u32x4*)(act + (size_t)row * FF + col0) = w;
            }
    }
};
struct EpiResid {
    static constexpr bool PERM = true;
    unsigned char* ws; float alpha;
    __device__ __forceinline__ void operator()(const AccT& acc, const Unit& u, int wr, int wc, int fr, int fq) const {
        bf16_t* xb = (bf16_t*)(ws + OFF_XB); float* ssx = (float*)(ws + OFF_SSX);
        const int row0 = u.pm * 256 + wr * 64 + fr, col0 = u.pn * 256 + wc * 32 + 8 * fq;
#pragma unroll
        for (int ai = 0; ai < 2; ++ai) {
            u32x4 xo[4][2];
#pragma unroll
            for (int m = 0; m < 4; ++m)
#pragma unroll
                for (int bj = 0; bj < 2; ++bj) xo[m][bj] = *(const u32x4*)(xb + (size_t)(row0 + ai * 128 + m * 16) * DM + col0 + bj * 128);
#pragma unroll
            for (int m = 0; m < 4; ++m) {
                const int row = row0 + ai * 128 + m * 16; float ss = 0.f;
#pragma unroll
                for (int bj = 0; bj < 2; ++bj) {
                    const size_t idx = (size_t)row * DM + col0 + bj * 128;
                    const u32x4 xw = xo[m][bj];
                    const f32x4 xo0 = {bflo(xw.x), bfhi(xw.x), bflo(xw.y), bfhi(xw.y)}, xo1 = {bflo(xw.z), bfhi(xw.z), bflo(xw.w), bfhi(xw.w)};
                    const f32x4 x0 = xo0 + acc[ai][bj][m][0] * alpha, x1 = xo1 + acc[ai][bj][m][1] * alpha;
                    u32x4 w; w.x = cvt_pk_bf16(x0[0], x0[1]); w.y = cvt_pk_bf16(x0[2], x0[3]); w.z = cvt_pk_bf16(x1[0], x1[1]); w.w = cvt_pk_bf16(x1[2], x1[3]); *(u32x4*)(xb + idx) = w;
                    ss += x0[0] * x0[0] + x0[1] * x0[1] + x0[2] * x0[2] + x0[3] * x0[3] + x1[0] * x1[0] + x1[1] * x1[1] + x1[2] * x1[2] + x1[3] * x1[3];
                }
                ss = quad_sum(ss);
                if (fq == 0) ssx[(size_t)row * 16 + u.pn * 4 + wc] = ss;
            }
        }
    }
};
struct EpiWin {
    static constexpr bool PERM = false;
    unsigned char* ws;
    __device__ __forceinline__ void operator()(const AccT& acc, const Unit& u, int wr, int wc, int fr, int fq) const {
        const float* ssx = (const float*)(ws + OFF_SSX); bf16_t* hyt = (bf16_t*)(ws + T_HYT); bf16_t* cqb = (bf16_t*)(ws + T_CQB); bf16_t* ckvb = (bf16_t*)(ws + T_CKVB);
        float* sscq = (float*)(ws + T_SSCQ); float* ssckv = (float*)(ws + T_SSCKV); bf16_t* kr = (bf16_t*)(ws + T_KR); bf16_t* gin = (bf16_t*)(ws + T_GIN); float* gg = (float*)(ws + T_GG); const float* rope = (const float*)(ws + OFF_ROPE);
        const int row0 = u.pm * 256 + wr * 64 + fr, pn = u.pn;
        if (pn < 3) {
#pragma unroll
            for (int ai = 0; ai < 2; ++ai)
#pragma unroll
                for (int m = 0; m < 4; ++m) {
                    const int row = row0 + ai * 128 + m * 16; const float rs = rstd16q(ssx, row, fq);
#pragma unroll
                    for (int bj = 0; bj < 2; ++bj)
#pragma unroll
                        for (int n = 0; n < 2; ++n)
#pragma unroll
                            for (int j = 0; j < 4; ++j) { const int col = pn * 256 + bj * 128 + wc * 32 + n * 16 + 4 * fq + j; hyt[(size_t)col * NTOK + row] = f2bf(acc[ai][bj][m][n][j] * rs); }
                }
        } else if (pn == 3 || pn == 4) {
            bf16_t* dst = pn == 3 ? cqb : ckvb; float* sdst = pn == 3 ? sscq : ssckv;
#pragma unroll
            for (int ai = 0; ai < 2; ++ai)
#pragma unroll
                for (int m = 0; m < 4; ++m) {
                    const int row = row0 + ai * 128 + m * 16; const float rs = rstd16q(ssx, row, fq);
                    float ss = 0.f;
#pragma unroll
                    for (int bj = 0; bj < 2; ++bj)
#pragma unroll
                        for (int n = 0; n < 2; ++n) {
                            const f32x4 v = acc[ai][bj][m][n] * rs; const float q = v[0] * v[0] + v[1] * v[1] + v[2] * v[2] + v[3] * v[3];
                            if (bj == 0 || pn == 3) ss += q;
                            u32x2 w; w.x = cvt_pk_bf16(v[0], v[1]); w.y = cvt_pk_bf16(v[2], v[3]);
                            *(u32x2*)(dst + (size_t)row * 256 + bj * 128 + wc * 32 + n * 16 + 4 * fq) = w;
                        }
                    ss = quad_sum(ss);
                    if (fq == 0) sdst[(size_t)row * 4 + wc] = ss;
                    if (pn == 4) {
                        if (wc < 2) {
                            const int s0 = 16 * wc + 4 * fq; const float* rp = rope + (size_t)(row & (SEQ - 1)) * 64 + s0;
                            const f32x4 cs = *(const f32x4*)rp, sn = *(const f32x4*)(rp + 32);
                            const f32x4 a = acc[ai][1][m][0] * rs, b = acc[ai][1][m][1] * rs;
                            const f32x4 oa = a * cs - b * sn, ob = a * sn + b * cs;
                            u32x2 w; w.x = cvt_pk_bf16(oa[0], oa[1]); w.y = cvt_pk_bf16(oa[2], oa[3]); *(u32x2*)(kr + (size_t)row * 64 + s0) = w;
                            w.x = cvt_pk_bf16(ob[0], ob[1]); w.y = cvt_pk_bf16(ob[2], ob[3]); *(u32x2*)(kr + (size_t)row * 64 + s0 + 32) = w;
                        } else {
#pragma unroll
                            for (int n = 0; n < 2; ++n) {
                                const f32x4 v = acc[ai][1][m][n] * rs; u32x2 w; w.x = cvt_pk_bf16(v[0], v[1]); w.y = cvt_pk_bf16(v[2], v[3]);
                                *(u32x2*)(gin + (size_t)row * 832 + (1152 + wc * 32 + n * 16 + 4 * fq - 1216)) = w;
                            }
                        }
                    }
                }
        } else {
#pragma unroll
            for (int ai = 0; ai < 2; ++ai)
#pragma unroll
                for (int m = 0; m < 4; ++m) {
                    const int row = row0 + ai * 128 + m * 16; const float rs = rstd16q(ssx, row, fq);
#pragma unroll
                    for (int bj = 0; bj < 2; ++bj)
#pragma unroll
                        for (int n = 0; n < 2; ++n) {
                            const f32x4 v = acc[ai][bj][m][n] * rs; const int col = pn * 256 + bj * 128 + wc * 32 + n * 16 + 4 * fq;
                            if (pn == 6 && bj == 1 && wc == 2) *(f32x4*)(gg + (size_t)row * 32 + n * 16 + 4 * fq) = v;
                            u32x2 w; w.x = cvt_pk_bf16(v[0], v[1]); w.y = cvt_pk_bf16(v[2], v[3]);
                            *(u32x2*)(gin + (size_t)row * 832 + (col - 1216)) = w;
                        }
                }
        }
    }
};
struct EpiUq {
    static constexpr bool PERM = false;
    unsigned char* ws;
    __device__ __forceinline__ void operator()(const AccT& acc, const Unit& u, int wr, int wc, int fr, int fq) const {
        const float* sscq = (const float*)(ws + T_SSCQ); bf16_t* qn = (bf16_t*)(ws + T_QN); bf16_t* qr = (bf16_t*)(ws + T_QR); const float* rope = (const float*)(ws + OFF_ROPE);
        const int row0 = u.pm * 256 + wr * 64 + fr, pn = u.pn;
        if (pn < 2) {
#pragma unroll
            for (int ai = 0; ai < 2; ++ai)
#pragma unroll
                for (int m = 0; m < 4; ++m) {
                    const int row = row0 + ai * 128 + m * 16; const float rs = rstd4(sscq, row, 1.0f / 256.0f);
                    const int b = row >> 13, s = row & (SEQ - 1);
#pragma unroll
                    for (int bj = 0; bj < 2; ++bj) { const int h = 2 * pn + bj; bf16_t* rp = qn + ((size_t)(b * 4 + h) * SEQ + s) * 128 + wc * 32 + 4 * fq;
#pragma unroll
                        for (int n = 0; n < 2; ++n) { const f32x4 v = acc[ai][bj][m][n] * rs; u32x2 w; w.x = cvt_pk_bf16(v[0], v[1]); w.y = cvt_pk_bf16(v[2], v[3]); *(u32x2*)(rp + n * 16) = w; } }
                }
        } else {
            const int s0 = 16 * (wc & 1) + 4 * fq;
#pragma unroll
            for (int ai = 0; ai < 2; ++ai)
#pragma unroll
                for (int m = 0; m < 4; ++m) {
                    const int row = row0 + ai * 128 + m * 16; const float rs = rstd4(sscq, row, 1.0f / 256.0f);
                    const int b = row >> 13, s = row & (SEQ - 1);
                    const float* rt = rope + (size_t)s * 64 + s0; const f32x4 cs = *(const f32x4*)rt, sn = *(const f32x4*)(rt + 32);
#pragma unroll
                    for (int bj = 0; bj < 2; ++bj) { const int h = 2 * bj + (wc >> 1); bf16_t* rp = qr + ((size_t)(b * 4 + h) * SEQ + s) * 64 + s0;
                        const f32x4 a = acc[ai][bj][m][0] * rs, bb = acc[ai][bj][m][1] * rs;
                        const f32x4 oa = a * cs - bb * sn, ob = a * sn + bb * cs;
                        u32x2 w; w.x = cvt_pk_bf16(oa[0], oa[1]); w.y = cvt_pk_bf16(oa[2], oa[3]); *(u32x2*)rp = w;
                        w.x = cvt_pk_bf16(ob[0], ob[1]); w.y = cvt_pk_bf16(ob[2], ob[3]); *(u32x2*)(rp + 32) = w; }
                }
        }
    }
};
struct EpiUkv {
    static constexpr bool PERM = false;
    unsigned char* ws;
    __device__ __forceinline__ void operator()(const AccT& acc, const Unit& u, int wr, int wc, int fr, int fq) const {
        const float* ssckv = (const float*)(ws + T_SSCKV); bf16_t* kn = (bf16_t*)(ws + T_KN); bf16_t* vv = (bf16_t*)(ws + T_V);
        const int row0 = u.pm * 256 + wr * 64 + fr, h = u.pn;
#pragma unroll
        for (int ai = 0; ai < 2; ++ai)
#pragma unroll
            for (int m = 0; m < 4; ++m) {
                const int row = row0 + ai * 128 + m * 16; const float rs = rstd4(ssckv, row, 1.0f / 128.0f);
                const int b = row >> 13, s = row & (SEQ - 1); const size_t base = ((size_t)(b * 4 + h) * SEQ + s) * 128 + wc * 32 + 4 * fq;
#pragma unroll
                for (int bj = 0; bj < 2; ++bj) { bf16_t* rp = (bj == 0 ? kn : vv) + base;
#pragma unroll
                    for (int n = 0; n < 2; ++n) { const f32x4 v = acc[ai][bj][m][n] * rs; u32x2 w; w.x = cvt_pk_bf16(v[0], v[1]); w.y = cvt_pk_bf16(v[2], v[3]); *(u32x2*)(rp + n * 16) = w; } }
            }
    }
};

__device__ __forceinline__ int map_col(int type, int nd, int& which) {
    which = 0;
    if (type == 1) { const int t = nd >> 8, r = nd & 255; which = r >> 7; return t * 128 + (r & 127); }
    if (type == 2) { if (nd >= 2016) return -1; if (nd >= 1152 && nd < 1216) { const int P = nd - 1152, w = P >> 5, n = (P >> 4) & 1, i = P & 15; return 1152 + 16 * w + i + 32 * n; } return nd; }
    if (type == 3) { if (nd < 512) { const int h = nd >> 7, d = nd & 127; return h * 192 + d; } const int Pp = nd - 512, h = Pp >> 6, P = Pp & 63; const int s = 16 * (P >> 5) + (P & 15) + 32 * ((P >> 4) & 1); return h * 192 + 128 + s; }
    return nd;
}
struct PrepJob { const float* src; const float* src2; const float* gain; bf16_t* dst; int Ks, Kd, Nsrc, Nd, type; };
__device__ __forceinline__ PrepJob prep_job(KP p, unsigned char* ws, int j) {
    const int l = j >> 3;
    switch (j & 7) {
        case 0: return PrepJob{p->in[2] + (size_t)l * DM * FF, p->in[3] + (size_t)l * DM * FF, p->in[1] + l * DM, (bf16_t*)(ws + OFF_WUP + (l * 2 + 0) * SZ_WUP), 1024, 1024, FF, 5632, 1};
        case 1: return PrepJob{p->in[30] + (size_t)l * DM * FF, p->in[31] + (size_t)l * DM * FF, p->in[29] + l * DM, (bf16_t*)(ws + OFF_WUP + (l * 2 + 1) * SZ_WUP), 1024, 1024, FF, 5632, 1};
        case 2: return PrepJob{p->in[4] + (size_t)l * FF * DM, nullptr, nullptr, (bf16_t*)(ws + OFF_WDN + (l * 2 + 0) * SZ_WDN), FF, FF, DM, DM, 0};
        case 3: return PrepJob{p->in[32] + (size_t)l * FF * DM, nullptr, nullptr, (bf16_t*)(ws + OFF_WDN + (l * 2 + 1) * SZ_WDN), FF, FF, DM, DM, 0};
        case 4: return PrepJob{p->in[6] + (size_t)l * DM * 2016, nullptr, p->in[5] + l * DM, (bf16_t*)(ws + OFF_WIN + l * SZ_WIN), 1024, 1024, 2016, 2048, 2};
        case 5: return PrepJob{p->in[28] + (size_t)l * DM * DM, nullptr, nullptr, (bf16_t*)(ws + OFF_WOUT + l * SZ_WOUT), 1024, 1024, 1024, 1024, 0};
        case 6: return PrepJob{p->in[19] + (size_t)l * 256 * 768, nullptr, p->in[18] + l * 256, (bf16_t*)(ws + OFF_WUQ + l * SZ_WUQ), 256, 256, 768, 768, 3};
        default: return PrepJob{p->in[21] + (size_t)l * 128 * 1024, nullptr, p->in[20] + l * 128, (bf16_t*)(ws + OFF_WUKV + l * SZ_WUKV), 128, 256, 1024, 1024, 0};
    }
}
__device__ __forceinline__ int prep_job_tiles(int j) { const int k = j & 7; return k < 2 ? 352 : k < 4 ? 176 : k == 4 ? 128 : k == 5 ? 64 : k == 6 ? 12 : 16; }
__device__ __forceinline__ void phase_prep(KP p, float* lds) {
    unsigned char* ws = opaque_ptr(p->ws); const int tid = opaque_tid(), wid = tid >> 6, lane = tid & 63;
    { float* tile = lds; constexpr int TOTAL = 2 * (352 * 2 + 176 * 2 + 128 + 64 + 12 + 16);
      float v[32]; bf16_t* dstp = nullptr; int Kd_c = 0, nd0_c = 0, k0_c = 0;
#define PREP_ISSUE(TT) do { int j_ = 0, t_ = (TT); \
          while (t_ >= prep_job_tiles(j_)) { t_ -= prep_job_tiles(j_); ++j_; } \
          const PrepJob J = prep_job(p, ws, j_); \
          const int ntk_ = J.Kd / 256, nd0_ = (t_ / ntk_) * 64, k0_ = (t_ % ntk_) * 256; \
          const int nn_ = tid & 63, kk_ = tid >> 6; int which_; const int ns_ = map_col(J.type, nd0_ + nn_, which_); const float* sp_ = which_ ? J.src2 : J.src; \
          _Pragma("unroll") for (int sub = 0; sub < 4; ++sub) _Pragma("unroll") for (int r = 0; r < 8; ++r) { const int k_ = k0_ + sub * 64 + kk_ + 8 * r; float x_ = 0.f; \
              if (ns_ >= 0 && k_ < J.Ks) { x_ = sp_[(size_t)k_ * J.Nsrc + ns_]; if (J.gain) x_ *= J.gain[k_]; } v[sub * 8 + r] = x_; } \
          dstp = J.dst; Kd_c = J.Kd; nd0_c = nd0_; k0_c = k0_; } while (0)
      int tt = opaque_bid();
      PREP_ISSUE(tt < TOTAL ? tt : TOTAL - 1);
      for (; tt < TOTAL; tt += gridDim.x) {
          { const int nn = tid & 63, kk = tid >> 6;
#pragma unroll
            for (int sub = 0; sub < 4; ++sub)
#pragma unroll
                for (int r = 0; r < 8; ++r) tile[sub * (64 * 65) + nn * 65 + kk + 8 * r] = v[sub * 8 + r]; }
          bf16_t* dcur = dstp; const int Kd = Kd_c, nd0 = nd0_c, k0 = k0_c;
          PREP_ISSUE(tt + (int)gridDim.x < TOTAL ? tt + (int)gridDim.x : TOTAL - 1);
          __syncthreads();
          { const int row = tid >> 3, kc = (tid & 7) * 8;
#pragma unroll
            for (int sub = 0; sub < 4; ++sub) { const float* tp = tile + sub * (64 * 65) + row * 65 + kc;
              u32x4 w; w.x = cvt_pk_bf16(tp[0], tp[1]); w.y = cvt_pk_bf16(tp[2], tp[3]); w.z = cvt_pk_bf16(tp[4], tp[5]); w.w = cvt_pk_bf16(tp[6], tp[7]);
              *(u32x4*)(dcur + (size_t)(nd0 + row) * Kd + k0 + sub * 64 + kc) = w; } }
          __syncthreads();
      } }
    { const float* x = p->in[0]; bf16_t* xb = (bf16_t*)(ws + OFF_XB); float* ssx = (float*)(ws + OFF_SSX);
      for (int rb = (opaque_bid() * 8 + wid) * 4; rb < NTOK; rb += gridDim.x * 32) {
          f32x4 v[4][4];
#pragma unroll
          for (int q = 0; q < 4; ++q)
#pragma unroll
              for (int i = 0; i < 4; ++i) v[q][i] = *(const f32x4*)(x + (size_t)(rb + q) * DM + lane * 16 + 4 * i);
#pragma unroll
          for (int q = 0; q < 4; ++q) { const int row = rb + q; float ss = 0.f;
#pragma unroll
              for (int i = 0; i < 4; ++i) ss += v[q][i][0] * v[q][i][0] + v[q][i][1] * v[q][i][1] + v[q][i][2] * v[q][i][2] + v[q][i][3] * v[q][i][3];
              u32x4 w0, w1; w0.x = cvt_pk_bf16(v[q][0][0], v[q][0][1]); w0.y = cvt_pk_bf16(v[q][0][2], v[q][0][3]); w0.z = cvt_pk_bf16(v[q][1][0], v[q][1][1]); w0.w = cvt_pk_bf16(v[q][1][2], v[q][1][3]);
              w1.x = cvt_pk_bf16(v[q][2][0], v[q][2][1]); w1.y = cvt_pk_bf16(v[q][2][2], v[q][2][3]); w1.z = cvt_pk_bf16(v[q][3][0], v[q][3][1]); w1.w = cvt_pk_bf16(v[q][3][2], v[q][3][3]);
              *(u32x4*)(xb + (size_t)row * DM + lane * 16) = w0; *(u32x4*)(xb + (size_t)row * DM + lane * 16 + 8) = w1;
              ss += __shfl_xor(ss, 1); ss += __shfl_xor(ss, 2);
              if ((lane & 3) == 0) ssx[(size_t)row * 16 + (lane >> 2)] = ss; }
      } }
    { float* rt = (float*)(ws + OFF_ROPE);
      for (int i = opaque_bid() * NTHR + tid; i < 8192 * 32; i += gridDim.x * NTHR) {
          const int pos = i >> 5, sx = i & 31; const float inv = __builtin_amdgcn_exp2f(-(float)sx * (13.287712379549449f / 32.0f));
          float rev = (float)pos * inv * 0.15915494309189535f; rev -= floorf(rev);
          rt[pos * 64 + sx] = cos_rev(rev); rt[pos * 64 + 32 + sx] = sin_rev(rev);
      } }
    { float* h2t = (float*)(ws + OFF_H2T); float* zs = lds; float* h1s = lds + 8 * 40;
      const int pp = tid >> 6, j = tid & 63;
      for (int l = 0; l < 2; ++l) {
          const float* w1 = p->in[9] + l * 33 * 64; const float* w2 = p->in[12] + l * 64 * 64;
          float w1c[33], w2c[64];
#pragma unroll
          for (int i = 0; i < 33; ++i) w1c[i] = w1[i * 64 + j];
#pragma unroll
          for (int i = 0; i < 64; ++i) w2c[i] = w2[i * 64 + j];
          const float b1 = p->in[10][l * 64 + j], f1 = p->in[11][l * 64 + j], b2 = p->in[13][l * 64 + j], f2 = p->in[14][l * 64 + j];
          for (int it = opaque_bid(); it < 1024; it += gridDim.x) {
              const int m0 = it * 8;
              __syncthreads();
              if (j < 33) { const int m = m0 + pp; float z;
                  if (j == 0) z = (float)m * (1.0f / 8191.0f);
                  else { const int bi = (j - 1) & 15; const float band = 1e-4f + (float)bi * ((15.0f - 1e-4f) / 15.0f); float rev = (float)m * band * (1.0f / 8192.0f); rev -= floorf(rev);
                         z = (j <= 16) ? cos_rev(rev) : -sin_rev(rev); }
                  zs[pp * 40 + j] = z; }
              __syncthreads();
              float a = b1;
#pragma unroll
              for (int i = 0; i < 33; ++i) a += zs[pp * 40 + i] * w1c[i];
              h1s[pp * 64 + j] = fast_sin(f1 * a);
              __syncthreads();
              float c = b2;
#pragma unroll
              for (int i = 0; i < 64; ++i) c += h1s[pp * 64 + i] * w2c[i];
              h2t[((size_t)l * 64 + j) * 8192 + m0 + pp] = fast_sin(f2 * c);
          }
      } }
}

namespace att {
constexpr float SCALE = 0.07216878364870322f;
constexpr float THR = 8.f;
constexpr int SHM_V = 64 * 128 * 2, SHM_K = 64 * 128 * 2, SHM_KR = 64 * 64 * 2;
constexpr int OFF_K = 2 * SHM_V, OFF_KR = OFF_K + 2 * SHM_K, OFF_QR = OFF_KR + 2 * SHM_KR, OFF_WS = OFF_QR + 8 * 8192, SHM_TOTAL = OFF_WS + 8 * 64 * 4;
static_assert(SHM_TOTAL <= LDS_BYTES, "attention LDS");
#define KSWZ(row, colB) ((row) * 256 + ((colB) ^ (((row) & 7) << 4)))
#define KRSWZ(row, chunk) ((row) * 128 + ((((chunk) ^ (((row) >> 1) & 7))) << 4))
#define SBAR() __builtin_amdgcn_sched_barrier(0)
__device__ __forceinline__ int crow(int r, int hi) { return (r & 3) + 8 * (r >> 2) + 4 * hi; }
__device__ __forceinline__ void partialSM(f32x16& p0, f32x16& p1, float& m_reg, float& mn, float& alpha) {
    constexpr float C = SCALE * 1.4426950408889634f;
    float pmax = p0[0];
#pragma unroll
    for (int r = 1; r < 16; ++r) pmax = fmaxf(pmax, p0[r]);
#pragma unroll
    for (int r = 0; r < 16; ++r) pmax = fmaxf(pmax, p1[r]);
    { auto rr = __builtin_amdgcn_permlane32_swap(__float_as_uint(pmax), __float_as_uint(pmax), false, false); pmax = fmaxf(__uint_as_float(rr[0]), __uint_as_float(rr[1])); }
    if (__builtin_expect(__all(pmax - m_reg <= THR / SCALE), 1)) { mn = m_reg; alpha = 1.f; }
    else { mn = fmaxf(m_reg, pmax); alpha = __builtin_amdgcn_exp2f((m_reg - mn) * C); m_reg = mn; }
    const float mnC = -mn * C;
#pragma unroll
    for (int r = 0; r < 16; ++r) p0[r] = fmaf(p0[r], C, mnC);
#pragma unroll
    for (int r = 0; r < 16; ++r) p1[r] = fmaf(p1[r], C, mnC);
#pragma unroll
    for (int r = 0; r < 16; ++r) p0[r] = __builtin_amdgcn_exp2f(p0[r]);
}
__device__ __forceinline__ void finishSM(f32x16& p0, f32x16& p1, float alpha, float& l_reg, bf16x8& pa0, bf16x8& pa1, bf16x8& pa2, bf16x8& pa3) {
#pragma unroll
    for (int r = 0; r < 16; ++r) p1[r] = __builtin_amdgcn_exp2f(p1[r]);
    float ps = 0;
#pragma unroll
    for (int r = 0; r < 16; ++r) ps += p0[r];
#pragma unroll
    for (int r = 0; r < 16; ++r) ps += p1[r];
    { auto rr = __builtin_amdgcn_permlane32_swap(__float_as_uint(ps), __float_as_uint(ps), false, false); ps = __uint_as_float(rr[0]) + __uint_as_float(rr[1]); }
    l_reg = l_reg * alpha + ps;
#define PK4(P, BASE, OUT) do { unsigned a0 = cvt_pk_bf16(P[BASE + 0], P[BASE + 1]), a1 = cvt_pk_bf16(P[BASE + 2], P[BASE + 3]);   \
    unsigned b0 = cvt_pk_bf16(P[BASE + 4], P[BASE + 5]), b1 = cvt_pk_bf16(P[BASE + 6], P[BASE + 7]);                              \
    auto r0 = __builtin_amdgcn_permlane32_swap(a0, b0, false, false); auto r1 = __builtin_amdgcn_permlane32_swap(a1, b1, false, false); \
    u32x4 w = {r0[0], r1[0], r0[1], r1[1]}; OUT = *reinterpret_cast<bf16x8*>(&w); } while (0)
    PK4(p0, 0, pa0); PK4(p0, 8, pa1); PK4(p1, 0, pa2); PK4(p1, 8, pa3);
#undef PK4
}
__device__ __forceinline__ void qkt(f32x16& p0, f32x16& p1, const char* Ks, const char* Krs, const bf16x8* qr, const char* qrl, int r32, int hi) {
    p0 = f32x16{}; p1 = f32x16{};
#pragma unroll
    for (int d0 = 0; d0 < 8; ++d0) { const int cb = (d0 * 16 + hi * 8) * 2;
        const bf16x8 b0 = *reinterpret_cast<const bf16x8*>(Ks + KSWZ(r32, cb));
        const bf16x8 b1 = *reinterpret_cast<const bf16x8*>(Ks + KSWZ(32 + r32, cb));
        const bf16x8 q = d0 < 4 ? qr[d0 & 3] : *reinterpret_cast<const bf16x8*>(qrl + d0 * 1024);
        p0 = __builtin_amdgcn_mfma_f32_32x32x16_bf16(b0, q, p0, 0, 0, 0);
        p1 = __builtin_amdgcn_mfma_f32_32x32x16_bf16(b1, q, p1, 0, 0, 0); }
#pragma unroll
    for (int d0 = 0; d0 < 4; ++d0) { const int ch = d0 * 2 + hi;
        const bf16x8 b0 = *reinterpret_cast<const bf16x8*>(Krs + KRSWZ(r32, ch));
        const bf16x8 b1 = *reinterpret_cast<const bf16x8*>(Krs + KRSWZ(32 + r32, ch));
        const bf16x8 q = *reinterpret_cast<const bf16x8*>(qrl + d0 * 1024);
        p0 = __builtin_amdgcn_mfma_f32_32x32x16_bf16(b0, q, p0, 0, 0, 0);
        p1 = __builtin_amdgcn_mfma_f32_32x32x16_bf16(b1, q, p1, 0, 0, 0); }
}
__device__ __forceinline__ int v_st(int k, int c) { const int kk = (k & ~0xC) | ((k & 4) << 1) | ((k & 8) >> 1); return ((kk >> 3) * 4 + (c >> 5)) * 512 + ((kk & 7) * 32 + (c & 31)) * 2; }
__device__ __forceinline__ int v_rd_base(int lane) { return ((lane & 3) << 3) | (((lane >> 2) & 3) << 6) | (((lane >> 4) & 1) << 5) | (((lane >> 5) & 1) << 8); }
constexpr int v_rd_off(int d0, int ks, int half) { return d0 * 512 + ks * 4096 + half * 2048; }
template <int OFF> __device__ __forceinline__ s16x4 tr_read(int vb) { s16x4 r; asm volatile("ds_read_b64_tr_b16 %0, %1 offset:%2" : "=&v"(r) : "v"(vb), "i"(OFF) : "memory"); return r; }
template <int D0> __device__ __forceinline__ void pv_one(f32x16& od, int vb, bf16x8 pa0, bf16x8 pa1, bf16x8 pa2, bf16x8 pa3) {
    const s16x4 l0 = tr_read<v_rd_off(D0, 0, 0)>(vb), h0 = tr_read<v_rd_off(D0, 0, 1)>(vb), l1 = tr_read<v_rd_off(D0, 1, 0)>(vb), h1 = tr_read<v_rd_off(D0, 1, 1)>(vb);
    const s16x4 l2 = tr_read<v_rd_off(D0, 2, 0)>(vb), h2 = tr_read<v_rd_off(D0, 2, 1)>(vb), l3 = tr_read<v_rd_off(D0, 3, 0)>(vb), h3 = tr_read<v_rd_off(D0, 3, 1)>(vb);
    asm volatile("s_waitcnt lgkmcnt(0)" ::: "memory"); SBAR();
#define PK(L, H) (bf16x8){L[0], L[1], L[2], L[3], H[0], H[1], H[2], H[3]}
    od = __builtin_amdgcn_mfma_f32_32x32x16_bf16(pa0, PK(l0, h0), od, 0, 0, 0);
    od = __builtin_amdgcn_mfma_f32_32x32x16_bf16(pa1, PK(l1, h1), od, 0, 0, 0);
    od = __builtin_amdgcn_mfma_f32_32x32x16_bf16(pa2, PK(l2, h2), od, 0, 0, 0);
    od = __builtin_amdgcn_mfma_f32_32x32x16_bf16(pa3, PK(l3, h3), od, 0, 0, 0);
#undef PK
}
__device__ __forceinline__ void pv_d0(f32x16* o, int vb, bf16x8 pa0, bf16x8 pa1, bf16x8 pa2, bf16x8 pa3) {
    pv_one<0>(o[0], vb, pa0, pa1, pa2, pa3); pv_one<1>(o[1], vb, pa0, pa1, pa2, pa3); pv_one<2>(o[2], vb, pa0, pa1, pa2, pa3); pv_one<3>(o[3], vb, pa0, pa1, pa2, pa3);
}
__device__ __forceinline__ void attn_body(const bf16_t* __restrict__ Qb, const bf16_t* __restrict__ QRb, const bf16_t* __restrict__ Kh, const bf16_t* __restrict__ Krh,
                                          const bf16_t* __restrict__ Vh, bf16_t* __restrict__ Ob, int seq, char* lds) {
    const int tid = opaque_tid(), wid = tid >> 6, lane = tid & 63, r32 = lane & 31, hi = lane >> 5;
    char* V_lds = lds; char* K_lds = lds + OFF_K; char* Kr_lds = lds + OFF_KR; char* qrl = lds + OFF_QR + wid * 8192 + lane * 16;
    float* wsf = (float*)(lds + OFF_WS) + wid * 64; float* li_l = wsf; float* al_l = wsf + 32;
    float m_reg = -1e30f, l_reg = 0; f32x16 o[4] = {}; bf16x8 qr[4];
    __syncthreads();
    { const bf16_t* Qw = Qb + (long)(wid * 32 + r32) * 128 + hi * 8;
#pragma unroll
      for (int d0 = 0; d0 < 4; ++d0) qr[d0] = *reinterpret_cast<const bf16x8*>(Qw + d0 * 16);
#pragma unroll
      for (int d0 = 4; d0 < 8; ++d0) *reinterpret_cast<bf16x8*>(qrl + d0 * 1024) = *reinterpret_cast<const bf16x8*>(Qw + d0 * 16);
      const bf16_t* QRw = QRb + (long)(wid * 32 + r32) * 64 + hi * 8;
#pragma unroll
      for (int d0 = 0; d0 < 4; ++d0) *reinterpret_cast<bf16x8*>(qrl + d0 * 1024) = *reinterpret_cast<const bf16x8*>(QRw + d0 * 16); }
    const int sr = tid >> 4, sc = (tid & 15) * 8, vst0 = v_st(sr, sc), vst1 = v_st(32 + sr, sc);
    const int krr = tid >> 3, krc = tid & 7, krst = KRSWZ(krr, krc);
    const int vb0 = (int)(uintptr_t)V_lds + v_rd_base(lane);
    struct { bf16x8 vs0, vs1, ks0, ks1, kr; } sr_[1];
#define SLOAD(i, k0) do { sr_[i].vs0 = *reinterpret_cast<const bf16x8*>(&Vh[(long)((k0) + sr) * 128 + sc]); sr_[i].vs1 = *reinterpret_cast<const bf16x8*>(&Vh[(long)((k0) + 32 + sr) * 128 + sc]); \
    sr_[i].ks0 = *reinterpret_cast<const bf16x8*>(&Kh[(long)((k0) + sr) * 128 + sc]); sr_[i].ks1 = *reinterpret_cast<const bf16x8*>(&Kh[(long)((k0) + 32 + sr) * 128 + sc]); \
    sr_[i].kr = *reinterpret_cast<const bf16x8*>(&Krh[(long)((k0) + krr) * 64 + krc * 8]); } while (0)
#define SWRITE(b, i) do { *(bf16x8*)(V_lds + (b) * SHM_V + vst0) = sr_[i].vs0; *(bf16x8*)(V_lds + (b) * SHM_V + vst1) = sr_[i].vs1; const int kc = sc * 2; \
    *(bf16x8*)(K_lds + (b) * SHM_K + KSWZ(sr, kc)) = sr_[i].ks0; *(bf16x8*)(K_lds + (b) * SHM_K + KSWZ(32 + sr, kc)) = sr_[i].ks1; \
    *(bf16x8*)(Kr_lds + (b) * SHM_KR + krst) = sr_[i].kr; } while (0)
#define SWAIT() asm volatile("s_waitcnt vmcnt(0)" ::: "memory")
#define RESC(a) do { if (__any((a) < 1.f)) { if (hi == 0) al_l[r32] = (a); asm volatile("s_waitcnt lgkmcnt(0)" ::: "memory"); \
    _Pragma("unroll") for (int d = 0; d < 4; ++d) _Pragma("unroll") for (int r = 0; r < 16; ++r) o[d][r] *= al_l[crow(r, hi)]; } } while (0)
    f32x16 pA0, pA1, pB0, pB1; float mnA, mnB, alA, alB; bf16x8 pa0, pa1, pa2, pa3; const int NT = seq / 64;
    constexpr int SE = 0, SO = 0;
    SLOAD(SE, 0); asm volatile("s_waitcnt vmcnt(0)" ::: "memory"); SWRITE(0, SE); __syncthreads();
    qkt(pA0, pA1, K_lds, Kr_lds, qr, qrl, r32, hi); partialSM(pA0, pA1, m_reg, mnA, alA);
    SLOAD(SO, 64);
    SWAIT(); SWRITE(1, SO); __syncthreads();
    for (int j = 1; j + 1 < NT; j += 2) {
        SBAR(); qkt(pB0, pB1, K_lds + SHM_K, Kr_lds + SHM_KR, qr, qrl, r32, hi);
        finishSM(pA0, pA1, alA, l_reg, pa0, pa1, pa2, pa3); SBAR();
        SLOAD(SO, (j + 1) * 64); SBAR();
        pv_d0(o, vb0, pa0, pa1, pa2, pa3); partialSM(pB0, pB1, m_reg, mnB, alB);
        __syncthreads(); SWAIT(); SWRITE(0, SE);
        RESC(alB); __syncthreads();
        SBAR(); qkt(pA0, pA1, K_lds, Kr_lds, qr, qrl, r32, hi);
        finishSM(pB0, pB1, alB, l_reg, pa0, pa1, pa2, pa3); SBAR();
        SLOAD(SE, (j + 2) * 64); SBAR();
        pv_d0(o, vb0 + SHM_V, pa0, pa1, pa2, pa3); partialSM(pA0, pA1, m_reg, mnA, alA);
        __syncthreads(); SWAIT(); SWRITE(1, SO);
        RESC(alA); __syncthreads();
    }
    SBAR(); qkt(pB0, pB1, K_lds + SHM_K, Kr_lds + SHM_KR, qr, qrl, r32, hi);
    finishSM(pA0, pA1, alA, l_reg, pa0, pa1, pa2, pa3); SBAR();
    pv_d0(o, vb0, pa0, pa1, pa2, pa3); partialSM(pB0, pB1, m_reg, mnB, alB);
    __syncthreads(); RESC(alB);
    finishSM(pB0, pB1, alB, l_reg, pa0, pa1, pa2, pa3); SBAR();
    pv_d0(o, vb0 + SHM_V, pa0, pa1, pa2, pa3);
    if (hi == 0) li_l[r32] = l_reg; asm volatile("s_waitcnt lgkmcnt(0)" ::: "memory");
    float rli[16];
#pragma unroll
    for (int r = 0; r < 16; ++r) rli[r] = __builtin_amdgcn_rcpf(li_l[crow(r, hi)]);
    bf16_t* Ow = Ob + (long)(wid * 32) * 512;
#pragma unroll
    for (int r = 0; r < 16; ++r) { const int orow = crow(r, hi);
#pragma unroll
        for (int d0 = 0; d0 < 4; ++d0) Ow[(long)orow * 512 + d0 * 32 + r32] = f2bf(o[d0][r] * rli[r]); }
#undef SLOAD
#undef SWRITE
#undef SWAIT
#undef RESC
}
}

__device__ __forceinline__ float2 cmul(float2 a, float2 b) { return make_float2(a.x * b.x - a.y * b.y, a.x * b.y + a.y * b.x); }
template <bool LAST = true, bool FIRST = true> __device__ __forceinline__ void fft_dif(float2* d) {
    const int tid = opaque_tid();
    for (int s = FIRST ? 0 : 1; s < 6; ++s) {
        const int lg = 12 - 2 * s, span = 1 << lg; const float rs = 1.0f / (float)(4 << lg);
#pragma unroll 4
        for (int i = 0; i < 8; ++i) {
            const int bf = tid + 512 * i, j = bf & (span - 1), g = bf >> lg, base = ((g << 2) << lg) + j;
            const float2 a0 = d[base], a1 = d[base + span], a2 = d[base + 2 * span], a3 = d[base + 3 * span];
            const float2 b0 = make_float2(a0.x + a2.x, a0.y + a2.y), b1 = make_float2(a0.x - a2.x, a0.y - a2.y), b2 = make_float2(a1.x + a3.x, a1.y + a3.y), b3 = make_float2(a1.x - a3.x, a1.y - a3.y);
            const float2 y0 = make_float2(b0.x + b2.x, b0.y + b2.y), y2 = make_float2(b0.x - b2.x, b0.y - b2.y);
            const float2 y1 = make_float2(b1.x + b3.y, b1.y - b3.x), y3 = make_float2(b1.x - b3.y, b1.y + b3.x);
            const float r = (float)j * rs;
            const float2 w1 = make_float2(cos_rev(r), -sin_rev(r)), w2 = make_float2(cos_rev(2.f * r), -sin_rev(2.f * r)), w3 = make_float2(cos_rev(3.f * r), -sin_rev(3.f * r));
            d[base] = y0; d[base + span] = cmul(y1, w1); d[base + 2 * span] = cmul(y2, w2); d[base + 3 * span] = cmul(y3, w3);
        }
        __syncthreads();
    }
    if (!LAST) return;
#pragma unroll 4
    for (int i = 0; i < 8; ++i) {
        f32x4* q = (f32x4*)(d + 4 * (tid + 512 * i));
        const f32x4 A = q[0], B = q[1];
        const float b0x = A[0] + B[0], b0y = A[1] + B[1], b1x = A[0] - B[0], b1y = A[1] - B[1], b2x = A[2] + B[2], b2y = A[3] + B[3], b3x = A[2] - B[2], b3y = A[3] - B[3];
        q[0] = (f32x4){b0x + b2x, b0y + b2y, b1x + b3y, b1y - b3x};
        q[1] = (f32x4){b0x - b2x, b0y - b2y, b1x - b3y, b1y + b3x};
    }
    __syncthreads();
}
template <bool FIRST = true, bool LASTS = true> __device__ __forceinline__ void fft_dit_inv(float2* d) {
    const int tid = opaque_tid();
    if (FIRST) {
#pragma unroll 4
    for (int i = 0; i < 8; ++i) {
        f32x4* q = (f32x4*)(d + 4 * (tid + 512 * i));
        const f32x4 A = q[0], B = q[1];
        const float c0x = A[0] + B[0], c0y = A[1] + B[1], c1x = A[0] - B[0], c1y = A[1] - B[1], c2x = A[2] + B[2], c2y = A[3] + B[3], c3x = A[2] - B[2], c3y = A[3] - B[3];
        q[0] = (f32x4){c0x + c2x, c0y + c2y, c1x - c3y, c1y + c3x};
        q[1] = (f32x4){c0x - c2x, c0y - c2y, c1x + c3y, c1y - c3x};
    }
    __syncthreads();
    }
    for (int s = 5; s >= (LASTS ? 0 : 1); --s) {
        const int lg = 12 - 2 * s, span = 1 << lg; const float rs = 1.0f / (float)(4 << lg);
#pragma unroll 4
        for (int i = 0; i < 8; ++i) {
            const int bf = tid + 512 * i, j = bf & (span - 1), g = bf >> lg, base = ((g << 2) << lg) + j;
            const float r = (float)j * rs;
            const float2 w1 = make_float2(cos_rev(r), sin_rev(r)), w2 = make_float2(cos_rev(2.f * r), sin_rev(2.f * r)), w3 = make_float2(cos_rev(3.f * r), sin_rev(3.f * r));
            const float2 y0 = d[base], y1 = cmul(d[base + span], w1), y2 = cmul(d[base + 2 * span], w2), y3 = cmul(d[base + 3 * span], w3);
            const float2 c0 = make_float2(y0.x + y2.x, y0.y + y2.y), c1 = make_float2(y0.x - y2.x, y0.y - y2.y), c2 = make_float2(y1.x + y3.x, y1.y + y3.y), c3 = make_float2(y1.x - y3.x, y1.y - y3.y);
            d[base] = make_float2(c0.x + c2.x, c0.y + c2.y); d[base + 2 * span] = make_float2(c0.x - c2.x, c0.y - c2.y);
            d[base + span] = make_float2(c1.x - c3.y, c1.y + c3.x); d[base + 3 * span] = make_float2(c1.x + c3.y, c1.y - c3.x);
        }
        __syncthreads();
    }
}
__device__ __forceinline__ float sconv(const bf16_t* p, int t, float w0, float w1, float w2, float bias) {
    const float a = t > 0 ? bf2f(p[t - 1]) : 0.f, b = bf2f(p[t]), c = t < SEQ - 1 ? bf2f(p[t + 1]) : 0.f;
    return bias + w0 * a + w1 * b + w2 * c;
}
__device__ __forceinline__ float2 sconv2(const bf16_t* p, int m, float w0, float w1, float w2, float bias) {
    const unsigned* pw = (const unsigned*)p;
    const unsigned wm = m > 0 ? pw[m - 1] : 0u, wc = pw[m], wp = m < SEQ / 2 - 1 ? pw[m + 1] : 0u;
    const float a = bfhi(wm), b = bflo(wc), c = bfhi(wc), d = bflo(wp);
    return make_float2(bias + w0 * a + w1 * b + w2 * c, bias + w0 * b + w1 * c + w2 * d);
}
__device__ __forceinline__ int rev4_14(int x) { const unsigned b = __brev((unsigned)x) >> 18; return (int)(((b & 0x1555u) << 1) | ((b >> 1) & 0x1555u)); }
__device__ __forceinline__ void hyena_filter(KP p, int l, int c, float2* data, float2* Kd, float delta) {
    const int tid = opaque_tid(); unsigned char* ws = opaque_ptr(p->ws);
    const float* h2t = (const float*)(ws + OFF_H2T) + (size_t)l * 64 * 8192; const float* w3 = p->in[15] + (size_t)l * 64 * 1024;
    const int m0 = tid * 16;
    f32x4 af0[4], ab0[4], af1[4], ab1[4];
#pragma unroll
    for (int q = 0; q < 4; ++q) { af0[q] = (f32x4){0.f, 0.f, 0.f, 0.f}; ab0[q] = af0[q]; af1[q] = af0[q]; ab1[q] = af0[q]; }
#pragma unroll 2
    for (int j = 0; j < 64; ++j) {
        const float wf0 = w3[j * 1024 + c], wb0 = w3[j * 1024 + 256 + c], wf1 = w3[j * 1024 + 512 + c], wb1 = w3[j * 1024 + 768 + c];
        const f32x4* hp = (const f32x4*)(h2t + j * 8192 + m0);
#pragma unroll
        for (int q = 0; q < 4; ++q) { const f32x4 h = hp[q]; af0[q] += h * wf0; ab0[q] += h * wb0; af1[q] += h * wf1; ab1[q] += h * wb1; }
    }
#pragma unroll
    for (int q = 0; q < 4; ++q)
#pragma unroll
        for (int k = 0; k < 4; ++k) {
            const int m = m0 + q * 4 + k; const float win = __expf(-((float)m * (1.0f / 8191.0f)) * delta);
            data[m] = make_float2(af0[q][k] * win, af1[q][k] * win);
            if (m >= 1) data[16384 - m] = make_float2(ab0[q][k] * win, ab1[q][k] * win);
        }
    if (tid == 0) data[8192] = make_float2(0.f, 0.f);
    __syncthreads();
    fft_dif(data);
#pragma unroll 8
    for (int i = 0; i < 32; ++i) { const int q = tid + 512 * i; const float2 v = data[q]; Kd[q] = make_float2(v.x * (1.0f / 16384.0f), v.y * (1.0f / 16384.0f)); }
    __syncthreads();
}
template <int O> __device__ __forceinline__ void hyena_mid(float2* d, const float2* Z) {
    const int tid = opaque_tid();
#pragma unroll 4
    for (int i = 0; i < 8; ++i) {
        const int q0 = 4 * (tid + 512 * i);
        f32x4* qp = (f32x4*)(d + q0);
        const f32x4 A = qp[0], B = qp[1];
        const f32x4 ZA = *(const f32x4*)(Z + q0), ZB = *(const f32x4*)(Z + q0 + 2);
        float2 z2[4];
#pragma unroll
        for (int e = 0; e < 4; ++e) { const int f = rev4_14(q0 + e); z2[e] = Z[rev4_14((16384 - f) & 16383)]; }
        const float b0x = A[0] + B[0], b0y = A[1] + B[1], b1x = A[0] - B[0], b1y = A[1] - B[1], b2x = A[2] + B[2], b2y = A[3] + B[3], b3x = A[2] - B[2], b3y = A[3] - B[3];
        float2 y[4] = {make_float2(b0x + b2x, b0y + b2y), make_float2(b1x + b3y, b1y - b3x), make_float2(b0x - b2x, b0y - b2y), make_float2(b1x - b3y, b1y + b3x)};
        const float2 z[4] = {make_float2(ZA[0], ZA[1]), make_float2(ZA[2], ZA[3]), make_float2(ZB[0], ZB[1]), make_float2(ZB[2], ZB[3])};
#pragma unroll
        for (int e = 0; e < 4; ++e) {
            const float2 k = O == 0 ? make_float2(0.5f * (z[e].x + z2[e].x), 0.5f * (z[e].y - z2[e].y)) : make_float2(0.5f * (z[e].y + z2[e].y), -0.5f * (z[e].x - z2[e].x));
            y[e] = cmul(y[e], k);
        }
        const float c0x = y[0].x + y[2].x, c0y = y[0].y + y[2].y, c1x = y[0].x - y[2].x, c1y = y[0].y - y[2].y, c2x = y[1].x + y[3].x, c2y = y[1].y + y[3].y, c3x = y[1].x - y[3].x, c3y = y[1].y - y[3].y;
        qp[0] = (f32x4){c0x + c2x, c0y + c2y, c1x - c3y, c1y + c3x};
        qp[1] = (f32x4){c0x - c2x, c0y - c2y, c1x + c3y, c1y - c3x};
    }
    __syncthreads();
}
template <int O> __device__ __forceinline__ void hyena_mul(float2* data, const float2* Z) {
    const int tid = opaque_tid();
#pragma unroll 8
    for (int i = 0; i < 32; ++i) {
        const int q = tid + 512 * i, f = rev4_14(q), q2 = rev4_14((16384 - f) & 16383);
        const float2 z = Z[q], z2 = Z[q2];
        const float2 k = O == 0 ? make_float2(0.5f * (z.x + z2.x), 0.5f * (z.y - z2.y)) : make_float2(0.5f * (z.y + z2.y), -0.5f * (z.x - z2.x));
        data[q] = cmul(data[q], k);
    }
    __syncthreads();
}
__device__ __forceinline__ void dif0_pair(float2* d, int j, f32x4 in0, f32x4 in1) {
    f32x4 o0, o1, o2, o3;
#pragma unroll
    for (int e = 0; e < 2; ++e) {
        const float2 a0 = make_float2(in0[2 * e], in0[2 * e + 1]), a1 = make_float2(in1[2 * e], in1[2 * e + 1]);
        const float r = (float)(j + e) * (1.0f / 16384.0f);
        const float2 w1 = make_float2(cos_rev(r), -sin_rev(r)), w2 = make_float2(cos_rev(2.f * r), -sin_rev(2.f * r)), w3 = make_float2(cos_rev(3.f * r), -sin_rev(3.f * r));
        const float2 y0 = make_float2(a0.x + a1.x, a0.y + a1.y), y2 = cmul(make_float2(a0.x - a1.x, a0.y - a1.y), w2);
        const float2 y1 = cmul(make_float2(a0.x + a1.y, a0.y - a1.x), w1), y3 = cmul(make_float2(a0.x - a1.y, a0.y + a1.x), w3);
        o0[2 * e] = y0.x; o0[2 * e + 1] = y0.y; o1[2 * e] = y1.x; o1[2 * e + 1] = y1.y; o2[2 * e] = y2.x; o2[2 * e + 1] = y2.y; o3[2 * e] = y3.x; o3[2 * e + 1] = y3.y;
    }
    *(f32x4*)(d + j) = o0; *(f32x4*)(d + j + 4096) = o1; *(f32x4*)(d + j + 8192) = o2; *(f32x4*)(d + j + 12288) = o3;
}
__device__ __forceinline__ void dit0_pair(const float2* d, int j, f32x4& out0, f32x4& out1) {
    const f32x4 i0 = *(const f32x4*)(d + j), i1 = *(const f32x4*)(d + j + 4096), i2 = *(const f32x4*)(d + j + 8192), i3 = *(const f32x4*)(d + j + 12288);
#pragma unroll
    for (int e = 0; e < 2; ++e) {
        const float r = (float)(j + e) * (1.0f / 16384.0f);
        const float2 w1 = make_float2(cos_rev(r), sin_rev(r)), w2 = make_float2(cos_rev(2.f * r), sin_rev(2.f * r)), w3 = make_float2(cos_rev(3.f * r), sin_rev(3.f * r));
        const float2 y0 = make_float2(i0[2 * e], i0[2 * e + 1]), y1 = cmul(make_float2(i1[2 * e], i1[2 * e + 1]), w1), y2 = cmul(make_float2(i2[2 * e], i2[2 * e + 1]), w2), y3 = cmul(make_float2(i3[2 * e], i3[2 * e + 1]), w3);
        const float2 c0 = make_float2(y0.x + y2.x, y0.y + y2.y), c1 = make_float2(y0.x - y2.x, y0.y - y2.y), c2 = make_float2(y1.x + y3.x, y1.y + y3.y), c3 = make_float2(y1.x - y3.x, y1.y - y3.y);
        out0[2 * e] = c0.x + c2.x; out0[2 * e + 1] = c0.y + c2.y; out1[2 * e] = c1.x - c3.y; out1[2 * e + 1] = c1.y + c3.x;
    }
}
__device__ __forceinline__ void hyena_item(KP p, int l, int c, float2* data, bool do_store) {
    const int tid = opaque_tid(); unsigned char* ws = opaque_ptr(p->ws);
    bf16_t* hv = (bf16_t*)(ws + T_HYT) + (size_t)c * NTOK; const bf16_t* hx1 = (const bf16_t*)(ws + T_HYT) + (size_t)(256 + c) * NTOK; const bf16_t* hx2 = (const bf16_t*)(ws + T_HYT) + (size_t)(512 + c) * NTOK;
    float2* RA = (float2*)(ws + T_FK) + (size_t)c * 2 * 16384; float2* RB = RA + 16384;
    const float* cw = p->in[7] + l * 3 * 768; const float* cb = p->in[8] + l * 768;
    const float wv0 = cw[c], wv1 = cw[768 + c], wv2 = cw[1536 + c], bv = cb[c];
    const float wa0 = cw[256 + c], wa1 = cw[768 + 256 + c], wa2 = cw[1536 + 256 + c], ba = cb[256 + c];
    const float wb0 = cw[512 + c], wb1 = cw[768 + 512 + c], wb2 = cw[1536 + 512 + c], bb = cb[512 + c];
    const float skip0 = p->in[16][l * 512 + c], skip1 = p->in[16][l * 512 + 256 + c];
    const float mind = -3.0701134573253945f, maxd = -15.350567286626973f;
    const float delta = fabsf(mind + (float)c * ((maxd - mind) / 255.0f));
    __syncthreads();
    hyena_filter(p, l, c, data, RA, delta);
#pragma unroll 1
    for (int pr = 0; pr < 2; ++pr) {
        const int o0 = (2 * pr) * SEQ, o1 = (2 * pr + 1) * SEQ;
        { const int tq = opaque_tid();
#pragma unroll
          for (int i = 0; i < 4; ++i) { const int m = tq + 512 * i;
              const float2 a0 = sconv2(hv + o0, m, wv0, wv1, wv2, bv), a1 = sconv2(hv + o1, m, wv0, wv1, wv2, bv);
              const float2 b0 = sconv2(hv + o0, m + 2048, wv0, wv1, wv2, bv), b1 = sconv2(hv + o1, m + 2048, wv0, wv1, wv2, bv);
              dif0_pair(data, 2 * m, (f32x4){a0.x, a1.x, a0.y, a1.y}, (f32x4){b0.x, b1.x, b0.y, b1.y}); } }
        __syncthreads();
        fft_dif<false, false>(data);
        hyena_mid<0>(data, RA);
        fft_dit_inv<false, false>(data);
        { const int tq = opaque_tid();
#pragma unroll
          for (int i = 0; i < 4; ++i) { const int m = tq + 512 * i; f32x4 cva, cvb; dit0_pair(data, 2 * m, cva, cvb);
              { const float2 v0 = sconv2(hv + o0, m, wv0, wv1, wv2, bv), v1 = sconv2(hv + o1, m, wv0, wv1, wv2, bv);
                const float2 x0 = sconv2(hx1 + o0, m, wa0, wa1, wa2, ba), x1 = sconv2(hx1 + o1, m, wa0, wa1, wa2, ba);
                *(f32x4*)(RB + pr * 8192 + 2 * m) = (f32x4){x0.x * (cva[0] + skip0 * v0.x), x1.x * (cva[1] + skip0 * v1.x), x0.y * (cva[2] + skip0 * v0.y), x1.y * (cva[3] + skip0 * v1.y)}; }
              { const int mb = m + 2048;
                const float2 v0 = sconv2(hv + o0, mb, wv0, wv1, wv2, bv), v1 = sconv2(hv + o1, mb, wv0, wv1, wv2, bv);
                const float2 x0 = sconv2(hx1 + o0, mb, wa0, wa1, wa2, ba), x1 = sconv2(hx1 + o1, mb, wa0, wa1, wa2, ba);
                *(f32x4*)(RB + pr * 8192 + 2 * mb) = (f32x4){x0.x * (cvb[0] + skip0 * v0.x), x1.x * (cvb[1] + skip0 * v1.x), x0.y * (cvb[2] + skip0 * v0.y), x1.y * (cvb[3] + skip0 * v1.y)}; } } }
        __syncthreads();
    }
#pragma unroll 1
    for (int pr = 0; pr < 2; ++pr) {
        const int o0 = (2 * pr) * SEQ, o1 = (2 * pr + 1) * SEQ;
        { const int tq = opaque_tid();
#pragma unroll
          for (int i = 0; i < 4; ++i) { const int m = tq + 512 * i;
              dif0_pair(data, 2 * m, *(const f32x4*)(RB + pr * 8192 + 2 * m), *(const f32x4*)(RB + pr * 8192 + 2 * m + 4096)); } }
        __syncthreads();
        fft_dif<false, false>(data);
        hyena_mid<1>(data, RA);
        fft_dit_inv<false, false>(data);
        { const int tq = opaque_tid();
#pragma unroll
          for (int i = 0; i < 4; ++i) { const int m = tq + 512 * i; f32x4 cva, cvb; dit0_pair(data, 2 * m, cva, cvb);
              { const f32x4 y1 = *(const f32x4*)(RB + pr * 8192 + 2 * m);
                const float2 x0 = sconv2(hx2 + o0, m, wb0, wb1, wb2, bb), x1 = sconv2(hx2 + o1, m, wb0, wb1, wb2, bb);
                if (do_store) { *(unsigned*)(hv + o0 + 2 * m) = cvt_pk_bf16(x0.x * (cva[0] + skip1 * y1[0]), x0.y * (cva[2] + skip1 * y1[2]));
                                *(unsigned*)(hv + o1 + 2 * m) = cvt_pk_bf16(x1.x * (cva[1] + skip1 * y1[1]), x1.y * (cva[3] + skip1 * y1[3])); } }
              { const int mb = m + 2048; const f32x4 y1 = *(const f32x4*)(RB + pr * 8192 + 2 * mb);
                const float2 x0 = sconv2(hx2 + o0, mb, wb0, wb1, wb2, bb), x1 = sconv2(hx2 + o1, mb, wb0, wb1, wb2, bb);
                if (do_store) { *(unsigned*)(hv + o0 + 2 * mb) = cvt_pk_bf16(x0.x * (cvb[0] + skip1 * y1[0]), x0.y * (cvb[2] + skip1 * y1[2]));
                                *(unsigned*)(hv + o1 + 2 * mb) = cvt_pk_bf16(x1.x * (cvb[1] + skip1 * y1[1]), x1.y * (cvb[3] + skip1 * y1[3])); } } } }
        __syncthreads();
    }
}

constexpr int G_QF = 0, G_QB = G_QF + 64 * 33, G_KF = G_QB + 64 * 33, G_KB = G_KF + 32 * 68, G_V = G_KB + 32 * 68, G_A = G_V + 64 * 68, G_S = G_A + 64 * 68, G_T = G_S + 32 * 68,
              G_GF = G_T + 32 * 68, G_GB = G_GF + 64 * 33, G_O = G_GB + 64 * 33, G_O1 = G_O + 64 * 68, G_END = G_O1 + 64 * 68;
static_assert(G_END * 4 <= LDS_BYTES, "gla lds");
template <int CTRL, int ROW_MASK> __device__ __forceinline__ float dpp_add(float v) {
    const int s = __builtin_amdgcn_update_dpp(0, __float_as_int(v), CTRL, ROW_MASK, 0xf, true);
    return v + __int_as_float(s);
}
__device__ __forceinline__ float wave_incl_scan(float v) {
    v = dpp_add<0x111, 0xf>(v); v = dpp_add<0x112, 0xf>(v); v = dpp_add<0x114, 0xf>(v); v = dpp_add<0x118, 0xf>(v);
    v = dpp_add<0x142, 0xa>(v); v = dpp_add<0x143, 0xc>(v);
    return v;
}
struct GlaLoads { f32x4 gx[8]; u32x4 vw; u32x2 qw, kw; };
__device__ __forceinline__ GlaLoads gla_issue(KP p, int it) {
    const int tid = opaque_tid(), wid = __builtin_amdgcn_readfirstlane(tid >> 6), lane = tid & 63; unsigned char* ws = opaque_ptr(p->ws);
    const int h = it & 3, n = (it >> 2) & 127, b = it >> 9, row0 = b * SEQ + n * 64;
    const bf16_t* gin = (const bf16_t*)(ws + T_GIN); const float* gg = (const float*)(ws + T_GG);
    GlaLoads g;
    { const f32x4* gr = (const f32x4*)(gg + (size_t)(row0 + lane) * 32);
#pragma unroll
      for (int q = 0; q < 8; ++q) g.gx[q] = gr[q]; }
    g.vw = *(const u32x4*)(gin + (size_t)(row0 + (tid >> 3)) * 832 + 256 + h * 64 + (tid & 7) * 8);
    g.qw = *(const u32x2*)(gin + (size_t)(row0 + lane) * 832 + h * 32 + 4 * wid); g.kw = *(const u32x2*)(gin + (size_t)(row0 + lane) * 832 + 128 + h * 32 + 4 * wid);
    return g;
}
template <bool NEED_Q> __device__ __forceinline__ void gla_prepare(KP p, int l, int h, const GlaLoads& g, float* L) {
    const int tid = opaque_tid(), wid = __builtin_amdgcn_readfirstlane(tid >> 6), lane = tid & 63;
    const float* wf = p->in[23] + l * 16 * 128 + h * 32 + 4 * wid; const float* wb = p->in[25] + l * 16 * 128 + h * 32 + 4 * wid;
    f32x4 af = *(const f32x4*)(p->in[24] + l * 128 + h * 32 + 4 * wid), ab = *(const f32x4*)(p->in[26] + l * 128 + h * 32 + 4 * wid);
#pragma unroll
    for (int r = 0; r < 16; ++r) { const float xf = g.gx[r >> 2][r & 3], xb = g.gx[4 + (r >> 2)][r & 3];
        af += *(const f32x4*)(wf + r * 128) * xf; ab += *(const f32x4*)(wb + r * 128) * xb; }
    float bb[4], cc[4];
#pragma unroll
    for (int k = 0; k < 4; ++k) {
        const float vf = (fminf(af[k], 0.f) - __logf(1.f + __expf(-fabsf(af[k])))) * (1.0f / 16.0f), vb = (fminf(ab[k], 0.f) - __logf(1.f + __expf(-fabsf(ab[k])))) * (1.0f / 16.0f);
        const float pf = wave_incl_scan(vf), pb = wave_incl_scan(vb);
        const float tot = __int_as_float(__builtin_amdgcn_readlane(__float_as_int(pb), 63));
        bb[k] = pf; cc[k] = tot - pb + vb; }
    __syncthreads();
    { float* vp = L + G_V + (tid >> 3) * 68 + (tid & 7) * 8; const u32x4 vw = g.vw;
      vp[0] = bflo(vw.x); vp[1] = bfhi(vw.x); vp[2] = bflo(vw.y); vp[3] = bfhi(vw.y); vp[4] = bflo(vw.z); vp[5] = bfhi(vw.z); vp[6] = bflo(vw.w); vp[7] = bfhi(vw.w); }
    { const u32x2 qw = g.qw, kw = g.kw; const float qv[4] = {bflo(qw.x), bfhi(qw.x), bflo(qw.y), bfhi(qw.y)}, kv[4] = {bflo(kw.x), bfhi(kw.x), bflo(kw.y), bfhi(kw.y)};
#pragma unroll
      for (int k = 0; k < 4; ++k) { const int d = 4 * wid + k; const float qs = qv[k] * 0.17677669529663687f;
          if (NEED_Q) { L[G_QF + lane * 33 + d] = qs * __expf(bb[k]); L[G_QB + lane * 33 + d] = qs * __expf(cc[k]); }
          L[G_KF + d * 68 + lane] = kv[k] * __expf(-bb[k]); L[G_KB + d * 68 + lane] = kv[k] * __expf(-cc[k]);
          if (lane == 63) L[G_GF + 63 * 33 + d] = bb[k];
          if (lane == 0) L[G_GB + d] = cc[k]; } }
    __syncthreads();
}
__device__ __forceinline__ int crow32(int r, int hi) { return (r & 3) + 8 * (r >> 2) + 4 * hi; }
__device__ __forceinline__ void gla_pass1(KP p, int l, float* L) {
    const int tid = opaque_tid(), wid = tid >> 6, lane = tid & 63, c = lane & 31, kh = lane >> 5; unsigned char* ws = opaque_ptr(p->ws);
    float* SF = (float*)(ws + T_SF); float* SB = (float*)(ws + T_SB); float* DF = (float*)(ws + T_DF); float* DB = (float*)(ws + T_DB);
    int it = opaque_bid(); if (it >= 2048) return;
    GlaLoads cur = gla_issue(p, it);
    for (; it < 2048; it += gridDim.x) {
        const int h = it & 3, n = (it >> 2) & 127, b = it >> 9;
        const int itn = it + (int)gridDim.x < 2048 ? it + (int)gridDim.x : it;
        const GlaLoads nxt = gla_issue(p, itn);
        gla_prepare<false>(p, l, h, cur, L);
        cur = nxt;
        if (wid < 4) {
            const int te = wid & 1, dir = wid >> 1; const float* Kx = L + (dir ? G_KB : G_KF) + c * 68 + kh; const float* Vx = L + G_V + kh * 68 + 32 * te + c;
            f32x16 acc = {};
#pragma unroll 8
            for (int kk = 0; kk < 32; ++kk) acc = __builtin_amdgcn_mfma_f32_32x32x2f32(Kx[2 * kk], Vx[2 * kk * 68], acc, 0, 0, 0);
            float* Sx = (dir ? SB : SF) + ((size_t)((b * 4 + h) * 128 + n)) * 2048 + 32 * te + c;
#pragma unroll
            for (int r = 0; r < 16; ++r) { const int d = crow32(r, kh); const float sc = __expf(dir ? L[G_GB + d] : L[G_GF + 63 * 33 + d]); Sx[d * 64] = acc[r] * sc; }
        }
        if (tid < 32) { DF[((b * 4 + h) * 128 + n) * 32 + tid] = __expf(L[G_GF + 63 * 33 + tid]); DB[((b * 4 + h) * 128 + n) * 32 + tid] = __expf(L[G_GB + tid]); }
    }
}
__device__ __forceinline__ void gla_pass2(KP p) {
    unsigned char* ws = opaque_ptr(p->ws); const int gid = opaque_bid() * NTHR + opaque_tid();
    if (gid >= 65536) return;
    const int bh = gid >> 12, dir = (gid >> 11) & 1, el = gid & 2047, d = el >> 6;
    float* S = (float*)(ws + (dir ? T_SB : T_SF)) + (size_t)bh * 128 * 2048 + el; const float* Dc = (const float*)(ws + (dir ? T_DB : T_DF)) + bh * 128 * 32 + d;
    float st = 0.f;
    for (int n0 = 0; n0 < 128; n0 += 32) {
        float Lv[32], Dv[32];
#pragma unroll
        for (int k = 0; k < 32; ++k) { const int n = dir ? 127 - (n0 + k) : n0 + k; Lv[k] = S[(size_t)n * 2048]; Dv[k] = Dc[n * 32]; }
#pragma unroll
        for (int k = 0; k < 32; ++k) { const int n = dir ? 127 - (n0 + k) : n0 + k; S[(size_t)n * 2048] = st; st = Dv[k] * st + Lv[k]; }
    }
}
__device__ __forceinline__ void gla_pass3(KP p, int l, float* L) {
    const int tid = opaque_tid(), wid = tid >> 6, lane = tid & 63, c = lane & 31, kh = lane >> 5; unsigned char* ws = opaque_ptr(p->ws);
    const float* SF = (const float*)(ws + T_SF); const float* SB = (const float*)(ws + T_SB);
    const bf16_t* gin = (const bf16_t*)(ws + T_GIN); bf16_t* mixb = (bf16_t*)(ws + T_MIXB);
    int it = opaque_bid(); if (it >= 2048) return;
    GlaLoads cur = gla_issue(p, it);
    for (; it < 2048; it += gridDim.x) {
        const int h = it & 3, n = (it >> 2) & 127, b = it >> 9;
        const size_t so = ((size_t)((b * 4 + h) * 128 + n)) * 2048 + tid * 4;
        const f32x4 sreg = *(const f32x4*)(SF + so), treg = *(const f32x4*)(SB + so);
        const int i0 = (tid >> 4) * 2, e0 = (tid & 15) * 4;
        const u32x2 rw0 = *(const u32x2*)(gin + (size_t)(b * SEQ + n * 64 + i0) * 832 + 544 + h * 64 + e0), rw1 = *(const u32x2*)(gin + (size_t)(b * SEQ + n * 64 + i0 + 1) * 832 + 544 + h * 64 + e0);
        const f32x4 gn = *(const f32x4*)(p->in[27] + l * 64 + e0);
        const int itn = it + (int)gridDim.x < 2048 ? it + (int)gridDim.x : it;
        const GlaLoads nxt = gla_issue(p, itn);
        gla_prepare<true>(p, l, h, cur, L);
        cur = nxt;
        { const int d = tid >> 4; *(f32x4*)(L + G_S + d * 68 + e0) = sreg; *(f32x4*)(L + G_T + d * 68 + e0) = treg; }
        { const int ti = (wid >> 1) & 1, tj = wid & 1, dir = wid >> 2;
          const float* Qx = L + (dir ? G_QB : G_QF) + (32 * ti + c) * 33 + kh; const float* Kx = L + (dir ? G_KB : G_KF) + kh * 68 + 32 * tj + c;
          f32x16 acc = {};
#pragma unroll
          for (int kk = 0; kk < 16; ++kk) acc = __builtin_amdgcn_mfma_f32_32x32x2f32(Qx[2 * kk], Kx[2 * kk * 68], acc, 0, 0, 0);
          const int j = 32 * tj + c;
#pragma unroll
          for (int r = 0; r < 16; ++r) { const int i = 32 * ti + crow32(r, kh); const bool mine = dir ? (j > i) : (j <= i); if (mine) L[G_A + i * 65 + j] = acc[r]; } }
        __syncthreads();
        { const int ti = (wid >> 1) & 1, te = wid & 1, half = wid >> 2; f32x16 acc = {};
          if (half == 0) {
              const float* Ax = L + G_A + (32 * ti + c) * 65 + kh; const float* Vx = L + G_V + kh * 68 + 32 * te + c;
#pragma unroll 8
              for (int kk = 0; kk < 32; ++kk) acc = __builtin_amdgcn_mfma_f32_32x32x2f32(Ax[2 * kk], Vx[2 * kk * 68], acc, 0, 0, 0);
          } else {
              const float* Qf = L + G_QF + (32 * ti + c) * 33 + kh; const float* Qb = L + G_QB + (32 * ti + c) * 33 + kh;
              const float* Sx = L + G_S + kh * 68 + 32 * te + c; const float* Tx = L + G_T + kh * 68 + 32 * te + c;
#pragma unroll
              for (int kk = 0; kk < 16; ++kk) acc = __builtin_amdgcn_mfma_f32_32x32x2f32(Qf[2 * kk], Sx[2 * kk * 68], acc, 0, 0, 0);
#pragma unroll
              for (int kk = 0; kk < 16; ++kk) acc = __builtin_amdgcn_mfma_f32_32x32x2f32(Qb[2 * kk], Tx[2 * kk * 68], acc, 0, 0, 0);
#pragma unroll
              for (int r = 0; r < 16; ++r) L[G_O1 + (32 * ti + crow32(r, kh)) * 68 + 32 * te + c] = acc[r];
          }
          __syncthreads();
          if (half == 0) {
#pragma unroll
              for (int r = 0; r < 16; ++r) { const int o = (32 * ti + crow32(r, kh)) * 68 + 32 * te + c; L[G_O + o] = acc[r] + L[G_O1 + o]; }
          } }
        __syncthreads();
        const f32x4 o0 = *(const f32x4*)(L + G_O + i0 * 68 + e0), o1 = *(const f32x4*)(L + G_O + (i0 + 1) * 68 + e0);
        float s0 = o0[0] * o0[0] + o0[1] * o0[1] + o0[2] * o0[2] + o0[3] * o0[3], s1 = o1[0] * o1[0] + o1[1] * o1[1] + o1[2] * o1[2] + o1[3] * o1[3];
        s0 = dpp_add<0x128, 0xf>(s0); s0 = dpp_add<0x124, 0xf>(s0); s0 = dpp_add<0x122, 0xf>(s0); s0 = dpp_add<0x121, 0xf>(s0);
        s1 = dpp_add<0x128, 0xf>(s1); s1 = dpp_add<0x124, 0xf>(s1); s1 = dpp_add<0x122, 0xf>(s1); s1 = dpp_add<0x121, 0xf>(s1);
        const float r0 = rsqrtf(s0 * (1.0f / 64.0f) + 1e-6f), r1 = rsqrtf(s1 * (1.0f / 64.0f) + 1e-6f);
#pragma unroll
        for (int rr = 0; rr < 2; ++rr) { const int row = b * SEQ + n * 64 + i0 + rr; const f32x4 ov = rr ? o1 : o0; const float rs = rr ? r1 : r0;
            const u32x2 rw = rr ? rw1 : rw0; const float rv[4] = {bflo(rw.x), bfhi(rw.x), bflo(rw.y), bfhi(rw.y)};
            float ot[4];
#pragma unroll
            for (int k = 0; k < 4; ++k) ot[k] = ov[k] * rs * gn[k] * (rv[k] * __builtin_amdgcn_rcpf(1.f + __expf(-rv[k])));
            u32x2 w; w.x = cvt_pk_bf16(ot[0], ot[1]); w.y = cvt_pk_bf16(ot[2], ot[3]); *(u32x2*)(mixb + (size_t)row * DM + 768 + h * 64 + e0) = w; }
    }
}

__device__ __forceinline__ void mix_assemble(KP p, int l, float* L) {
    const int tid = opaque_tid(), wid = tid >> 6, lane = tid & 63; unsigned char* ws = opaque_ptr(p->ws);
    const bf16_t* hy = (const bf16_t*)(ws + T_HYT); bf16_t* mixb = (bf16_t*)(ws + T_MIXB); const bf16_t* atto = (const bf16_t*)(ws + T_ATTO);
    const float* gh = p->in[17] + l * 256; const float* gm = p->in[22] + l * 512;
    float* tile = L; float* red = L + 256 * 65;
    for (int it = opaque_bid(); it < NTOK / 64; it += gridDim.x) {
        const int row0 = it * 64;
        __syncthreads();
        { const int c = tid >> 1, t0 = (tid & 1) * 32; const bf16_t* sp = hy + (size_t)c * NTOK + row0 + t0;
#pragma unroll
          for (int q = 0; q < 4; ++q) { const u32x4 w = *(const u32x4*)(sp + q * 8); float* tp = tile + c * 65 + t0 + q * 8;
              tp[0] = bflo(w.x); tp[1] = bfhi(w.x); tp[2] = bflo(w.y); tp[3] = bfhi(w.y); tp[4] = bflo(w.z); tp[5] = bfhi(w.z); tp[6] = bflo(w.w); tp[7] = bfhi(w.w); } }
        __syncthreads();
        { const int t = tid & 63, part = tid >> 6; float ss = 0.f;
#pragma unroll 8
          for (int cc = 0; cc < 32; ++cc) { const float v = tile[(part * 32 + cc) * 65 + t]; ss += v * v; }
          red[part * 64 + t] = ss; }
        __syncthreads();
        { const int t = tid >> 3, cg8 = (tid & 7) * 32; float ss = 0.f;
#pragma unroll
          for (int q = 0; q < 8; ++q) ss += red[q * 64 + t];
          const float rs = rsqrtf(ss * (1.0f / 256.0f) + 1e-6f); bf16_t* op = mixb + (size_t)(row0 + t) * DM + cg8;
#pragma unroll
          for (int q = 0; q < 4; ++q) { float v[8];
#pragma unroll
              for (int k = 0; k < 8; ++k) v[k] = tile[(cg8 + q * 8 + k) * 65 + t] * rs * gh[cg8 + q * 8 + k];
              u32x4 w; w.x = cvt_pk_bf16(v[0], v[1]); w.y = cvt_pk_bf16(v[2], v[3]); w.z = cvt_pk_bf16(v[4], v[5]); w.w = cvt_pk_bf16(v[6], v[7]);
              *(u32x4*)(op + q * 8) = w; } }
    }
    for (int rb = (opaque_bid() * 8 + wid) * 4; rb < NTOK; rb += gridDim.x * 32) {
        u32x4 w[4];
#pragma unroll
        for (int q = 0; q < 4; ++q) w[q] = *(const u32x4*)(atto + (size_t)(rb + q) * 512 + lane * 8);
        const f32x4 g0 = *(const f32x4*)(gm + lane * 8), g1 = *(const f32x4*)(gm + lane * 8 + 4);
#pragma unroll
        for (int q = 0; q < 4; ++q) {
            float v[8] = {bflo(w[q].x), bfhi(w[q].x), bflo(w[q].y), bfhi(w[q].y), bflo(w[q].z), bfhi(w[q].z), bflo(w[q].w), bfhi(w[q].w)}; float ss = 0.f;
#pragma unroll
            for (int k = 0; k < 8; ++k) ss += v[k] * v[k];
#pragma unroll
            for (int sft = 1; sft < 64; sft <<= 1) ss += __shfl_xor(ss, sft);
            const float rs = rsqrtf(ss * (1.0f / 512.0f) + 1e-6f);
#pragma unroll
            for (int k = 0; k < 8; ++k) v[k] *= rs * (k < 4 ? g0[k & 3] : g1[k & 3]);
            u32x4 o; o.x = cvt_pk_bf16(v[0], v[1]); o.y = cvt_pk_bf16(v[2], v[3]); o.z = cvt_pk_bf16(v[4], v[5]); o.w = cvt_pk_bf16(v[6], v[7]);
            *(u32x4*)(mixb + (size_t)(rb + q) * DM + 256 + lane * 8) = o;
        }
    }
}

#define XB_TMO      128
#define XB_XCNT(j)  (256  + 64 * (j))
#define XB_XSUB(j)  (1280 + 64 * (j))
#define XB_XGEN(j)  (2304 + 64 * (j))
#define XB_TOP      3328
#define XB_TOPGEN   3392
#define XCD_BAR_WORDS 3456
#define XB_SPIN_CAP (1u << 20)
__device__ __forceinline__ unsigned xb_ld(unsigned* p)              { return __hip_atomic_load(p, __ATOMIC_RELAXED, __HIP_MEMORY_SCOPE_AGENT); }
__device__ __forceinline__ unsigned xb_add(unsigned* p, unsigned v) { return __hip_atomic_fetch_add(p, v, __ATOMIC_RELAXED, __HIP_MEMORY_SCOPE_AGENT); }
__device__ __forceinline__ unsigned xb_xcc_id() { return (unsigned)__builtin_amdgcn_s_getreg((3 << 11) | 20) & 0xFu; }
#define XB_SPIN(cond, bar) do { unsigned _sp = 0; while (cond) { __builtin_amdgcn_s_sleep(1); \
    if ((++_sp & 255u) == 0u) { if (xb_ld(&(bar)[XB_TMO])) break; if (_sp > XB_SPIN_CAP) { atomicAdd(&(bar)[XB_TMO], 1u); break; } } } } while (0)
struct XcdBarrier { unsigned* bar; unsigned x; volatile LAS unsigned* st; };
__device__ __forceinline__ XcdBarrier xcd_barrier_post(unsigned* bar, volatile LAS unsigned* st) {
    XcdBarrier b; b.bar = bar; b.x = xb_xcc_id(); b.st = st;
    if (threadIdx.x == 0) (void)xb_add(&bar[XB_XCNT(b.x)], 1u);
    return b;
}
__device__ __forceinline__ void xcd_barrier_complete(unsigned* bar, unsigned x, unsigned& nloc, unsigned& nx) {
    const unsigned G = gridDim.x * gridDim.y * gridDim.z;
    unsigned sum, cnt, mine, sp = 0u;
    for (;;) {
        sum = 0u; cnt = 0u; mine = 0u;
#pragma unroll
        for (unsigned j = 0; j < 16; ++j) { const unsigned c = xb_ld(&bar[XB_XCNT(j)]); sum += c; cnt += (c > 0u) ? 1u : 0u; mine = (j == x) ? c : mine; }
        if (sum == G) break;
        __builtin_amdgcn_s_sleep(1);
        if ((++sp & 255u) == 0u) { if (xb_ld(&bar[XB_TMO])) break; if (sp > XB_SPIN_CAP) { atomicAdd(&bar[XB_TMO], 1u); break; } }
    }
    nloc = mine > 0u ? mine : 1u; nx = cnt > 0u ? cnt : 1u;
}
__device__ __forceinline__ void xcd_barrier(const XcdBarrier& b) {
    asm volatile("s_waitcnt vmcnt(0)" ::: "memory");
    __syncthreads();
    if (threadIdx.x == 0) {
        unsigned* bar = b.bar;
        __builtin_amdgcn_s_waitcnt(0);
        unsigned nloc = b.st[0], nx = b.st[1];
        if (nloc == 0u) { xcd_barrier_complete(bar, b.x, nloc, nx); b.st[0] = nloc; b.st[1] = nx; }
        const unsigned old = xb_add(&bar[XB_XSUB(b.x)], 1u);
        const unsigned gen = old / nloc;
        if (old + 1u == (gen + 1u) * nloc) {
            __builtin_amdgcn_fence(__ATOMIC_RELEASE, "agent");
            asm volatile("s_waitcnt vmcnt(0)" ::: "memory");
            const unsigned og = xb_add(&bar[XB_TOP], 1u);
            const unsigned tg = og / nx;
            if (og + 1u == (tg + 1u) * nx) xb_add(&bar[XB_TOPGEN], 1u);
            else XB_SPIN(xb_ld(&bar[XB_TOPGEN]) == tg, bar);
            __builtin_amdgcn_fence(__ATOMIC_ACQUIRE, "agent");
            xb_add(&bar[XB_XGEN(b.x)], 1u);
            asm volatile("s_waitcnt vmcnt(0)" ::: "memory");
        } else {
            XB_SPIN(xb_ld(&bar[XB_XGEN(b.x)]) == gen, bar);
            __builtin_amdgcn_fence(__ATOMIC_ACQUIRE, "agent");
            asm volatile("s_waitcnt vmcnt(0)" ::: "memory");
        }
    }
    __syncthreads();
}

template <int SEL> __global__ __launch_bounds__(NTHR, 2) void mega_t(Params pv) {
    extern __shared__ __attribute__((aligned(16))) unsigned char shm[];
    cg::grid_group grid = cg::this_grid();
    __shared__ uint4 xb_words;
    if (threadIdx.x == 0) xb_words = make_uint4(0u, 0u, 0u, 0u);
    __syncthreads();
    const XcdBarrier xb = xcd_barrier_post((unsigned*)(pv.ws + OFF_BAR), (volatile LAS unsigned*)&xb_words);
    const KP kp = (KP)__builtin_amdgcn_kernarg_segment_ptr();
    unsigned char* ws = pv.ws;
    float* X = pv.out; bf16_t* XB = (bf16_t*)(ws + OFF_XB); float* SSX = (float*)(ws + OFF_SSX);
    for (int ph = pv.ph_lo; ph < pv.ph_hi; ++ph) {
        KP p = kp; asm volatile("" : "+s"(p));
        if (ph == 0) { if constexpr (SEL < 0 || SEL == 100) for (int r0 = 0; r0 < (PROBE_REP == 100 ? 2 : 1); ++r0) phase_prep(p, (float*)shm); }
        else if (ph == 19) { if constexpr (SEL < 0 || SEL == 101) {
            const float* g = p->in[33]; const int tid = opaque_tid(), wid = tid >> 6, lane = tid & 63;
            f32x4 gv[4];
#pragma unroll
            for (int i = 0; i < 4; ++i) gv[i] = *(const f32x4*)(g + lane * 16 + 4 * i);
            for (int rb = (opaque_bid() * 8 + wid) * 4; rb < NTOK; rb += gridDim.x * 32) {
                u32x4 w0[4], w1[4]; float rs[4];
#pragma unroll
                for (int q = 0; q < 4; ++q) { const bf16_t* bp = XB + (size_t)(rb + q) * DM + lane * 16; w0[q] = *(const u32x4*)bp; w1[q] = *(const u32x4*)(bp + 8); rs[q] = rstd16(SSX, rb + q); }
#pragma unroll
                for (int q = 0; q < 4; ++q) { float* xp = X + (size_t)(rb + q) * DM + lane * 16;
                    const float xv[16] = {bflo(w0[q].x), bfhi(w0[q].x), bflo(w0[q].y), bfhi(w0[q].y), bflo(w0[q].z), bfhi(w0[q].z), bflo(w0[q].w), bfhi(w0[q].w), bflo(w1[q].x), bfhi(w1[q].x), bflo(w1[q].y), bfhi(w1[q].y), bflo(w1[q].z), bfhi(w1[q].z), bflo(w1[q].w), bfhi(w1[q].w)};
#pragma unroll
                    for (int i = 0; i < 4; ++i) { f32x4 v = {xv[4 * i], xv[4 * i + 1], xv[4 * i + 2], xv[4 * i + 3]}; v = v * rs[q] * gv[i]; *(f32x4*)(xp + 4 * i) = v; } }
            } }
        } else {
            const int l = (ph - 1) / 9, sp = (ph - 1) % 9;
            pg8::StaticOrder S;
            if constexpr (SEL < 0 || SEL == 0) if (sp == 0 || sp == 7) {
                const int f = sp == 0 ? 0 : 1;
                pg8::Gemm g{XB, (const bf16_t*)(ws + OFF_WUP + (l * 2 + f) * SZ_WUP), NTOK, 5632, 1024, 1024}; S.init(g.M, g.N, gridDim.x, opaque_bid());
                EpiFfnUp E{ws, -1, {0.f, 0.f, 0.f, 0.f, 0.f, 0.f, 0.f, 0.f}};
                for (int r1 = 0; r1 < (PROBE_REP == 0 ? 2 : 1); ++r1) pg8::gemm_phase(( LAS unsigned char*)shm, g, S, E);
            }
            if constexpr (SEL < 0 || SEL == 1) if (sp == 1 || sp == 8) {
                const int f = sp == 1 ? 0 : 1;
                pg8::Gemm g{(const bf16_t*)(ws + T_ACT), (const bf16_t*)(ws + OFF_WDN + (l * 2 + f) * SZ_WDN), NTOK, 1024, FF, FF}; S.init(g.M, g.N, gridDim.x, opaque_bid());
                for (int r1 = (PROBE_REP == 1 ? 0 : 1); r1 < 2; ++r1) { EpiResid E{ws, r1 == 0 ? 0.f : 0.5f};
                pg8::gemm_phase((LAS unsigned char*)shm, g, S, E); }
            }
            if constexpr (SEL < 0 || SEL == 2) if (sp == 2) {
                pg8::Gemm g{XB, (const bf16_t*)(ws + OFF_WIN + l * SZ_WIN), NTOK, 2048, 1024, 1024}; S.init(g.M, g.N, gridDim.x, opaque_bid());
                EpiWin E{ws};
                for (int r1 = 0; r1 < (PROBE_REP == 2 ? 2 : 1); ++r1) pg8::gemm_phase((LAS unsigned char*)shm, g, S, E);
            }
            if constexpr (SEL < 0 || SEL == 30 || SEL == 31 || SEL == 32) if (sp == 3) {
                if constexpr (SEL < 0 || SEL == 30) for (int r3 = 0; r3 < (PROBE_REP == 30 ? 2 : 1); ++r3) {
                { pg8::Gemm g{(const bf16_t*)(ws + T_CQB), (const bf16_t*)(ws + OFF_WUQ + l * SZ_WUQ), NTOK, 768, 256, 256}; S.init(g.M, g.N, gridDim.x, opaque_bid());
                  EpiUq E{ws};
                  pg8::gemm_phase((LAS unsigned char*)shm, g, S, E); }
                { pg8::Gemm g{(const bf16_t*)(ws + T_CKVB), (const bf16_t*)(ws + OFF_WUKV + l * SZ_WUKV), NTOK, 1024, 256, 256}; S.init(g.M, g.N, gridDim.x, opaque_bid());
                  EpiUkv E{ws};
                  pg8::gemm_phase((LAS unsigned char*)shm, g, S, E); }
                }
                if constexpr (SEL < 0 || SEL == 31) for (int r3 = (PROBE_REP == 31 ? 0 : 1); r3 < 2; ++r3) for (int c = opaque_bid(); c < 256; c += gridDim.x) hyena_item(p, l, c, (float2*)shm, r3 == 1);
                if constexpr (SEL < 0 || SEL == 32) for (int r3 = 0; r3 < (PROBE_REP == 32 ? 2 : 1); ++r3) gla_pass1(p, l, (float*)shm);
            }
            if constexpr (SEL < 0 || SEL == 4) if (sp == 4) {
                gla_pass2(p);
                const bf16_t* QN = (const bf16_t*)(ws + T_QN); const bf16_t* QR = (const bf16_t*)(ws + T_QR); const bf16_t* KN = (const bf16_t*)(ws + T_KN);
                const bf16_t* KR = (const bf16_t*)(ws + T_KR); const bf16_t* VV = (const bf16_t*)(ws + T_V); bf16_t* AO = (bf16_t*)(ws + T_ATTO);
                const int nper = (512 * 8) / (int)gridDim.x;
                (void)nper;
                for (int r4 = 0; r4 < (PROBE_REP == 4 ? 2 : 1); ++r4)
                for (int it = opaque_bid(); it < 512; it += gridDim.x) {
                    const int x = it & 7, y = it >> 3;
                    const int bh = x + 8 * (y >> 5), qb = y & 31;
                    const int b = bh >> 2, h = bh & 3;
                    const size_t hoff = ((size_t)bh * SEQ) * 128;
                    att::attn_body(QN + hoff + (size_t)qb * 256 * 128, QR + ((size_t)bh * SEQ + qb * 256) * 64, KN + hoff, KR + (size_t)b * SEQ * 64, VV + hoff,
                                   AO + ((size_t)b * SEQ + qb * 256) * 512 + h * 128, SEQ, (char*)shm);
                }
            }
            if constexpr (SEL < 0 || SEL == 5) if (sp == 5) {
                for (int r5 = 0; r5 < (PROBE_REP == 50 ? 2 : 1); ++r5) mix_assemble(p, l, (float*)shm);
                for (int r5 = 0; r5 < (PROBE_REP == 51 ? 2 : 1); ++r5) gla_pass3(p, l, (float*)shm);
            }
            if constexpr (SEL < 0 || SEL == 6) if (sp == 6) {
                pg8::Gemm g{(const bf16_t*)(ws + T_MIXB), (const bf16_t*)(ws + OFF_WOUT + l * SZ_WOUT), NTOK, 1024, 1024, 1024}; S.init(g.M, g.N, gridDim.x, opaque_bid());
                for (int r1 = (PROBE_REP == 6 ? 0 : 1); r1 < 2; ++r1) { EpiResid E{ws, r1 == 0 ? 0.f : 1.0f};
                pg8::gemm_phase((LAS unsigned char*)shm, g, S, E); }
            }
        }
        if (ph + 1 < pv.ph_hi) { if (pv.ph_hi > 1000) grid.sync(); else xcd_barrier(xb); }
    }
}

#if MK_COOP
#define MEGA_MAIN mega_t<-1>
#else
#define MEGA_MAIN mega_t<0>
#endif
extern "C" void kernel_launch(void* const* d_in, const int* in_sizes, int n_in, void* d_out, int out_size, void* d_ws, size_t ws_size, hipStream_t stream) {
    static int grid_blocks = 0;
    if (grid_blocks == 0) {
        if (n_in != 34 || out_size != NTOK * DM || ws_size < WS_END) { fprintf(stderr, "kernel_launch: unexpected shapes n_in %d out %d ws %zu (need %zu)\n", n_in, out_size, ws_size, (size_t)WS_END); grid_blocks = -1; return; }
        if (hipFuncSetAttribute((const void*)MEGA_MAIN, hipFuncAttributeMaxDynamicSharedMemorySize, LDS_BYTES) != hipSuccess) { fprintf(stderr, "kernel_launch: hipFuncSetAttribute failed\n"); grid_blocks = -1; return; }
        int dev = 0, cus = 0, per_cu = 0;
        (void)hipGetDevice(&dev); (void)hipDeviceGetAttribute(&cus, hipDeviceAttributeMultiprocessorCount, dev);
        (void)hipOccupancyMaxActiveBlocksPerMultiprocessor(&per_cu, (const void*)MEGA_MAIN, NTHR, LDS_BYTES);
        if (per_cu < 1) { fprintf(stderr, "kernel_launch: occupancy query says %d blocks/CU\n", per_cu); per_cu = 1; }
        (void)hipGetLastError();
        grid_blocks = cus * per_cu;
        fprintf(stderr, "kernel_launch: grid %d (cus %d x %d)\n", grid_blocks, cus, per_cu);
    }
    if (grid_blocks < 0) return;
    Params p{};
    for (int i = 0; i < 34; ++i) p.in[i] = (const float*)d_in[i];
    p.out = (float*)d_out; p.ws = (unsigned char*)d_ws;
    if (hipMemsetAsync((unsigned char*)d_ws + OFF_BAR, 0, 16384, stream) != hipSuccess) { fprintf(stderr, "kernel_launch: memset of barrier words failed\n"); return; }
#if MK_COOP == 2
    for (int ph = 0; ph < 20; ++ph) { p.ph_lo = ph; p.ph_hi = ph + 1; hipLaunchKernelGGL(mega_t<-1>, dim3(grid_blocks), dim3(NTHR), LDS_BYTES, stream, p); }
#elif MK_COOP
    p.ph_lo = 0; p.ph_hi = 20;
    void* args[] = {&p};
    hipError_t e = hipLaunchCooperativeKernel((const void*)mega_t<-1>, dim3(grid_blocks), dim3(NTHR), args, LDS_BYTES, stream);
    if (e != hipSuccess) fprintf(stderr, "cooperative launch failed: %s (grid %d)\n", hipGetErrorString(e), grid_blocks);
#else
    static int attr_done = 0;
    if (!attr_done) {
        attr_done = 1;
        (void)hipFuncSetAttribute((const void*)mega_t<0>, hipFuncAttributeMaxDynamicSharedMemorySize, LDS_BYTES); (void)hipFuncSetAttribute((const void*)mega_t<1>, hipFuncAttributeMaxDynamicSharedMemorySize, LDS_BYTES);
        (void)hipFuncSetAttribute((const void*)mega_t<2>, hipFuncAttributeMaxDynamicSharedMemorySize, LDS_BYTES); (void)hipFuncSetAttribute((const void*)mega_t<30>, hipFuncAttributeMaxDynamicSharedMemorySize, LDS_BYTES); (void)hipFuncSetAttribute((const void*)mega_t<31>, hipFuncAttributeMaxDynamicSharedMemorySize, LDS_BYTES); (void)hipFuncSetAttribute((const void*)mega_t<32>, hipFuncAttributeMaxDynamicSharedMemorySize, LDS_BYTES);
        (void)hipFuncSetAttribute((const void*)mega_t<4>, hipFuncAttributeMaxDynamicSharedMemorySize, LDS_BYTES); (void)hipFuncSetAttribute((const void*)mega_t<5>, hipFuncAttributeMaxDynamicSharedMemorySize, LDS_BYTES);
        (void)hipFuncSetAttribute((const void*)mega_t<6>, hipFuncAttributeMaxDynamicSharedMemorySize, LDS_BYTES); (void)hipFuncSetAttribute((const void*)mega_t<100>, hipFuncAttributeMaxDynamicSharedMemorySize, LDS_BYTES);
        (void)hipFuncSetAttribute((const void*)mega_t<101>, hipFuncAttributeMaxDynamicSharedMemorySize, LDS_BYTES);
    }
    for (int ph = 0; ph < 20; ++ph) {
        p.ph_lo = ph; p.ph_hi = ph + 1;
        const int sp = (ph == 0) ? 100 : (ph == 19) ? 101 : (ph - 1) % 9;
        switch (sp) {
            case 0: case 7: hipLaunchKernelGGL(mega_t<0>, dim3(grid_blocks), dim3(NTHR), LDS_BYTES, stream, p); break;
            case 1: case 8: hipLaunchKernelGGL(mega_t<1>, dim3(grid_blocks), dim3(NTHR), LDS_BYTES, stream, p); break;
            case 2: hipLaunchKernelGGL(mega_t<2>, dim3(grid_blocks), dim3(NTHR), LDS_BYTES, stream, p); break;
            case 3: hipLaunchKernelGGL(mega_t<30>, dim3(grid_blocks), dim3(NTHR), LDS_BYTES, stream, p); hipLaunchKernelGGL(mega_t<31>, dim3(grid_blocks), dim3(NTHR), LDS_BYTES, stream, p);
                    hipLaunchKernelGGL(mega_t<32>, dim3(grid_blocks), dim3(NTHR), LDS_BYTES, stream, p); break;
            case 4: hipLaunchKernelGGL(mega_t<4>, dim3(grid_blocks), dim3(NTHR), LDS_BYTES, stream, p); break;
            case 5: hipLaunchKernelGGL(mega_t<5>, dim3(grid_blocks), dim3(NTHR), LDS_BYTES, stream, p); break;
            case 6: hipLaunchKernelGGL(mega_t<6>, dim3(grid_blocks), dim3(NTHR), LDS_BYTES, stream, p); break;
            case 100: hipLaunchKernelGGL(mega_t<100>, dim3(grid_blocks), dim3(NTHR), LDS_BYTES, stream, p); break;
            default: hipLaunchKernelGGL(mega_t<101>, dim3(grid_blocks), dim3(NTHR), LDS_BYTES, stream, p); break;
        }
    }
#endif
}
```

```cpp
#include <hip/hip_runtime.h>
#include <hip/hip_cooperative_groups.h>
#include <cstdio>
#include <cstdint>
namespace cg = cooperative_groups;

#ifndef MK_COOP
#define MK_COOP 1
#endif
#ifndef PROBE_REP
#define PROBE_REP -1
#endif

typedef unsigned short bf16_t;
typedef short bf16x8 __attribute__((ext_vector_type(8)));
typedef short s16x4 __attribute__((ext_vector_type(4)));
typedef float f32x4 __attribute__((ext_vector_type(4)));
typedef float f32x16 __attribute__((ext_vector_type(16)));
typedef unsigned u32x4 __attribute__((ext_vector_type(4)));
typedef unsigned u32x2 __attribute__((ext_vector_type(2)));
#define LAS __attribute__((address_space(3)))

constexpr int NTOK = 32768, DM = 1024, FF = 2816, SEQ = 8192, NB = 4;
constexpr int NTHR = 512;
constexpr int LDS_BYTES = 149504;

constexpr size_t SZ_WUP = (size_t)5632 * 1024 * 2, SZ_WDN = (size_t)1024 * 2816 * 2, SZ_WIN = (size_t)2048 * 1024 * 2, SZ_WOUT = (size_t)1024 * 1024 * 2,
                 SZ_WUQ = (size_t)768 * 256 * 2, SZ_WUKV = (size_t)1024 * 256 * 2;
constexpr size_t OFF_WUP = 0, OFF_WDN = OFF_WUP + 4 * SZ_WUP, OFF_WIN = OFF_WDN + 4 * SZ_WDN, OFF_WOUT = OFF_WIN + 2 * SZ_WIN, OFF_WUQ = OFF_WOUT + 2 * SZ_WOUT,
                 OFF_WUKV = OFF_WUQ + 2 * SZ_WUQ, OFF_XB = OFF_WUKV + 2 * SZ_WUKV, OFF_SSX = OFF_XB + (size_t)NTOK * DM * 2, OFF_H2T = OFF_SSX + (size_t)NTOK * 16 * 4,
                 OFF_ROPE = OFF_H2T + (size_t)2 * 64 * 8192 * 4, OFF_BAR = OFF_ROPE + (size_t)8192 * 64 * 4, OFF_TR = OFF_BAR + 16384;
constexpr size_t T_ACT = OFF_TR;
constexpr size_t T_HYT = OFF_TR;
constexpr size_t T_CQB = T_HYT + (size_t)768 * NTOK * 2;
constexpr size_t T_CKVB = T_CQB + (size_t)NTOK * 256 * 2;
constexpr size_t T_SSCQ = T_CKVB + (size_t)NTOK * 256 * 2;
constexpr size_t T_SSCKV = T_SSCQ + (size_t)NTOK * 4 * 4;
constexpr size_t T_KR = T_SSCKV + (size_t)NTOK * 4 * 4;
constexpr size_t T_GIN = T_KR + (size_t)NTOK * 64 * 2;
constexpr size_t T_GG = T_GIN + (size_t)NTOK * 832 * 2;
constexpr size_t T_FK = T_GG + (size_t)NTOK * 32 * 4;
constexpr size_t T_ATTO = T_FK;
constexpr size_t T_SF = T_FK + (size_t)256 * 2 * 16384 * 8;
constexpr size_t T_SB = T_SF + (size_t)16 * 128 * 2048 * 4;
constexpr size_t T_DF = T_SB + (size_t)16 * 128 * 2048 * 4;
constexpr size_t T_DB = T_DF + (size_t)16 * 128 * 32 * 4;
constexpr size_t T_QN = T_DB + (size_t)16 * 128 * 32 * 4;
constexpr size_t T_MIXB = T_QN;
constexpr size_t T_QR = T_QN + (size_t)NTOK * 4 * 128 * 2;
constexpr size_t T_KN = T_QR + (size_t)NTOK * 4 * 64 * 2;
constexpr size_t T_V = T_KN + (size_t)NTOK * 4 * 128 * 2;
constexpr size_t WS_END = T_V + (size_t)NTOK * 4 * 128 * 2;
static_assert(WS_END <= (size_t)536870912, "workspace over 512 MiB");
static_assert(T_ACT + (size_t)NTOK * FF * 2 <= WS_END, "act");
static_assert((size_t)NTOK * DM * 2 <= (T_KN + (size_t)NTOK * 4 * 128 * 2) - T_QN, "mixb alias");

struct Params {
    const float* in[34];
    float* out;
    unsigned char* ws;
    int ph_lo, ph_hi;
};

typedef const Params __attribute__((address_space(4)))* KP;
__device__ __forceinline__ int opaque_tid() { int t = threadIdx.x; asm volatile("" : "+v"(t)); return t; }
__device__ __forceinline__ unsigned char* opaque_ptr(unsigned char* q) { return q; }
__device__ __forceinline__ int opaque_bid() { int t = blockIdx.x; asm volatile("" : "+s"(t)); return t; }
__device__ __forceinline__ unsigned cvt_pk_bf16(float lo, float hi) { unsigned r; asm volatile("v_cvt_pk_bf16_f32 %0, %1, %2" : "=v"(r) : "v"(lo), "v"(hi)); return r; }
__device__ __forceinline__ bf16_t f2bf(float f) { return (bf16_t)(cvt_pk_bf16(f, 0.f) & 0xffffu); }
__device__ __forceinline__ float bf2f(bf16_t b) { return __uint_as_float(((unsigned)b) << 16); }
__device__ __forceinline__ float bflo(unsigned w) { return __uint_as_float(w << 16); }
__device__ __forceinline__ float bfhi(unsigned w) { return __uint_as_float(w & 0xffff0000u); }
__device__ __forceinline__ float sin_rev(float r) { return __builtin_amdgcn_sinf(r); }
__device__ __forceinline__ float cos_rev(float r) { return __builtin_amdgcn_cosf(r); }
__device__ __forceinline__ float fast_sin(float x) { float r = x * 0.15915494309189535f; r = r - floorf(r); return __builtin_amdgcn_sinf(r); }
__device__ __forceinline__ float quad_sum(float s) {
    auto a = __builtin_amdgcn_permlane16_swap(__float_as_uint(s), __float_as_uint(s), false, false); s = __uint_as_float(a[0]) + __uint_as_float(a[1]);
    auto b = __builtin_amdgcn_permlane32_swap(__float_as_uint(s), __float_as_uint(s), false, false); return __uint_as_float(b[0]) + __uint_as_float(b[1]);
}
__device__ __forceinline__ float rstd16(const float* ss, int row) {
    const f32x4* p = (const f32x4*)(ss + (size_t)row * 16); const f32x4 a = p[0], b = p[1], c = p[2], d = p[3];
    const float s = ((a.x + a.y) + (a.z + a.w)) + ((b.x + b.y) + (b.z + b.w)) + ((c.x + c.y) + (c.z + c.w)) + ((d.x + d.y) + (d.z + d.w));
    return rsqrtf(s * (1.0f / 1024.0f) + 1e-6f);
}
__device__ __forceinline__ float rstd16q(const float* ss, int row, int fq) {
    const f32x4 a = *(const f32x4*)(ss + (size_t)row * 16 + 4 * fq); float s = (a.x + a.y) + (a.z + a.w);
    s = quad_sum(s);
    return rsqrtf(s * (1.0f / 1024.0f) + 1e-6f);
}
__device__ __forceinline__ float rstd4(const float* ss, int row, float invn) {
    const f32x4 a = *(const f32x4*)(ss + (size_t)row * 4); return rsqrtf(((a.x + a.y) + (a.z + a.w)) * invn + 1e-6f);
}

namespace pg8 {
constexpr int BM = 256, BK = 64, HALF = 128, HTB = HALF * BK * 2, NXCD = 8, WGM = 8;
__host__ __device__ __forceinline__ int lds_byte(int r, int c) { const int st = (r >> 4) * 2 + (c >> 5), rr = r & 15, cc = c & 31, ob = rr * 64 + cc * 2; return st * 1024 + (ob ^ (((ob >> 9) & 1) << 5)); }
__host__ __device__ __forceinline__ void stage_rc(int b, int& R, int& C) { const int st = b / 1024, sb = b % 1024, swz = sb ^ (((sb >> 9) & 1) << 5); R = (st >> 1) * 16 + swz / 64; C = (st & 1) * 32 + (swz % 64) / 2; }
__host__ __device__ __forceinline__ int perm32(int rho) { const int n = rho >> 4, i = rho & 15; return 8 * (i >> 2) + 4 * n + (i & 3); }
struct Unit { int pm, pn; };
struct Gemm { const bf16_t* A; const bf16_t* Bt; int M, N, K, lda; };
struct StaticOrder {
    int nM, nN, nwg, G, c;
    __device__ void init(int M, int N, int G_, int c_) { nM = M / BM; nN = N / BM; nwg = nM * nN; G = G_; c = c_; }
    __device__ bool next(int i, Unit& u) const {
        const long L = (long)i * G + c; if (L >= nwg) return false;
        int wgid = (int)L; { const int q = nwg / NXCD, r = nwg % NXCD, xcd = wgid % NXCD, off = wgid / NXCD; wgid = (xcd < r ? xcd * (q + 1) : r * (q + 1) + (xcd - r) * q) + off; }
        const int nig = WGM * nN, gid = wgid / nig, fm = gid * WGM, gsz = (nM - fm) < WGM ? (nM - fm) : WGM;
        u.pm = fm + ((wgid % nig) % gsz); u.pn = (wgid % nig) / gsz; return true;
    }
};
template <class Epi>
__device__ __forceinline__ void gemm_phase(LAS unsigned char* lds, const Gemm g, const StaticOrder& S, Epi& E) {
    const int tid = opaque_tid(), wid = __builtin_amdgcn_readfirstlane(tid >> 6), lane = tid & 63, wr = wid >> 2, wc = wid & 3, fr = lane & 15, fq = lane >> 4;
    int K = g.K, lda = g.lda; asm volatile("" : "+s"(K), "+s"(lda));
    const int nt = K / BK;
    unsigned voffA[2], voffB[2];
#pragma unroll
    for (int i = 0; i < 2; ++i) { int R, C; stage_rc(tid * 16 + i * 8192, R, C); const int Rb = Epi::PERM ? ((R & ~31) + perm32(R & 31)) : R; voffA[i] = (unsigned)(R * lda + C) * 2u; voffB[i] = (unsigned)(Rb * K + C) * 2u; }
    const size_t kstep = (size_t)(BK * 2);
    const size_t hstepA = (size_t)HALF * lda * 2, hstepB = (size_t)HALF * K * 2;
    const size_t tstepA = 2 * hstepA, tstepB = 2 * hstepB;
    const unsigned ldsw = (unsigned)wid * 1024u;
    const int aoff = lds_byte(wr * 64 + fr, fq * 8), boff = lds_byte(wc * 32 + fr, fq * 8);
#define PG8_SA(b, h) (((b) * 2 + (h)) * HTB)
#define PG8_SB(b, h) ((4 + (b) * 2 + (h)) * HTB)
#define PG8_STAGE(bufoff, gbase, voff) do { _Pragma("unroll") for (int _i = 0; _i < 2; ++_i) \
        __builtin_amdgcn_global_load_lds((const unsigned*)((const char*)(gbase) + (voff)[_i]), (LAS unsigned*)(lds + (bufoff) + ldsw + _i * 8192), 16, 0, 0); } while (0)
#define PG8_LDA(dst, b, h) do { _Pragma("unroll") for (int m = 0; m < 4; ++m) _Pragma("unroll") for (int k = 0; k < 2; ++k) dst[m][k] = *(const LAS bf16x8*)(lds + PG8_SA(b, h) + aoff + m * 2048 + k * 1024); } while (0)
#define PG8_LDB(dst, b, h) do { _Pragma("unroll") for (int n = 0; n < 2; ++n) _Pragma("unroll") for (int k = 0; k < 2; ++k) dst[n][k] = *(const LAS bf16x8*)(lds + PG8_SB(b, h) + boff + n * 2048 + k * 1024); } while (0)
#define PG8_MMA(ai, bj, At, Bt) do { __builtin_amdgcn_s_setprio(1); _Pragma("unroll") for (int m = 0; m < 4; ++m) _Pragma("unroll") for (int n = 0; n < 2; ++n) _Pragma("unroll") for (int k = 0; k < 2; ++k) \
        acc[ai][bj][m][n] = __builtin_amdgcn_mfma_f32_16x16x32_bf16(Bt[n][k], At[m][k], acc[ai][bj][m][n], 0, 0, 0); __builtin_amdgcn_s_setprio(0); } while (0)
#define PG8_WAIT_V(n) asm volatile("s_waitcnt vmcnt(" #n ")" ::: "memory")
#define PG8_WAIT_L(n) asm volatile("s_waitcnt lgkmcnt(" #n ")" ::: "memory")
#define PG8_BAR __builtin_amdgcn_s_barrier()
#define PG8_SCHED __builtin_amdgcn_sched_barrier(0)
    Unit cur, nxt; int ui = 0;
    if (!S.next(0, cur)) return;
    f32x4 acc[2][2][4][2];
#pragma unroll
    for (int a = 0; a < 2; ++a)
#pragma unroll
        for (int b = 0; b < 2; ++b)
#pragma unroll
            for (int m = 0; m < 4; ++m)
#pragma unroll
                for (int n = 0; n < 2; ++n) acc[a][b][m][n] = (f32x4){0.f, 0.f, 0.f, 0.f};
    bf16x8 At[4][2], B0[2][2], B1[2][2];
    const char* cA = (const char*)g.A + (size_t)cur.pm * tstepA; const char* cB = (const char*)g.Bt + (size_t)cur.pn * tstepB;
    PG8_STAGE(PG8_SB(0, 0), cB, voffB); PG8_STAGE(PG8_SA(0, 0), cA, voffA); PG8_STAGE(PG8_SB(0, 1), cB + hstepB, voffB); PG8_STAGE(PG8_SA(0, 1), cA + hstepA, voffA);
    if (wr == 1) PG8_BAR;
    PG8_WAIT_V(4); PG8_BAR;
    PG8_STAGE(PG8_SB(1, 0), cB + kstep, voffB); PG8_STAGE(PG8_SA(1, 0), cA + kstep, voffA); PG8_STAGE(PG8_SB(1, 1), cB + hstepB + kstep, voffB);
    PG8_WAIT_V(6); PG8_BAR;
    for (;;) {
        const bool has_next = S.next(ui + 1, nxt);
        const char* nA = has_next ? (const char*)g.A + (size_t)nxt.pm * tstepA : cA; const char* nB = has_next ? (const char*)g.Bt + (size_t)nxt.pn * tstepB : cB;
        for (int t = 0; t < nt; t += 2) {
            const bool last = (t == nt - 2);
            const char* a1 = cA + (size_t)(t + 1) * kstep;
            const char* a2 = last ? nA : cA + (size_t)(t + 2) * kstep; const char* b2 = last ? nB : cB + (size_t)(t + 2) * kstep;
            const char* a3 = a2 + kstep; const char* b3 = b2 + kstep;
            PG8_LDB(B0, 0, 0); PG8_SCHED; PG8_LDA(At, 0, 0); PG8_STAGE(PG8_SA(1, 1), a1 + hstepA, voffA);
            PG8_WAIT_L(8); PG8_BAR; PG8_WAIT_L(0); PG8_MMA(0, 0, At, B0); PG8_BAR; PG8_SCHED;
            PG8_LDB(B1, 0, 1); PG8_STAGE(PG8_SB(0, 0), b2, voffB);
            PG8_BAR; PG8_WAIT_L(0); PG8_MMA(0, 1, At, B1); PG8_BAR;
            PG8_LDA(At, 0, 1); PG8_STAGE(PG8_SA(0, 0), a2, voffA);
            PG8_BAR; PG8_WAIT_L(0); PG8_MMA(1, 0, At, B0); PG8_BAR; PG8_SCHED;
            PG8_STAGE(PG8_SB(0, 1), b2 + hstepB, voffB);
            PG8_WAIT_V(6); PG8_BAR; PG8_MMA(1, 1, At, B1); PG8_BAR;
            PG8_LDB(B0, 1, 0); PG8_SCHED; PG8_LDA(At, 1, 0); PG8_STAGE(PG8_SA(0, 1), a2 + hstepA, voffA);
            PG8_WAIT_L(8); PG8_BAR; PG8_WAIT_L(0); PG8_MMA(0, 0, At, B0); PG8_BAR; PG8_SCHED;
            PG8_LDB(B1, 1, 1); PG8_STAGE(PG8_SB(1, 0), b3, voffB);
            PG8_BAR; PG8_WAIT_L(0); PG8_MMA(0, 1, At, B1); PG8_BAR;
            PG8_LDA(At, 1, 1); PG8_STAGE(PG8_SA(1, 0), a3, voffA);
            PG8_BAR; PG8_WAIT_L(0); PG8_MMA(1, 0, At, B0); PG8_BAR; PG8_SCHED;
            PG8_STAGE(PG8_SB(1, 1), b3 + hstepB, voffB);
            PG8_WAIT_V(6); PG8_BAR; PG8_MMA(1, 1, At, B1); PG8_BAR;
        }
        { int fr2 = fr, fq2 = fq, wr2 = wr, wc2 = wc; asm volatile("" : "+v"(fr2), "+v"(fq2), "+s"(wr2), "+s"(wc2));
          E(acc, cur, wr2, wc2, fr2, fq2); }
        if (!has_next) break;
#pragma unroll
        for (int a = 0; a < 2; ++a)
#pragma unroll
            for (int b = 0; b < 2; ++b)
#pragma unroll
                for (int m = 0; m < 4; ++m)
#pragma unroll
                    for (int n = 0; n < 2; ++n) acc[a][b][m][n] = (f32x4){0.f, 0.f, 0.f, 0.f};
        cur = nxt; cA = nA; cB = nB; ++ui;
    }
    PG8_WAIT_V(0);
    if (wr == 0) PG8_BAR;
    PG8_BAR;
#undef PG8_SA
#undef PG8_SB
#undef PG8_STAGE
#undef PG8_LDA
#undef PG8_LDB
#undef PG8_MMA
#undef PG8_WAIT_V
#undef PG8_WAIT_L
#undef PG8_BAR
#undef PG8_SCHED
}
}
using pg8::Unit;
typedef f32x4 AccT[2][2][4][2];

struct EpiFfnUp {
    static constexpr bool PERM = true;
    unsigned char* ws; int last_pm; float rsc[8];
    __device__ __forceinline__ void operator()(const AccT& acc, const Unit& u, int wr, int wc, int fr, int fq) {
        bf16_t* act = (bf16_t*)(ws + T_ACT); const float* ssx = (const float*)(ws + OFF_SSX);
        const int row0 = u.pm * 256 + wr * 64 + fr, col0 = u.pn * 128 + wc * 32 + 8 * fq;
        if (u.pm != last_pm) {
            last_pm = u.pm;
#pragma unroll
            for (int ai = 0; ai < 2; ++ai)
#pragma unroll
                for (int m = 0; m < 4; ++m) rsc[ai * 4 + m] = rstd16q(ssx, row0 + ai * 128 + m * 16, fq);
        }
#pragma unroll
        for (int ai = 0; ai < 2; ++ai)
#pragma unroll
            for (int m = 0; m < 4; ++m) {
                const int row = row0 + ai * 128 + m * 16; const float rs = rsc[ai * 4 + m];
                float o[8];
#pragma unroll
                for (int n = 0; n < 2; ++n)
#pragma unroll
                    for (int j = 0; j < 4; ++j) { const float gv = acc[ai][0][m][n][j] * rs, uv = acc[ai][1][m][n][j] * rs; o[4 * n + j] = gv * __builtin_amdgcn_rcpf(1.f + __expf(-gv)) * uv; }
                u32x4 w; w.x = cvt_pk_bf16(o[0], o[1]); w.y = cvt_pk_bf16(o[2], o[3]); w.z = cvt_pk_bf16(o[4], o[5]); w.w = cvt_pk_bf16(o[6], o[7]);
                *(u32x4*)(act + (size_t)row * FF + col0) = w;
            }
    }
};
struct EpiResid {
    static constexpr bool PERM = true;
    unsigned char* ws; float alpha;
    __device__ __forceinline__ void operator()(const AccT& acc, const Unit& u, int wr, int wc, int fr, int fq) const {
        bf16_t* xb = (bf16_t*)(ws + OFF_XB); float* ssx = (float*)(ws + OFF_SSX);
        const int row0 = u.pm * 256 + wr * 64 + fr, col0 = u.pn * 256 + wc * 32 + 8 * fq;
#pragma unroll
        for (int ai = 0; ai < 2; ++ai) {
            u32x4 xo[4][2];
#pragma unroll
            for (int m = 0; m < 4; ++m)
#pragma unroll
                for (int bj = 0; bj < 2; ++bj) xo[m][bj] = *(const u32x4*)(xb + (size_t)(row0 + ai * 128 + m * 16) * DM + col0 + bj * 128);
#pragma unroll
            for (int m = 0; m < 4; ++m) {
                const int row = row0 + ai * 128 + m * 16; float ss = 0.f;
#pragma unroll
                for (int bj = 0; bj < 2; ++bj) {
                    const size_t idx = (size_t)row * DM + col0 + bj * 128;
                    const u32x4 xw = xo[m][bj];
                    const f32x4 xo0 = {bflo(xw.x), bfhi(xw.x), bflo(xw.y), bfhi(xw.y)}, xo1 = {bflo(xw.z), bfhi(xw.z), bflo(xw.w), bfhi(xw.w)};
                    const f32x4 x0 = xo0 + acc[ai][bj][m][0] * alpha, x1 = xo1 + acc[ai][bj][m][1] * alpha;
                    u32x4 w; w.x = cvt_pk_bf16(x0[0], x0[1]); w.y = cvt_pk_bf16(x0[2], x0[3]); w.z = cvt_pk_bf16(x1[0], x1[1]); w.w = cvt_pk_bf16(x1[2], x1[3]); *(u32x4*)(xb + idx) = w;
                    ss += x0[0] * x0[0] + x0[1] * x0[1] + x0[2] * x0[2] + x0[3] * x0[3] + x1[0] * x1[0] + x1[1] * x1[1] + x1[2] * x1[2] + x1[3] * x1[3];
                }
                ss = quad_sum(ss);
                if (fq == 0) ssx[(size_t)row * 16 + u.pn * 4 + wc] = ss;
            }
        }
    }
};
struct EpiWin {
    static constexpr bool PERM = false;
    unsigned char* ws;
    __device__ __forceinline__ void operator()(const AccT& acc, const Unit& u, int wr, int wc, int fr, int fq) const {
        const float* ssx = (const float*)(ws + OFF_SSX); bf16_t* hyt = (bf16_t*)(ws + T_HYT); bf16_t* cqb = (bf16_t*)(ws + T_CQB); bf16_t* ckvb = (bf16_t*)(ws + T_CKVB);
        float* sscq = (float*)(ws + T_SSCQ); float* ssckv = (float*)(ws + T_SSCKV); bf16_t* kr = (bf16_t*)(ws + T_KR); bf16_t* gin = (bf16_t*)(ws + T_GIN); float* gg = (float*)(ws + T_GG); const float* rope = (const float*)(ws + OFF_ROPE);
        const int row0 = u.pm * 256 + wr * 64 + fr, pn = u.pn;
        if (pn < 3) {
#pragma unroll
            for (int ai = 0; ai < 2; ++ai)
#pragma unroll
                for (int m = 0; m < 4; ++m) {
                    const int row = row0 + ai * 128 + m * 16; const float rs = rstd16q(ssx, row, fq);
#pragma unroll
                    for (int bj = 0; bj < 2; ++bj)
#pragma unroll
                        for (int n = 0; n < 2; ++n)
#pragma unroll
                            for (int j = 0; j < 4; ++j) { const int col = pn * 256 + bj * 128 + wc * 32 + n * 16 + 4 * fq + j; hyt[(size_t)col * NTOK + row] = f2bf(acc[ai][bj][m][n][j] * rs); }
                }
        } else if (pn == 3 || pn == 4) {
            bf16_t* dst = pn == 3 ? cqb : ckvb; float* sdst = pn == 3 ? sscq : ssckv;
#pragma unroll
            for (int ai = 0; ai < 2; ++ai)
#pragma unroll
                for (int m = 0; m < 4; ++m) {
                    const int row = row0 + ai * 128 + m * 16; const float rs = rstd16q(ssx, row, fq);
                    float ss = 0.f;
#pragma unroll
                    for (int bj = 0; bj < 2; ++bj)
#pragma unroll
                        for (int n = 0; n < 2; ++n) {
                            const f32x4 v = acc[ai][bj][m][n] * rs; const float q = v[0] * v[0] + v[1] * v[1] + v[2] * v[2] + v[3] * v[3];
                            if (bj == 0 || pn == 3) ss += q;
                            u32x2 w; w.x = cvt_pk_bf16(v[0], v[1]); w.y = cvt_pk_bf16(v[2], v[3]);
                            *(u32x2*)(dst + (size_t)row * 256 + bj * 128 + wc * 32 + n * 16 + 4 * fq) = w;
                        }
                    ss = quad_sum(ss);
                    if (fq == 0) sdst[(size_t)row * 4 + wc] = ss;
                    if (pn == 4) {
                        if (wc < 2) {
                            const int s0 = 16 * wc + 4 * fq; const float* rp = rope + (size_t)(row & (SEQ - 1)) * 64 + s0;
                            const f32x4 cs = *(const f32x4*)rp, sn = *(const f32x4*)(rp + 32);
                            const f32x4 a = acc[ai][1][m][0] * rs, b = acc[ai][1][m][1] * rs;
                            const f32x4 oa = a * cs - b * sn, ob = a * sn + b * cs;
                            u32x2 w; w.x = cvt_pk_bf16(oa[0], oa[1]); w.y = cvt_pk_bf16(oa[2], oa[3]); *(u32x2*)(kr + (size_t)row * 64 + s0) = w;
                            w.x = cvt_pk_bf16(ob[0], ob[1]); w.y = cvt_pk_bf16(ob[2], ob[3]); *(u32x2*)(kr + (size_t)row * 64 + s0 + 32) = w;
                        } else {
#pragma unroll
                            for (int n = 0; n < 2; ++n) {
                                const f32x4 v = acc[ai][1][m][n] * rs; u32x2 w; w.x = cvt_pk_bf16(v[0], v[1]); w.y = cvt_pk_bf16(v[2], v[3]);
                                *(u32x2*)(gin + (size_t)row * 832 + (1152 + wc * 32 + n * 16 + 4 * fq - 1216)) = w;
                            }
                        }
                    }
                }
        } else {
#pragma unroll
            for (int ai = 0; ai < 2; ++ai)
#pragma unroll
                for (int m = 0; m < 4; ++m) {
                    const int row = row0 + ai * 128 + m * 16; const float rs = rstd16q(ssx, row, fq);
#pragma unroll
                    for (int bj = 0; bj < 2; ++bj)
#pragma unroll
                        for (int n = 0; n < 2; ++n) {
                            const f32x4 v = acc[ai][bj][m][n] * rs; const int col = pn * 256 + bj * 128 + wc * 32 + n * 16 + 4 * fq;
                            if (pn == 6 && bj == 1 && wc == 2) *(f32x4*)(gg + (size_t)row * 32 + n * 16 + 4 * fq) = v;
                            u32x2 w; w.x = cvt_pk_bf16(v[0], v[1]); w.y = cvt_pk_bf16(v[2], v[3]);
                            *(u32x2*)(gin + (size_t)row * 832 + (col - 1216)) = w;
                        }
                }
        }
    }
};
struct EpiUq {
    static constexpr bool PERM = false;
    unsigned char* ws;
    __device__ __forceinline__ void operator()(const AccT& acc, const Unit& u, int wr, int wc, int fr, int fq) const {
        const float* sscq = (const float*)(ws + T_SSCQ); bf16_t* qn = (bf16_t*)(ws + T_QN); bf16_t* qr = (bf16_t*)(ws + T_QR); const float* rope = (const float*)(ws + OFF_ROPE);
        const int row0 = u.pm * 256 + wr * 64 + fr, pn = u.pn;
        if (pn < 2) {
#pragma unroll
            for (int ai = 0; ai < 2; ++ai)
#pragma unroll
                for (int m = 0; m < 4; ++m) {
                    const int row = row0 + ai * 128 + m * 16; const float rs = rstd4(sscq, row, 1.0f / 256.0f);
                    const int b = row >> 13, s = row & (SEQ - 1);
#pragma unroll
                    for (int bj = 0; bj < 2; ++bj) { const int h = 2 * pn + bj; bf16_t* rp = qn + ((size_t)(b * 4 + h) * SEQ + s) * 128 + wc * 32 + 4 * fq;
#pragma unroll
                        for (int n = 0; n < 2; ++n) { const f32x4 v = acc[ai][bj][m][n] * rs; u32x2 w; w.x = cvt_pk_bf16(v[0], v[1]); w.y = cvt_pk_bf16(v[2], v[3]); *(u32x2*)(rp + n * 16) = w; } }
                }
        } else {
            const int s0 = 16 * (wc & 1) + 4 * fq;
#pragma unroll
            for (int ai = 0; ai < 2; ++ai)
#pragma unroll
                for (int m = 0; m < 4; ++m) {
                    const int row = row0 + ai * 128 + m * 16; const float rs = rstd4(sscq, row, 1.0f / 256.0f);
                    const int b = row >> 13, s = row & (SEQ - 1);
                    const float* rt = rope + (size_t)s * 64 + s0; const f32x4 cs = *(const f32x4*)rt, sn = *(const f32x4*)(rt + 32);
#pragma unroll
                    for (int bj = 0; bj < 2; ++bj) { const int h = 2 * bj + (wc >> 1); bf16_t* rp = qr + ((size_t)(b * 4 + h) * SEQ + s) * 64 + s0;
                        const f32x4 a = acc[ai][bj][m][0] * rs, bb = acc[ai][bj][m][1] * rs;
                        const f32x4 oa = a * cs - bb * sn, ob = a * sn + bb * cs;
                        u32x2 w; w.x = cvt_pk_bf16(oa[0], oa[1]); w.y = cvt_pk_bf16(oa[2], oa[3]); *(u32x2*)rp = w;
                        w.x = cvt_pk_bf16(ob[0], ob[1]); w.y = cvt_pk_bf16(ob[2], ob[3]); *(u32x2*)(rp + 32) = w; }
                }
        }
    }
};
struct EpiUkv {
    static constexpr bool PERM = false;
    unsigned char* ws;
    __device__ __forceinline__ void operator()(const AccT& acc, const Unit& u, int wr, int wc, int fr, int fq) const {
        const float* ssckv = (const float*)(ws + T_SSCKV); bf16_t* kn = (bf16_t*)(ws + T_KN); bf16_t* vv = (bf16_t*)(ws + T_V);
        const int row0 = u.pm * 256 + wr * 64 + fr, h = u.pn;
#pragma unroll
        for (int ai = 0; ai < 2; ++ai)
#pragma unroll
            for (int m = 0; m < 4; ++m) {
                const int row = row0 + ai * 128 + m * 16; const float rs = rstd4(ssckv, row, 1.0f / 128.0f);
                const int b = row >> 13, s = row & (SEQ - 1); const size_t base = ((size_t)(b * 4 + h) * SEQ + s) * 128 + wc * 32 + 4 * fq;
#pragma unroll
                for (int bj = 0; bj < 2; ++bj) { bf16_t* rp = (bj == 0 ? kn : vv) + base;
#pragma unroll
                    for (int n = 0; n < 2; ++n) { const f32x4 v = acc[ai][bj][m][n] * rs; u32x2 w; w.x = cvt_pk_bf16(v[0], v[1]); w.y = cvt_pk_bf16(v[2], v[3]); *(u32x2*)(rp + n * 16) = w; } }
            }
    }
};

__device__ __forceinline__ int map_col(int type, int nd, int& which) {
    which = 0;
    if (type == 1) { const int t = nd >> 8, r = nd & 255; which = r >> 7; return t * 128 + (r & 127); }
    if (type == 2) { if (nd >= 2016) return -1; if (nd >= 1152 && nd < 1216) { const int P = nd - 1152, w = P >> 5, n = (P >> 4) & 1, i = P & 15; return 1152 + 16 * w + i + 32 * n; } return nd; }
    if (type == 3) { if (nd < 512) { const int h = nd >> 7, d = nd & 127; return h * 192 + d; } const int Pp = nd - 512, h = Pp >> 6, P = Pp & 63; const int s = 16 * (P >> 5) + (P & 15) + 32 * ((P >> 4) & 1); return h * 192 + 128 + s; }
    return nd;
}
struct PrepJob { const float* src; const float* src2; const float* gain; bf16_t* dst; int Ks, Kd, Nsrc, Nd, type; };
__device__ __forceinline__ PrepJob prep_job(KP p, unsigned char* ws, int j) {
    const int l = j >> 3;
    switch (j & 7) {
        case 0: return PrepJob{p->in[2] + (size_t)l * DM * FF, p->in[3] + (size_t)l * DM * FF, p->in[1] + l * DM, (bf16_t*)(ws + OFF_WUP + (l * 2 + 0) * SZ_WUP), 1024, 1024, FF, 5632, 1};
        case 1: return PrepJob{p->in[30] + (size_t)l * DM * FF, p->in[31] + (size_t)l * DM * FF, p->in[29] + l * DM, (bf16_t*)(ws + OFF_WUP + (l * 2 + 1) * SZ_WUP), 1024, 1024, FF, 5632, 1};
        case 2: return PrepJob{p->in[4] + (size_t)l * FF * DM, nullptr, nullptr, (bf16_t*)(ws + OFF_WDN + (l * 2 + 0) * SZ_WDN), FF, FF, DM, DM, 0};
        case 3: return PrepJob{p->in[32] + (size_t)l * FF * DM, nullptr, nullptr, (bf16_t*)(ws + OFF_WDN + (l * 2 + 1) * SZ_WDN), FF, FF, DM, DM, 0};
        case 4: return PrepJob{p->in[6] + (size_t)l * DM * 2016, nullptr, p->in[5] + l * DM, (bf16_t*)(ws + OFF_WIN + l * SZ_WIN), 1024, 1024, 2016, 2048, 2};
        case 5: return PrepJob{p->in[28] + (size_t)l * DM * DM, nullptr, nullptr, (bf16_t*)(ws + OFF_WOUT + l * SZ_WOUT), 1024, 1024, 1024, 1024, 0};
        case 6: return PrepJob{p->in[19] + (size_t)l * 256 * 768, nullptr, p->in[18] + l * 256, (bf16_t*)(ws + OFF_WUQ + l * SZ_WUQ), 256, 256, 768, 768, 3};
        default: return PrepJob{p->in[21] + (size_t)l * 128 * 1024, nullptr, p->in[20] + l * 128, (bf16_t*)(ws + OFF_WUKV + l * SZ_WUKV), 128, 256, 1024, 1024, 0};
    }
}
__device__ __forceinline__ int prep_job_tiles(int j) { const int k = j & 7; return k < 2 ? 352 : k < 4 ? 176 : k == 4 ? 128 : k == 5 ? 64 : k == 6 ? 12 : 16; }
__device__ __forceinline__ void phase_prep(KP p, float* lds) {
    unsigned char* ws = opaque_ptr(p->ws); const int tid = opaque_tid(), wid = tid >> 6, lane = tid & 63;
    { float* tile = lds; constexpr int TOTAL = 2 * (352 * 2 + 176 * 2 + 128 + 64 + 12 + 16);
      float v[32]; bf16_t* dstp = nullptr; int Kd_c = 0, nd0_c = 0, k0_c = 0;
#define PREP_ISSUE(TT) do { int j_ = 0, t_ = (TT); \
          while (t_ >= prep_job_tiles(j_)) { t_ -= prep_job_tiles(j_); ++j_; } \
          const PrepJob J = prep_job(p, ws, j_); \
          const int ntk_ = J.Kd / 256, nd0_ = (t_ / ntk_) * 64, k0_ = (t_ % ntk_) * 256; \
          const int nn_ = tid & 63, kk_ = tid >> 6; int which_; const int ns_ = map_col(J.type, nd0_ + nn_, which_); const float* sp_ = which_ ? J.src2 : J.src; \
          _Pragma("unroll") for (int sub = 0; sub < 4; ++sub) _Pragma("unroll") for (int r = 0; r < 8; ++r) { const int k_ = k0_ + sub * 64 + kk_ + 8 * r; float x_ = 0.f; \
              if (ns_ >= 0 && k_ < J.Ks) { x_ = sp_[(size_t)k_ * J.Nsrc + ns_]; if (J.gain) x_ *= J.gain[k_]; } v[sub * 8 + r] = x_; } \
          dstp = J.dst; Kd_c = J.Kd; nd0_c = nd0_; k0_c = k0_; } while (0)
      int tt = opaque_bid();
      PREP_ISSUE(tt < TOTAL ? tt : TOTAL - 1);
      for (; tt < TOTAL; tt += gridDim.x) {
          { const int nn = tid & 63, kk = tid >> 6;
#pragma unroll
            for (int sub = 0; sub < 4; ++sub)
#pragma unroll
                for (int r = 0; r < 8; ++r) tile[sub * (64 * 65) + nn * 65 + kk + 8 * r] = v[sub * 8 + r]; }
          bf16_t* dcur = dstp; const int Kd = Kd_c, nd0 = nd0_c, k0 = k0_c;
          PREP_ISSUE(tt + (int)gridDim.x < TOTAL ? tt + (int)gridDim.x : TOTAL - 1);
          __syncthreads();
          { const int row = tid >> 3, kc = (tid & 7) * 8;
#pragma unroll
            for (int sub = 0; sub < 4; ++sub) { const float* tp = tile + sub * (64 * 65) + row * 65 + kc;
              u32x4 w; w.x = cvt_pk_bf16(tp[0], tp[1]); w.y = cvt_pk_bf16(tp[2], tp[3]); w.z = cvt_pk_bf16(tp[4], tp[5]); w.w = cvt_pk_bf16(tp[6], tp[7]);
              *(u32x4*)(dcur + (size_t)(nd0 + row) * Kd + k0 + sub * 64 + kc) = w; } }
          __syncthreads();
      } }
    { const float* x = p->in[0]; bf16_t* xb = (bf16_t*)(ws + OFF_XB); float* ssx = (float*)(ws + OFF_SSX);
      for (int rb = (opaque_bid() * 8 + wid) * 4; rb < NTOK; rb += gridDim.x * 32) {
          f32x4 v[4][4];
#pragma unroll
          for (int q = 0; q < 4; ++q)
#pragma unroll
              for (int i = 0; i < 4; ++i) v[q][i] = *(const f32x4*)(x + (size_t)(rb + q) * DM + lane * 16 + 4 * i);
#pragma unroll
          for (int q = 0; q < 4; ++q) { const int row = rb + q; float ss = 0.f;
#pragma unroll
              for (int i = 0; i < 4; ++i) ss += v[q][i][0] * v[q][i][0] + v[q][i][1] * v[q][i][1] + v[q][i][2] * v[q][i][2] + v[q][i][3] * v[q][i][3];
              u32x4 w0, w1; w0.x = cvt_pk_bf16(v[q][0][0], v[q][0][1]); w0.y = cvt_pk_bf16(v[q][0][2], v[q][0][3]); w0.z = cvt_pk_bf16(v[q][1][0], v[q][1][1]); w0.w = cvt_pk_bf16(v[q][1][2], v[q][1][3]);
              w1.x = cvt_pk_bf16(v[q][2][0], v[q][2][1]); w1.y = cvt_pk_bf16(v[q][2][2], v[q][2][3]); w1.z = cvt_pk_bf16(v[q][3][0], v[q][3][1]); w1.w = cvt_pk_bf16(v[q][3][2], v[q][3][3]);
              *(u32x4*)(xb + (size_t)row * DM + lane * 16) = w0; *(u32x4*)(xb + (size_t)row * DM + lane * 16 + 8) = w1;
              ss += __shfl_xor(ss, 1); ss += __shfl_xor(ss, 2);
              if ((lane & 3) == 0) ssx[(size_t)row * 16 + (lane >> 2)] = ss; }
      } }
    { float* rt = (float*)(ws + OFF_ROPE);
      for (int i = opaque_bid() * NTHR + tid; i < 8192 * 32; i += gridDim.x * NTHR) {
          const int pos = i >> 5, sx = i & 31; const float inv = __builtin_amdgcn_exp2f(-(float)sx * (13.287712379549449f / 32.0f));
          float rev = (float)pos * inv * 0.15915494309189535f; rev -= floorf(rev);
          rt[pos * 64 + sx] = cos_rev(rev); rt[pos * 64 + 32 + sx] = sin_rev(rev);
      } }
    { float* h2t = (float*)(ws + OFF_H2T); float* zs = lds; float* h1s = lds + 8 * 40;
      const int pp = tid >> 6, j = tid & 63;
      for (int l = 0; l < 2; ++l) {
          const float* w1 = p->in[9] + l * 33 * 64; const float* w2 = p->in[12] + l * 64 * 64;
          float w1c[33], w2c[64];
#pragma unroll
          for (int i = 0; i < 33; ++i) w1c[i] = w1[i * 64 + j];
#pragma unroll
          for (int i = 0; i < 64; ++i) w2c[i] = w2[i * 64 + j];
          const float b1 = p->in[10][l * 64 + j], f1 = p->in[11][l * 64 + j], b2 = p->in[13][l * 64 + j], f2 = p->in[14][l * 64 + j];
          for (int it = opaque_bid(); it < 1024; it += gridDim.x) {
              const int m0 = it * 8;
              __syncthreads();
              if (j < 33) { const int m = m0 + pp; float z;
                  if (j == 0) z = (float)m * (1.0f / 8191.0f);
                  else { const int bi = (j - 1) & 15; const float band = 1e-4f + (float)bi * ((15.0f - 1e-4f) / 15.0f); float rev = (float)m * band * (1.0f / 8192.0f); rev -= floorf(rev);
                         z = (j <= 16) ? cos_rev(rev) : -sin_rev(rev); }
                  zs[pp * 40 + j] = z; }
              __syncthreads();
              float a = b1;
#pragma unroll
              for (int i = 0; i < 33; ++i) a += zs[pp * 40 + i] * w1c[i];
              h1s[pp * 64 + j] = fast_sin(f1 * a);
              __syncthreads();
              float c = b2;
#pragma unroll
              for (int i = 0; i < 64; ++i) c += h1s[pp * 64 + i] * w2c[i];
              h2t[((size_t)l * 64 + j) * 8192 + m0 + pp] = fast_sin(f2 * c);
          }
      } }
}

namespace att {
constexpr float SCALE = 0.07216878364870322f;
constexpr float THR = 8.f;
constexpr int SHM_V = 64 * 128 * 2, SHM_K = 64 * 128 * 2, SHM_KR = 64 * 64 * 2;
constexpr int OFF_K = 2 * SHM_V, OFF_KR = OFF_K + 2 * SHM_K, OFF_QR = OFF_KR + 2 * SHM_KR, OFF_WS = OFF_QR + 8 * 8192, SHM_TOTAL = OFF_WS + 8 * 64 * 4;
static_assert(SHM_TOTAL <= LDS_BYTES, "attention LDS");
#define KSWZ(row, colB) ((row) * 256 + ((colB) ^ (((row) & 7) << 4)))
#define KRSWZ(row, chunk) ((row) * 128 + ((((chunk) ^ (((row) >> 1) & 7))) << 4))
#define SBAR() __builtin_amdgcn_sched_barrier(0)
__device__ __forceinline__ int crow(int r, int hi) { return (r & 3) + 8 * (r >> 2) + 4 * hi; }
__device__ __forceinline__ void partialSM(f32x16& p0, f32x16& p1, float& m_reg, float& mn, float& alpha) {
    constexpr float C = SCALE * 1.4426950408889634f;
    float pmax = p0[0];
#pragma unroll
    for (int r = 1; r < 16; ++r) pmax = fmaxf(pmax, p0[r]);
#pragma unroll
    for (int r = 0; r < 16; ++r) pmax = fmaxf(pmax, p1[r]);
    { auto rr = __builtin_amdgcn_permlane32_swap(__float_as_uint(pmax), __float_as_uint(pmax), false, false); pmax = fmaxf(__uint_as_float(rr[0]), __uint_as_float(rr[1])); }
    if (__builtin_expect(__all(pmax - m_reg <= THR / SCALE), 1)) { mn = m_reg; alpha = 1.f; }
    else { mn = fmaxf(m_reg, pmax); alpha = __builtin_amdgcn_exp2f((m_reg - mn) * C); m_reg = mn; }
    const float mnC = -mn * C;
#pragma unroll
    for (int r = 0; r < 16; ++r) p0[r] = fmaf(p0[r], C, mnC);
#pragma unroll
    for (int r = 0; r < 16; ++r) p1[r] = fmaf(p1[r], C, mnC);
#pragma unroll
    for (int r = 0; r < 16; ++r) p0[r] = __builtin_amdgcn_exp2f(p0[r]);
}
__device__ __forceinline__ void finishSM(f32x16& p0, f32x16& p1, float alpha, float& l_reg, bf16x8& pa0, bf16x8& pa1, bf16x8& pa2, bf16x8& pa3) {
#pragma unroll
    for (int r = 0; r < 16; ++r) p1[r] = __builtin_amdgcn_exp2f(p1[r]);
    float ps = 0;
#pragma unroll
    for (int r = 0; r < 16; ++r) ps += p0[r];
#pragma unroll
    for (int r = 0; r < 16; ++r) ps += p1[r];
    { auto rr = __builtin_amdgcn_permlane32_swap(__float_as_uint(ps), __float_as_uint(ps), false, false); ps = __uint_as_float(rr[0]) + __uint_as_float(rr[1]); }
    l_reg = l_reg * alpha + ps;
#define PK4(P, BASE, OUT) do { unsigned a0 = cvt_pk_bf16(P[BASE + 0], P[BASE + 1]), a1 = cvt_pk_bf16(P[BASE + 2], P[BASE + 3]);   \
    unsigned b0 = cvt_pk_bf16(P[BASE + 4], P[BASE + 5]), b1 = cvt_pk_bf16(P[BASE + 6], P[BASE + 7]);                              \
    auto r0 = __builtin_amdgcn_permlane32_swap(a0, b0, false, false); auto r1 = __builtin_amdgcn_permlane32_swap(a1, b1, false, false); \
    u32x4 w = {r0[0], r1[0], r0[1], r1[1]}; OUT = *reinterpret_cast<bf16x8*>(&w); } while (0)
    PK4(p0, 0, pa0); PK4(p0, 8, pa1); PK4(p1, 0, pa2); PK4(p1, 8, pa3);
#undef PK4
}
__device__ __forceinline__ void qkt(f32x16& p0, f32x16& p1, const char* Ks, const char* Krs, const bf16x8* qr, const char* qrl, int r32, int hi) {
    p0 = f32x16{}; p1 = f32x16{};
#pragma unroll
    for (int d0 = 0; d0 < 8; ++d0) { const int cb = (d0 * 16 + hi * 8) * 2;
        const bf16x8 b0 = *reinterpret_cast<const bf16x8*>(Ks + KSWZ(r32, cb));
        const bf16x8 b1 = *reinterpret_cast<const bf16x8*>(Ks + KSWZ(32 + r32, cb));
        const bf16x8 q = d0 < 4 ? qr[d0 & 3] : *reinterpret_cast<const bf16x8*>(qrl + d0 * 1024);
        p0 = __builtin_amdgcn_mfma_f32_32x32x16_bf16(b0, q, p0, 0, 0, 0);
        p1 = __builtin_amdgcn_mfma_f32_32x32x16_bf16(b1, q, p1, 0, 0, 0); }
#pragma unroll
    for (int d0 = 0; d0 < 4; ++d0) { const int ch = d0 * 2 + hi;
        const bf16x8 b0 = *reinterpret_cast<const bf16x8*>(Krs + KRSWZ(r32, ch));
        const bf16x8 b1 = *reinterpret_cast<const bf16x8*>(Krs + KRSWZ(32 + r32, ch));
        const bf16x8 q = *reinterpret_cast<const bf16x8*>(qrl + d0 * 1024);
        p0 = __builtin_amdgcn_mfma_f32_32x32x16_bf16(b0, q, p0, 0, 0, 0);
        p1 = __builtin_amdgcn_mfma_f32_32x32x16_bf16(b1, q, p1, 0, 0, 0); }
}
__device__ __forceinline__ int v_st(int k, int c) { const int kk = (k & ~0xC) | ((k & 4) << 1) | ((k & 8) >> 1); return ((kk >> 3) * 4 + (c >> 5)) * 512 + ((kk & 7) * 32 + (c & 31)) * 2; }
__device__ __forceinline__ int v_rd_base(int lane) { return ((lane & 3) << 3) | (((lane >> 2) & 3) << 6) | (((lane >> 4) & 1) << 5) | (((lane >> 5) & 1) << 8); }
constexpr int v_rd_off(int d0, int ks, int half) { return d0 * 512 + ks * 4096 + half * 2048; }
template <int OFF> __device__ __forceinline__ s16x4 tr_read(int vb) { s16x4 r; asm volatile("ds_read_b64_tr_b16 %0, %1 offset:%2" : "=&v"(r) : "v"(vb), "i"(OFF) : "memory"); return r; }
template <int D0> __device__ __forceinline__ void pv_one(f32x16& od, int vb, bf16x8 pa0, bf16x8 pa1, bf16x8 pa2, bf16x8 pa3) {
    const s16x4 l0 = tr_read<v_rd_off(D0, 0, 0)>(vb), h0 = tr_read<v_rd_off(D0, 0, 1)>(vb), l1 = tr_read<v_rd_off(D0, 1, 0)>(vb), h1 = tr_read<v_rd_off(D0, 1, 1)>(vb);
    const s16x4 l2 = tr_read<v_rd_off(D0, 2, 0)>(vb), h2 = tr_read<v_rd_off(D0, 2, 1)>(vb), l3 = tr_read<v_rd_off(D0, 3, 0)>(vb), h3 = tr_read<v_rd_off(D0, 3, 1)>(vb);
    asm volatile("s_waitcnt lgkmcnt(0)" ::: "memory"); SBAR();
#define PK(L, H) (bf16x8){L[0], L[1], L[2], L[3], H[0], H[1], H[2], H[3]}
    od = __builtin_amdgcn_mfma_f32_32x32x16_bf16(pa0, PK(l0, h0), od, 0, 0, 0);
    od = __builtin_amdgcn_mfma_f32_32x32x16_bf16(pa1, PK(l1, h1), od, 0, 0, 0);
    od = __builtin_amdgcn_mfma_f32_32x32x16_bf16(pa2, PK(l2, h2), od, 0, 0, 0);
    od = __builtin_amdgcn_mfma_f32_32x32x16_bf16(pa3, PK(l3, h3), od, 0, 0, 0);
#undef PK
}
__device__ __forceinline__ void pv_d0(f32x16* o, int vb, bf16x8 pa0, bf16x8 pa1, bf16x8 pa2, bf16x8 pa3) {
    pv_one<0>(o[0], vb, pa0, pa1, pa2, pa3); pv_one<1>(o[1], vb, pa0, pa1, pa2, pa3); pv_one<2>(o[2], vb, pa0, pa1, pa2, pa3); pv_one<3>(o[3], vb, pa0, pa1, pa2, pa3);
}
__device__ __forceinline__ void attn_body(const bf16_t* __restrict__ Qb, const bf16_t* __restrict__ QRb, const bf16_t* __restrict__ Kh, const bf16_t* __restrict__ Krh,
                                          const bf16_t* __restrict__ Vh, bf16_t* __restrict__ Ob, int seq, char* lds) {
    const int tid = opaque_tid(), wid = tid >> 6, lane = tid & 63, r32 = lane & 31, hi = lane >> 5;
    char* V_lds = lds; char* K_lds = lds + OFF_K; char* Kr_lds = lds + OFF_KR; char* qrl = lds + OFF_QR + wid * 8192 + lane * 16;
    float* wsf = (float*)(lds + OFF_WS) + wid * 64; float* li_l = wsf; float* al_l = wsf + 32;
    float m_reg = -1e30f, l_reg = 0; f32x16 o[4] = {}; bf16x8 qr[4];
    __syncthreads();
    { const bf16_t* Qw = Qb + (long)(wid * 32 + r32) * 128 + hi * 8;
#pragma unroll
      for (int d0 = 0; d0 < 4; ++d0) qr[d0] = *reinterpret_cast<const bf16x8*>(Qw + d0 * 16);
#pragma unroll
      for (int d0 = 4; d0 < 8; ++d0) *reinterpret_cast<bf16x8*>(qrl + d0 * 1024) = *reinterpret_cast<const bf16x8*>(Qw + d0 * 16);
      const bf16_t* QRw = QRb + (long)(wid * 32 + r32) * 64 + hi * 8;
#pragma unroll
      for (int d0 = 0; d0 < 4; ++d0) *reinterpret_cast<bf16x8*>(qrl + d0 * 1024) = *reinterpret_cast<const bf16x8*>(QRw + d0 * 16); }
    const int sr = tid >> 4, sc = (tid & 15) * 8, vst0 = v_st(sr, sc), vst1 = v_st(32 + sr, sc);
    const int krr = tid >> 3, krc = tid & 7, krst = KRSWZ(krr, krc);
    const int vb0 = (int)(uintptr_t)V_lds + v_rd_base(lane);
    struct { bf16x8 vs0, vs1, ks0, ks1, kr; } sr_[1];
#define SLOAD(i, k0) do { sr_[i].vs0 = *reinterpret_cast<const bf16x8*>(&Vh[(long)((k0) + sr) * 128 + sc]); sr_[i].vs1 = *reinterpret_cast<const bf16x8*>(&Vh[(long)((k0) + 32 + sr) * 128 + sc]); \
    sr_[i].ks0 = *reinterpret_cast<const bf16x8*>(&Kh[(long)((k0) + sr) * 128 + sc]); sr_[i].ks1 = *reinterpret_cast<const bf16x8*>(&Kh[(long)((k0) + 32 + sr) * 128 + sc]); \
    sr_[i].kr = *reinterpret_cast<const bf16x8*>(&Krh[(long)((k0) + krr) * 64 + krc * 8]); } while (0)
#define SWRITE(b, i) do { *(bf16x8*)(V_lds + (b) * SHM_V + vst0) = sr_[i].vs0; *(bf16x8*)(V_lds + (b) * SHM_V + vst1) = sr_[i].vs1; const int kc = sc * 2; \
    *(bf16x8*)(K_lds + (b) * SHM_K + KSWZ(sr, kc)) = sr_[i].ks0; *(bf16x8*)(K_lds + (b) * SHM_K + KSWZ(32 + sr, kc)) = sr_[i].ks1; \
    *(bf16x8*)(Kr_lds + (b) * SHM_KR + krst) = sr_[i].kr; } while (0)
#define SWAIT() asm volatile("s_waitcnt vmcnt(0)" ::: "memory")
#define RESC(a) do { if (__any((a) < 1.f)) { if (hi == 0) al_l[r32] = (a); asm volatile("s_waitcnt lgkmcnt(0)" ::: "memory"); \
    _Pragma("unroll") for (int d = 0; d < 4; ++d) _Pragma("unroll") for (int r = 0; r < 16; ++r) o[d][r] *= al_l[crow(r, hi)]; } } while (0)
    f32x16 pA0, pA1, pB0, pB1; float mnA, mnB, alA, alB; bf16x8 pa0, pa1, pa2, pa3; const int NT = seq / 64;
    constexpr int SE = 0, SO = 0;
    SLOAD(SE, 0); asm volatile("s_waitcnt vmcnt(0)" ::: "memory"); SWRITE(0, SE); __syncthreads();
    qkt(pA0, pA1, K_lds, Kr_lds, qr, qrl, r32, hi); partialSM(pA0, pA1, m_reg, mnA, alA);
    SLOAD(SO, 64);
    SWAIT(); SWRITE(1, SO); __syncthreads();
    for (int j = 1; j + 1 < NT; j += 2) {
        SBAR(); qkt(pB0, pB1, K_lds + SHM_K, Kr_lds + SHM_KR, qr, qrl, r32, hi);
        finishSM(pA0, pA1, alA, l_reg, pa0, pa1, pa2, pa3); SBAR();
        SLOAD(SO, (j + 1) * 64); SBAR();
        pv_d0(o, vb0, pa0, pa1, pa2, pa3); partialSM(pB0, pB1, m_reg, mnB, alB);
        __syncthreads(); SWAIT(); SWRITE(0, SE);
        RESC(alB); __syncthreads();
        SBAR(); qkt(pA0, pA1, K_lds, Kr_lds, qr, qrl, r32, hi);
        finishSM(pB0, pB1, alB, l_reg, pa0, pa1, pa2, pa3); SBAR();
        SLOAD(SE, (j + 2) * 64); SBAR();
        pv_d0(o, vb0 + SHM_V, pa0, pa1, pa2, pa3); partialSM(pA0, pA1, m_reg, mnA, alA);
        __syncthreads(); SWAIT(); SWRITE(1, SO);
        RESC(alA); __syncthreads();
    }
    SBAR(); qkt(pB0, pB1, K_lds + SHM_K, Kr_lds + SHM_KR, qr, qrl, r32, hi);
    finishSM(pA0, pA1, alA, l_reg, pa0, pa1, pa2, pa3); SBAR();
    pv_d0(o, vb0, pa0, pa1, pa2, pa3); partialSM(pB0, pB1, m_reg, mnB, alB);
    __syncthreads(); RESC(alB);
    finishSM(pB0, pB1, alB, l_reg, pa0, pa1, pa2, pa3); SBAR();
    pv_d0(o, vb0 + SHM_V, pa0, pa1, pa2, pa3);
    if (hi == 0) li_l[r32] = l_reg; asm volatile("s_waitcnt lgkmcnt(0)" ::: "memory");
    float rli[16];
#pragma unroll
    for (int r = 0; r < 16; ++r) rli[r] = __builtin_amdgcn_rcpf(li_l[crow(r, hi)]);
    bf16_t* Ow = Ob + (long)(wid * 32) * 512;
#pragma unroll
    for (int r = 0; r < 16; ++r) { const int orow = crow(r, hi);
#pragma unroll
        for (int d0 = 0; d0 < 4; ++d0) Ow[(long)orow * 512 + d0 * 32 + r32] = f2bf(o[d0][r] * rli[r]); }
#undef SLOAD
#undef SWRITE
#undef SWAIT
#undef RESC
}
}

__device__ __forceinline__ float2 cmul(float2 a, float2 b) { return make_float2(a.x * b.x - a.y * b.y, a.x * b.y + a.y * b.x); }
template <bool LAST = true, bool FIRST = true> __device__ __forceinline__ void fft_dif(float2* d) {
    const int tid = opaque_tid();
    for (int s = FIRST ? 0 : 1; s < 6; ++s) {
        const int lg = 12 - 2 * s, span = 1 << lg; const float rs = 1.0f / (float)(4 << lg);
#pragma unroll 4
        for (int i = 0; i < 8; ++i) {
            const int bf = tid + 512 * i, j = bf & (span - 1), g = bf >> lg, base = ((g << 2) << lg) + j;
            const float2 a0 = d[base], a1 = d[base + span], a2 = d[base + 2 * span], a3 = d[base + 3 * span];
            const float2 b0 = make_float2(a0.x + a2.x, a0.y + a2.y), b1 = make_float2(a0.x - a2.x, a0.y - a2.y), b2 = make_float2(a1.x + a3.x, a1.y + a3.y), b3 = make_float2(a1.x - a3.x, a1.y - a3.y);
            const float2 y0 = make_float2(b0.x + b2.x, b0.y + b2.y), y2 = make_float2(b0.x - b2.x, b0.y - b2.y);
            const float2 y1 = make_float2(b1.x + b3.y, b1.y - b3.x), y3 = make_float2(b1.x - b3.y, b1.y + b3.x);
            const float r = (float)j * rs;
            const float2 w1 = make_float2(cos_rev(r), -sin_rev(r)), w2 = make_float2(cos_rev(2.f * r), -sin_rev(2.f * r)), w3 = make_float2(cos_rev(3.f * r), -sin_rev(3.f * r));
            d[base] = y0; d[base + span] = cmul(y1, w1); d[base + 2 * span] = cmul(y2, w2); d[base + 3 * span] = cmul(y3, w3);
        }
        __syncthreads();
    }
    if (!LAST) return;
#pragma unroll 4
    for (int i = 0; i < 8; ++i) {
        f32x4* q = (f32x4*)(d + 4 * (tid + 512 * i));
        const f32x4 A = q[0], B = q[1];
        const float b0x = A[0] + B[0], b0y = A[1] + B[1], b1x = A[0] - B[0], b1y = A[1] - B[1], b2x = A[2] + B[2], b2y = A[3] + B[3], b3x = A[2] - B[2], b3y = A[3] - B[3];
        q[0] = (f32x4){b0x + b2x, b0y + b2y, b1x + b3y, b1y - b3x};
        q[1] = (f32x4){b0x - b2x, b0y - b2y, b1x - b3y, b1y + b3x};
    }
    __syncthreads();
}
template <bool FIRST = true, bool LASTS = true> __device__ __forceinline__ void fft_dit_inv(float2* d) {
    const int tid = opaque_tid();
    if (FIRST) {
#pragma unroll 4
    for (int i = 0; i < 8; ++i) {
        f32x4* q = (f32x4*)(d + 4 * (tid + 512 * i));
        const f32x4 A = q[0], B = q[1];
        const float c0x = A[0] + B[0], c0y = A[1] + B[1], c1x = A[0] - B[0], c1y = A[1] - B[1], c2x = A[2] + B[2], c2y = A[3] + B[3], c3x = A[2] - B[2], c3y = A[3] - B[3];
        q[0] = (f32x4){c0x + c2x, c0y + c2y, c1x - c3y, c1y + c3x};
        q[1] = (f32x4){c0x - c2x, c0y - c2y, c1x + c3y, c1y - c3x};
    }
    __syncthreads();
    }
    for (int s = 5; s >= (LASTS ? 0 : 1); --s) {
        const int lg = 12 - 2 * s, span = 1 << lg; const float rs = 1.0f / (float)(4 << lg);
#pragma unroll 4
        for (int i = 0; i < 8; ++i) {
            const int bf = tid + 512 * i, j = bf & (span - 1), g = bf >> lg, base = ((g << 2) << lg) + j;
            const float r = (float)j * rs;
            const float2 w1 = make_float2(cos_rev(r), sin_rev(r)), w2 = make_float2(cos_rev(2.f * r), sin_rev(2.f * r)), w3 = make_float2(cos_rev(3.f * r), sin_rev(3.f * r));
            const float2 y0 = d[base], y1 = cmul(d[base + span], w1), y2 = cmul(d[base + 2 * span], w2), y3 = cmul(d[base + 3 * span], w3);
            const float2 c0 = make_float2(y0.x + y2.x, y0.y + y2.y), c1 = make_float2(y0.x - y2.x, y0.y - y2.y), c2 = make_float2(y1.x + y3.x, y1.y + y3.y), c3 = make_float2(y1.x - y3.x, y1.y - y3.y);
            d[base] = make_float2(c0.x + c2.x, c0.y + c2.y); d[base + 2 * span] = make_float2(c0.x - c2.x, c0.y - c2.y);
            d[base + span] = make_float2(c1.x - c3.y, c1.y + c3.x); d[base + 3 * span] = make_float2(c1.x + c3.y, c1.y - c3.x);
        }
        __syncthreads();
    }
}
__device__ __forceinline__ float sconv(const bf16_t* p, int t, float w0, float w1, float w2, float bias) {
    const float a = t > 0 ? bf2f(p[t - 1]) : 0.f, b = bf2f(p[t]), c = t < SEQ - 1 ? bf2f(p[t + 1]) : 0.f;
    return bias + w0 * a + w1 * b + w2 * c;
}
__device__ __forceinline__ float2 sconv2(const bf16_t* p, int m, float w0, float w1, float w2, float bias) {
    const unsigned* pw = (const unsigned*)p;
    const unsigned wm = m > 0 ? pw[m - 1] : 0u, wc = pw[m], wp = m < SEQ / 2 - 1 ? pw[m + 1] : 0u;
    const float a = bfhi(wm), b = bflo(wc), c = bfhi(wc), d = bflo(wp);
    return make_float2(bias + w0 * a + w1 * b + w2 * c, bias + w0 * b + w1 * c + w2 * d);
}
__device__ __forceinline__ int rev4_14(int x) { const unsigned b = __brev((unsigned)x) >> 18; return (int)(((b & 0x1555u) << 1) | ((b >> 1) & 0x1555u)); }
__device__ __forceinline__ void hyena_filter(KP p, int l, int c, float2* data, float2* Kd, float delta) {
    const int tid = opaque_tid(); unsigned char* ws = opaque_ptr(p->ws);
    const float* h2t = (const float*)(ws + OFF_H2T) + (size_t)l * 64 * 8192; const float* w3 = p->in[15] + (size_t)l * 64 * 1024;
    const int m0 = tid * 16;
    f32x4 af0[4], ab0[4], af1[4], ab1[4];
#pragma unroll
    for (int q = 0; q < 4; ++q) { af0[q] = (f32x4){0.f, 0.f, 0.f, 0.f}; ab0[q] = af0[q]; af1[q] = af0[q]; ab1[q] = af0[q]; }
#pragma unroll 2
    for (int j = 0; j < 64; ++j) {
        const float wf0 = w3[j * 1024 + c], wb0 = w3[j * 1024 + 256 + c], wf1 = w3[j * 1024 + 512 + c], wb1 = w3[j * 1024 + 768 + c];
        const f32x4* hp = (const f32x4*)(h2t + j * 8192 + m0);
#pragma unroll
        for (int q = 0; q < 4; ++q) { const f32x4 h = hp[q]; af0[q] += h * wf0; ab0[q] += h * wb0; af1[q] += h * wf1; ab1[q] += h * wb1; }
    }
#pragma unroll
    for (int q = 0; q < 4; ++q)
#pragma unroll
        for (int k = 0; k < 4; ++k) {
            const int m = m0 + q * 4 + k; const float win = __expf(-((float)m * (1.0f / 8191.0f)) * delta);
            data[m] = make_float2(af0[q][k] * win, af1[q][k] * win);
            if (m >= 1) data[16384 - m] = make_float2(ab0[q][k] * win, ab1[q][k] * win);
        }
    if (tid == 0) data[8192] = make_float2(0.f, 0.f);
    __syncthreads();
    fft_dif(data);
#pragma unroll 8
    for (int i = 0; i < 32; ++i) { const int q = tid + 512 * i; const float2 v = data[q]; Kd[q] = make_float2(v.x * (1.0f / 16384.0f), v.y * (1.0f / 16384.0f)); }
    __syncthreads();
}
template <int O> __device__ __forceinline__ void hyena_mid(float2* d, const float2* Z) {
    const int tid = opaque_tid();
#pragma unroll 4
    for (int i = 0; i < 8; ++i) {
        const int q0 = 4 * (tid + 512 * i);
        f32x4* qp = (f32x4*)(d + q0);
        const f32x4 A = qp[0], B = qp[1];
        const f32x4 ZA = *(const f32x4*)(Z + q0), ZB = *(const f32x4*)(Z + q0 + 2);
        float2 z2[4];
#pragma unroll
        for (int e = 0; e < 4; ++e) { const int f = rev4_14(q0 + e); z2[e] = Z[rev4_14((16384 - f) & 16383)]; }
        const float b0x = A[0] + B[0], b0y = A[1] + B[1], b1x = A[0] - B[0], b1y = A[1] - B[1], b2x = A[2] + B[2], b2y = A[3] + B[3], b3x = A[2] - B[2], b3y = A[3] - B[3];
        float2 y[4] = {make_float2(b0x + b2x, b0y + b2y), make_float2(b1x + b3y, b1y - b3x), make_float2(b0x - b2x, b0y - b2y), make_float2(b1x - b3y, b1y + b3x)};
        const float2 z[4] = {make_float2(ZA[0], ZA[1]), make_float2(ZA[2], ZA[3]), make_float2(ZB[0], ZB[1]), make_float2(ZB[2], ZB[3])};
#pragma unroll
        for (int e = 0; e < 4; ++e) {
            const float2 k = O == 0 ? make_float2(0.5f * (z[e].x + z2[e].x), 0.5f * (z[e].y - z2[e].y)) : make_float2(0.5f * (z[e].y + z2[e].y), -0.5f * (z[e].x - z2[e].x));
            y[e] = cmul(y[e], k);
        }
        const float c0x = y[0].x + y[2].x, c0y = y[0].y + y[2].y, c1x = y[0].x - y[2].x, c1y = y[0].y - y[2].y, c2x = y[1].x + y[3].x, c2y = y[1].y + y[3].y, c3x = y[1].x - y[3].x, c3y = y[1].y - y[3].y;
        qp[0] = (f32x4){c0x + c2x, c0y + c2y, c1x - c3y, c1y + c3x};
        qp[1] = (f32x4){c0x - c2x, c0y - c2y, c1x + c3y, c1y - c3x};
    }
    __syncthreads();
}
template <int O> __device__ __forceinline__ void hyena_mul(float2* data, const float2* Z) {
    const int tid = opaque_tid();
#pragma unroll 8
    for (int i = 0; i < 32; ++i) {
        const int q = tid + 512 * i, f = rev4_14(q), q2 = rev4_14((16384 - f) & 16383);
        const float2 z = Z[q], z2 = Z[q2];
        const float2 k = O == 0 ? make_float2(0.5f * (z.x + z2.x), 0.5f * (z.y - z2.y)) : make_float2(0.5f * (z.y + z2.y), -0.5f * (z.x - z2.x));
        data[q] = cmul(data[q], k);
    }
    __syncthreads();
}
__device__ __forceinline__ void dif0_pair(float2* d, int j, f32x4 in0, f32x4 in1) {
    f32x4 o0, o1, o2, o3;
#pragma unroll
    for (int e = 0; e < 2; ++e) {
        const float2 a0 = make_float2(in0[2 * e], in0[2 * e + 1]), a1 = make_float2(in1[2 * e], in1[2 * e + 1]);
        const float r = (float)(j + e) * (1.0f / 16384.0f);
        const float2 w1 = make_float2(cos_rev(r), -sin_rev(r)), w2 = make_float2(cos_rev(2.f * r), -sin_rev(2.f * r)), w3 = make_float2(cos_rev(3.f * r), -sin_rev(3.f * r));
        const float2 y0 = make_float2(a0.x + a1.x, a0.y + a1.y), y2 = cmul(make_float2(a0.x - a1.x, a0.y - a1.y), w2);
        const float2 y1 = cmul(make_float2(a0.x + a1.y, a0.y - a1.x), w1), y3 = cmul(make_float2(a0.x - a1.y, a0.y + a1.x), w3);
        o0[2 * e] = y0.x; o0[2 * e + 1] = y0.y; o1[2 * e] = y1.x; o1[2 * e + 1] = y1.y; o2[2 * e] = y2.x; o2[2 * e + 1] = y2.y; o3[2 * e] = y3.x; o3[2 * e + 1] = y3.y;
    }
    *(f32x4*)(d + j) = o0; *(f32x4*)(d + j + 4096) = o1; *(f32x4*)(d + j + 8192) = o2; *(f32x4*)(d + j + 12288) = o3;
}
__device__ __forceinline__ void dit0_pair(const float2* d, int j, f32x4& out0, f32x4& out1) {
    const f32x4 i0 = *(const f32x4*)(d + j), i1 = *(const f32x4*)(d + j + 4096), i2 = *(const f32x4*)(d + j + 8192), i3 = *(const f32x4*)(d + j + 12288);
#pragma unroll
    for (int e = 0; e < 2; ++e) {
        const float r = (float)(j + e) * (1.0f / 16384.0f);
        const float2 w1 = make_float2(cos_rev(r), sin_rev(r)), w2 = make_float2(cos_rev(2.f * r), sin_rev(2.f * r)), w3 = make_float2(cos_rev(3.f * r), sin_rev(3.f * r));
        const float2 y0 = make_float2(i0[2 * e], i0[2 * e + 1]), y1 = cmul(make_float2(i1[2 * e], i1[2 * e + 1]), w1), y2 = cmul(make_float2(i2[2 * e], i2[2 * e + 1]), w2), y3 = cmul(make_float2(i3[2 * e], i3[2 * e + 1]), w3);
        const float2 c0 = make_float2(y0.x + y2.x, y0.y + y2.y), c1 = make_float2(y0.x - y2.x, y0.y - y2.y), c2 = make_float2(y1.x + y3.x, y1.y + y3.y), c3 = make_float2(y1.x - y3.x, y1.y - y3.y);
        out0[2 * e] = c0.x + c2.x; out0[2 * e + 1] = c0.y + c2.y; out1[2 * e] = c1.x - c3.y; out1[2 * e + 1] = c1.y + c3.x;
    }
}
__device__ __forceinline__ void hyena_item(KP p, int l, int c, float2* data, bool do_store) {
    const int tid = opaque_tid(); unsigned char* ws = opaque_ptr(p->ws);
    bf16_t* hv = (bf16_t*)(ws + T_HYT) + (size_t)c * NTOK; const bf16_t* hx1 = (const bf16_t*)(ws + T_HYT) + (size_t)(256 + c) * NTOK; const bf16_t* hx2 = (const bf16_t*)(ws + T_HYT) + (size_t)(512 + c) * NTOK;
    float2* RA = (float2*)(ws + T_FK) + (size_t)c * 2 * 16384; float2* RB = RA + 16384;
    const float* cw = p->in[7] + l * 3 * 768; const float* cb = p->in[8] + l * 768;
    const float wv0 = cw[c], wv1 = cw[768 + c], wv2 = cw[1536 + c], bv = cb[c];
    const float wa0 = cw[256 + c], wa1 = cw[768 + 256 + c], wa2 = cw[1536 + 256 + c], ba = cb[256 + c];
    const float wb0 = cw[512 + c], wb1 = cw[768 + 512 + c], wb2 = cw[1536 + 512 + c], bb = cb[512 + c];
    const float skip0 = p->in[16][l * 512 + c], skip1 = p->in[16][l * 512 + 256 + c];
    const float mind = -3.0701134573253945f, maxd = -15.350567286626973f;
    const float delta = fabsf(mind + (float)c * ((maxd - mind) / 255.0f));
    __syncthreads();
    hyena_filter(p, l, c, data, RA, delta);
#pragma unroll 1
    for (int pr = 0; pr < 2; ++pr) {
        const int o0 = (2 * pr) * SEQ, o1 = (2 * pr + 1) * SEQ;
        { const int tq = opaque_tid();
#pragma unroll
          for (int i = 0; i < 4; ++i) { const int m = tq + 512 * i;
              const float2 a0 = sconv2(hv + o0, m, wv0, wv1, wv2, bv), a1 = sconv2(hv + o1, m, wv0, wv1, wv2, bv);
              const float2 b0 = sconv2(hv + o0, m + 2048, wv0, wv1, wv2, bv), b1 = sconv2(hv + o1, m + 2048, wv0, wv1, wv2, bv);
              dif0_pair(data, 2 * m, (f32x4){a0.x, a1.x, a0.y, a1.y}, (f32x4){b0.x, b1.x, b0.y, b1.y}); } }
        __syncthreads();
        fft_dif<false, false>(data);
        hyena_mid<0>(data, RA);
        fft_dit_inv<false, false>(data);
        { const int tq = opaque_tid();
#pragma unroll
          for (int i = 0; i < 4; ++i) { const int m = tq + 512 * i; f32x4 cva, cvb; dit0_pair(data, 2 * m, cva, cvb);
              { const float2 v0 = sconv2(hv + o0, m, wv0, wv1, wv2, bv), v1 = sconv2(hv + o1, m, wv0, wv1, wv2, bv);
                const float2 x0 = sconv2(hx1 + o0, m, wa0, wa1, wa2, ba), x1 = sconv2(hx1 + o1, m, wa0, wa1, wa2, ba);
                *(f32x4*)(RB + pr * 8192 + 2 * m) = (f32x4){x0.x * (cva[0] + skip0 * v0.x), x1.x * (cva[1] + skip0 * v1.x), x0.y * (cva[2] + skip0 * v0.y), x1.y * (cva[3] + skip0 * v1.y)}; }
              { const int mb = m + 2048;
                const float2 v0 = sconv2(hv + o0, mb, wv0, wv1, wv2, bv), v1 = sconv2(hv + o1, mb, wv0, wv1, wv2, bv);
                const float2 x0 = sconv2(hx1 + o0, mb, wa0, wa1, wa2, ba), x1 = sconv2(hx1 + o1, mb, wa0, wa1, wa2, ba);
                *(f32x4*)(RB + pr * 8192 + 2 * mb) = (f32x4){x0.x * (cvb[0] + skip0 * v0.x), x1.x * (cvb[1] + skip0 * v1.x), x0.y * (cvb[2] + skip0 * v0.y), x1.y * (cvb[3] + skip0 * v1.y)}; } } }
        __syncthreads();
    }
#pragma unroll 1
    for (int pr = 0; pr < 2; ++pr) {
        const int o0 = (2 * pr) * SEQ, o1 = (2 * pr + 1) * SEQ;
        { const int tq = opaque_tid();
#pragma unroll
          for (int i = 0; i < 4; ++i) { const int m = tq + 512 * i;
              dif0_pair(data, 2 * m, *(const f32x4*)(RB + pr * 8192 + 2 * m), *(const f32x4*)(RB + pr * 8192 + 2 * m + 4096)); } }
        __syncthreads();
        fft_dif<false, false>(data);
        hyena_mid<1>(data, RA);
        fft_dit_inv<false, false>(data);
        { const int tq = opaque_tid();
#pragma unroll
          for (int i = 0; i < 4; ++i) { const int m = tq + 512 * i; f32x4 cva, cvb; dit0_pair(data, 2 * m, cva, cvb);
              { const f32x4 y1 = *(const f32x4*)(RB + pr * 8192 + 2 * m);
                const float2 x0 = sconv2(hx2 + o0, m, wb0, wb1, wb2, bb), x1 = sconv2(hx2 + o1, m, wb0, wb1, wb2, bb);
                if (do_store) { *(unsigned*)(hv + o0 + 2 * m) = cvt_pk_bf16(x0.x * (cva[0] + skip1 * y1[0]), x0.y * (cva[2] + skip1 * y1[2]));
                                *(unsigned*)(hv + o1 + 2 * m) = cvt_pk_bf16(x1.x * (cva[1] + skip1 * y1[1]), x1.y * (cva[3] + skip1 * y1[3])); } }
              { const int mb = m + 2048; const f32x4 y1 = *(const f32x4*)(RB + pr * 8192 + 2 * mb);
                const float2 x0 = sconv2(hx2 + o0, mb, wb0, wb1, wb2, bb), x1 = sconv2(hx2 + o1, mb, wb0, wb1, wb2, bb);
                if (do_store) { *(unsigned*)(hv + o0 + 2 * mb) = cvt_pk_bf16(x0.x * (cvb[0] + skip1 * y1[0]), x0.y * (cvb[2] + skip1 * y1[2]));
                                *(unsigned*)(hv + o1 + 2 * mb) = cvt_pk_bf16(x1.x * (cvb[1] + skip1 * y1[1]), x1.y * (cvb[3] + skip1 * y1[3])); } } } }
        __syncthreads();
    }
}

constexpr int G_QF = 0, G_QB = G_QF + 64 * 33, G_KF = G_QB + 64 * 33, G_KB = G_KF + 32 * 68, G_V = G_KB + 32 * 68, G_A = G_V + 64 * 68, G_S = G_A + 64 * 68, G_T = G_S + 32 * 68,
              G_GF = G_T + 32 * 68, G_GB = G_GF + 64 * 33, G_O = G_GB + 64 * 33, G_O1 = G_O + 64 * 68, G_END = G_O1 + 64 * 68;
static_assert(G_END * 4 <= LDS_BYTES, "gla lds");
template <int CTRL, int ROW_MASK> __device__ __forceinline__ float dpp_add(float v) {
    const int s = __builtin_amdgcn_update_dpp(0, __float_as_int(v), CTRL, ROW_MASK, 0xf, true);
    return v + __int_as_float(s);
}
__device__ __forceinline__ float wave_incl_scan(float v) {
    v = dpp_add<0x111, 0xf>(v); v = dpp_add<0x112, 0xf>(v); v = dpp_add<0x114, 0xf>(v); v = dpp_add<0x118, 0xf>(v);
    v = dpp_add<0x142, 0xa>(v); v = dpp_add<0x143, 0xc>(v);
    return v;
}
struct GlaLoads { f32x4 gx[8]; u32x4 vw; u32x2 qw, kw; };
template <bool NEED_Q> __device__ __forceinline__ GlaLoads gla_issue(KP p, int it) {
    const int tid = opaque_tid(), wid = __builtin_amdgcn_readfirstlane(tid >> 6), lane = tid & 63; unsigned char* ws = opaque_ptr(p->ws);
    const int h = it & 3, n = (it >> 2) & 127, b = it >> 9, row0 = b * SEQ + n * 64;
    const bf16_t* gin = (const bf16_t*)(ws + T_GIN); const float* gg = (const float*)(ws + T_GG);
    GlaLoads g;
    { const f32x4* gr = (const f32x4*)(gg + (size_t)(row0 + lane) * 32);
#pragma unroll
      for (int q = 0; q < 8; ++q) g.gx[q] = gr[q]; }
    g.vw = *(const u32x4*)(gin + (size_t)(row0 + (tid >> 3)) * 832 + 256 + h * 64 + (tid & 7) * 8);
    if (NEED_Q) g.qw = *(const u32x2*)(gin + (size_t)(row0 + lane) * 832 + h * 32 + 4 * wid); else g.qw = (u32x2){0u, 0u};
    g.kw = *(const u32x2*)(gin + (size_t)(row0 + lane) * 832 + 128 + h * 32 + 4 * wid);
    return g;
}
template <bool NEED_Q> __device__ __forceinline__ void gla_prepare(KP p, int l, int h, const GlaLoads& g, float* L) {
    const int tid = opaque_tid(), wid = __builtin_amdgcn_readfirstlane(tid >> 6), lane = tid & 63;
    const float* wf = p->in[23] + l * 16 * 128 + h * 32 + 4 * wid; const float* wb = p->in[25] + l * 16 * 128 + h * 32 + 4 * wid;
    f32x4 af = *(const f32x4*)(p->in[24] + l * 128 + h * 32 + 4 * wid), ab = *(const f32x4*)(p->in[26] + l * 128 + h * 32 + 4 * wid);
#pragma unroll
    for (int r = 0; r < 16; ++r) { const float xf = g.gx[r >> 2][r & 3], xb = g.gx[4 + (r >> 2)][r & 3];
        af += *(const f32x4*)(wf + r * 128) * xf; ab += *(const f32x4*)(wb + r * 128) * xb; }
    float bb[4], cc[4];
#pragma unroll
    for (int k = 0; k < 4; ++k) {
        const float vf = (fminf(af[k], 0.f) - __logf(1.f + __expf(-fabsf(af[k])))) * (1.0f / 16.0f), vb = (fminf(ab[k], 0.f) - __logf(1.f + __expf(-fabsf(ab[k])))) * (1.0f / 16.0f);
        const float pf = wave_incl_scan(vf), pb = wave_incl_scan(vb);
        const float tot = __int_as_float(__builtin_amdgcn_readlane(__float_as_int(pb), 63));
        bb[k] = pf; cc[k] = tot - pb + vb; }
    __syncthreads();
    { float* vp = L + G_V + (tid >> 3) * 68 + (tid & 7) * 8; const u32x4 vw = g.vw;
      vp[0] = bflo(vw.x); vp[1] = bfhi(vw.x); vp[2] = bflo(vw.y); vp[3] = bfhi(vw.y); vp[4] = bflo(vw.z); vp[5] = bfhi(vw.z); vp[6] = bflo(vw.w); vp[7] = bfhi(vw.w); }
    { const u32x2 qw = g.qw, kw = g.kw; const float qv[4] = {bflo(qw.x), bfhi(qw.x), bflo(qw.y), bfhi(qw.y)}, kv[4] = {bflo(kw.x), bfhi(kw.x), bflo(kw.y), bfhi(kw.y)};
#pragma unroll
      for (int k = 0; k < 4; ++k) { const int d = 4 * wid + k; const float qs = qv[k] * 0.17677669529663687f;
          if (NEED_Q) { L[G_QF + lane * 33 + d] = qs * __expf(bb[k]); L[G_QB + lane * 33 + d] = qs * __expf(cc[k]); }
          L[G_KF + d * 68 + lane] = kv[k] * __expf(-bb[k]); L[G_KB + d * 68 + lane] = kv[k] * __expf(-cc[k]);
          if (!NEED_Q) { if (lane == 63) L[G_GF + 63 * 33 + d] = bb[k];
                         if (lane == 0) L[G_GB + d] = cc[k]; } } }
    __syncthreads();
}
__device__ __forceinline__ int crow32(int r, int hi) { return (r & 3) + 8 * (r >> 2) + 4 * hi; }
__device__ __forceinline__ void gla_pass1(KP p, int l, float* L) {
    const int tid = opaque_tid(), wid = tid >> 6, lane = tid & 63, c = lane & 31, kh = lane >> 5; unsigned char* ws = opaque_ptr(p->ws);
    float* SF = (float*)(ws + T_SF); float* SB = (float*)(ws + T_SB); float* DF = (float*)(ws + T_DF); float* DB = (float*)(ws + T_DB);
    int it = opaque_bid(); if (it >= 2048) return;
    GlaLoads cur = gla_issue<false>(p, it);
    for (; it < 2048; it += gridDim.x) {
        const int h = it & 3, n = (it >> 2) & 127, b = it >> 9;
        const int itn = it + (int)gridDim.x < 2048 ? it + (int)gridDim.x : it;
        const GlaLoads nxt = gla_issue<false>(p, itn);
        gla_prepare<false>(p, l, h, cur, L);
        cur = nxt;
        if (wid < 4) {
            const int te = wid & 1, dir = wid >> 1; const float* Kx = L + (dir ? G_KB : G_KF) + c * 68 + kh; const float* Vx = L + G_V + kh * 68 + 32 * te + c;
            f32x16 acc = {};
#pragma unroll 8
            for (int kk = 0; kk < 32; ++kk) acc = __builtin_amdgcn_mfma_f32_32x32x2f32(Kx[2 * kk], Vx[2 * kk * 68], acc, 0, 0, 0);
            float* Sx = (dir ? SB : SF) + ((size_t)((b * 4 + h) * 128 + n)) * 2048 + 32 * te + c;
#pragma unroll
            for (int r = 0; r < 16; ++r) { const int d = crow32(r, kh); const float sc = __expf(dir ? L[G_GB + d] : L[G_GF + 63 * 33 + d]); Sx[d * 64] = acc[r] * sc; }
        }
        if (tid < 32) { DF[((b * 4 + h) * 128 + n) * 32 + tid] = __expf(L[G_GF + 63 * 33 + tid]); DB[((b * 4 + h) * 128 + n) * 32 + tid] = __expf(L[G_GB + tid]); }
    }
}
__device__ __forceinline__ void gla_pass2(KP p) {
    unsigned char* ws = opaque_ptr(p->ws); const int gid = opaque_bid() * NTHR + opaque_tid();
    if (gid >= 65536) return;
    const int bh = gid >> 12, dir = (gid >> 11) & 1, el = gid & 2047, d = el >> 6;
    float* S = (float*)(ws + (dir ? T_SB : T_SF)) + (size_t)bh * 128 * 2048 + el; const float* Dc = (const float*)(ws + (dir ? T_DB : T_DF)) + bh * 128 * 32 + d;
    float st = 0.f;
    for (int n0 = 0; n0 < 128; n0 += 32) {
        float Lv[32], Dv[32];
#pragma unroll
        for (int k = 0; k < 32; ++k) { const int n = dir ? 127 - (n0 + k) : n0 + k; Lv[k] = S[(size_t)n * 2048]; Dv[k] = Dc[n * 32]; }
#pragma unroll
        for (int k = 0; k < 32; ++k) { const int n = dir ? 127 - (n0 + k) : n0 + k; S[(size_t)n * 2048] = st; st = Dv[k] * st + Lv[k]; }
    }
}
__device__ __forceinline__ void gla_pass3(KP p, int l, float* L) {
    const int tid = opaque_tid(), wid = tid >> 6, lane = tid & 63, c = lane & 31, kh = lane >> 5; unsigned char* ws = opaque_ptr(p->ws);
    const float* SF = (const float*)(ws + T_SF); const float* SB = (const float*)(ws + T_SB);
    const bf16_t* gin = (const bf16_t*)(ws + T_GIN); bf16_t* mixb = (bf16_t*)(ws + T_MIXB);
    int it = opaque_bid(); if (it >= 2048) return;
    GlaLoads cur = gla_issue<true>(p, it);
    for (; it < 2048; it += gridDim.x) {
        const int h = it & 3, n = (it >> 2) & 127, b = it >> 9;
        const size_t so = ((size_t)((b * 4 + h) * 128 + n)) * 2048 + tid * 4;
        const f32x4 sreg = *(const f32x4*)(SF + so), treg = *(const f32x4*)(SB + so);
        const int i0 = (tid >> 4) * 2, e0 = (tid & 15) * 4;
        const u32x2 rw0 = *(const u32x2*)(gin + (size_t)(b * SEQ + n * 64 + i0) * 832 + 544 + h * 64 + e0), rw1 = *(const u32x2*)(gin + (size_t)(b * SEQ + n * 64 + i0 + 1) * 832 + 544 + h * 64 + e0);
        const f32x4 gn = *(const f32x4*)(p->in[27] + l * 64 + e0);
        const int itn = it + (int)gridDim.x < 2048 ? it + (int)gridDim.x : it;
        const GlaLoads nxt = gla_issue<true>(p, itn);
        gla_prepare<true>(p, l, h, cur, L);
        cur = nxt;
        { const int d = tid >> 4; *(f32x4*)(L + G_S + d * 68 + e0) = sreg; *(f32x4*)(L + G_T + d * 68 + e0) = treg; }
        { const int ti = (wid >> 1) & 1, tj = wid & 1, dir = wid >> 2;
          const float* Qx = L + (dir ? G_QB : G_QF) + (32 * ti + c) * 33 + kh; const float* Kx = L + (dir ? G_KB : G_KF) + kh * 68 + 32 * tj + c;
          f32x16 acc = {};
#pragma unroll
          for (int kk = 0; kk < 16; ++kk) acc = __builtin_amdgcn_mfma_f32_32x32x2f32(Qx[2 * kk], Kx[2 * kk * 68], acc, 0, 0, 0);
          const int j = 32 * tj + c;
#pragma unroll
          for (int r = 0; r < 16; ++r) { const int i = 32 * ti + crow32(r, kh); const bool mine = dir ? (j > i) : (j <= i); if (mine) L[G_A + i * 65 + j] = acc[r]; } }
        __syncthreads();
        { const int ti = (wid >> 1) & 1, te = wid & 1, half = wid >> 2; f32x16 acc = {};
          if (half == 0) {
              const float* Ax = L + G_A + (32 * ti + c) * 65 + kh; const float* Vx = L + G_V + kh * 68 + 32 * te + c;
#pragma unroll 8
              for (int kk = 0; kk < 32; ++kk) acc = __builtin_amdgcn_mfma_f32_32x32x2f32(Ax[2 * kk], Vx[2 * kk * 68], acc, 0, 0, 0);
          } else {
              const float* Qf = L + G_QF + (32 * ti + c) * 33 + kh; const float* Qb = L + G_QB + (32 * ti + c) * 33 + kh;
              const float* Sx = L + G_S + kh * 68 + 32 * te + c; const float* Tx = L + G_T + kh * 68 + 32 * te + c;
#pragma unroll
              for (int kk = 0; kk < 16; ++kk) acc = __builtin_amdgcn_mfma_f32_32x32x2f32(Qf[2 * kk], Sx[2 * kk * 68], acc, 0, 0, 0);
#pragma unroll
              for (int kk = 0; kk < 16; ++kk) acc = __builtin_amdgcn_mfma_f32_32x32x2f32(Qb[2 * kk], Tx[2 * kk * 68], acc, 0, 0, 0);
#pragma unroll
              for (int r = 0; r < 16; ++r) L[G_O1 + (32 * ti + crow32(r, kh)) * 68 + 32 * te + c] = acc[r];
          }
          __syncthreads();
          if (half == 0) {
#pragma unroll
              for (int r = 0; r < 16; ++r) { const int o = (32 * ti + crow32(r, kh)) * 68 + 32 * te + c; L[G_O + o] = acc[r] + L[G_O1 + o]; }
          } }
        __syncthreads();
        const f32x4 o0 = *(const f32x4*)(L + G_O + i0 * 68 + e0), o1 = *(const f32x4*)(L + G_O + (i0 + 1) * 68 + e0);
        float s0 = o0[0] * o0[0] + o0[1] * o0[1] + o0[2] * o0[2] + o0[3] * o0[3], s1 = o1[0] * o1[0] + o1[1] * o1[1] + o1[2] * o1[2] + o1[3] * o1[3];
        s0 = dpp_add<0x128, 0xf>(s0); s0 = dpp_add<0x124, 0xf>(s0); s0 = dpp_add<0x122, 0xf>(s0); s0 = dpp_add<0x121, 0xf>(s0);
        s1 = dpp_add<0x128, 0xf>(s1); s1 = dpp_add<0x124, 0xf>(s1); s1 = dpp_add<0x122, 0xf>(s1); s1 = dpp_add<0x121, 0xf>(s1);
        const float r0 = rsqrtf(s0 * (1.0f / 64.0f) + 1e-6f), r1 = rsqrtf(s1 * (1.0f / 64.0f) + 1e-6f);
#pragma unroll
        for (int rr = 0; rr < 2; ++rr) { const int row = b * SEQ + n * 64 + i0 + rr; const f32x4 ov = rr ? o1 : o0; const float rs = rr ? r1 : r0;
            const u32x2 rw = rr ? rw1 : rw0; const float rv[4] = {bflo(rw.x), bfhi(rw.x), bflo(rw.y), bfhi(rw.y)};
            float ot[4];
#pragma unroll
            for (int k = 0; k < 4; ++k) ot[k] = ov[k] * rs * gn[k] * (rv[k] * __builtin_amdgcn_rcpf(1.f + __expf(-rv[k])));
            u32x2 w; w.x = cvt_pk_bf16(ot[0], ot[1]); w.y = cvt_pk_bf16(ot[2], ot[3]); *(u32x2*)(mixb + (size_t)row * DM + 768 + h * 64 + e0) = w; }
    }
}

__device__ __forceinline__ void mix_assemble(KP p, int l, float* L) {
    const int tid = opaque_tid(), wid = tid >> 6, lane = tid & 63; unsigned char* ws = opaque_ptr(p->ws);
    const bf16_t* hy = (const bf16_t*)(ws + T_HYT); bf16_t* mixb = (bf16_t*)(ws + T_MIXB); const bf16_t* atto = (const bf16_t*)(ws + T_ATTO);
    const float* gh = p->in[17] + l * 256; const float* gm = p->in[22] + l * 512;
    float* tile = L; float* red = L + 256 * 65;
    for (int it = opaque_bid(); it < NTOK / 64; it += gridDim.x) {
        const int row0 = it * 64;
        __syncthreads();
        { const int c = tid >> 1, t0 = (tid & 1) * 32; const bf16_t* sp = hy + (size_t)c * NTOK + row0 + t0;
#pragma unroll
          for (int q = 0; q < 4; ++q) { const u32x4 w = *(const u32x4*)(sp + q * 8); float* tp = tile + c * 65 + t0 + q * 8;
              tp[0] = bflo(w.x); tp[1] = bfhi(w.x); tp[2] = bflo(w.y); tp[3] = bfhi(w.y); tp[4] = bflo(w.z); tp[5] = bfhi(w.z); tp[6] = bflo(w.w); tp[7] = bfhi(w.w); } }
        __syncthreads();
        { const int t = tid & 63, part = tid >> 6; float ss = 0.f;
#pragma unroll 8
          for (int cc = 0; cc < 32; ++cc) { const float v = tile[(part * 32 + cc) * 65 + t]; ss += v * v; }
          red[part * 64 + t] = ss; }
        __syncthreads();
        { const int t = tid >> 3, cg8 = (tid & 7) * 32; float ss = 0.f;
#pragma unroll
          for (int q = 0; q < 8; ++q) ss += red[q * 64 + t];
          const float rs = rsqrtf(ss * (1.0f / 256.0f) + 1e-6f); bf16_t* op = mixb + (size_t)(row0 + t) * DM + cg8;
#pragma unroll
          for (int q = 0; q < 4; ++q) { float v[8];
#pragma unroll
              for (int k = 0; k < 8; ++k) v[k] = tile[(cg8 + q * 8 + k) * 65 + t] * rs * gh[cg8 + q * 8 + k];
              u32x4 w; w.x = cvt_pk_bf16(v[0], v[1]); w.y = cvt_pk_bf16(v[2], v[3]); w.z = cvt_pk_bf16(v[4], v[5]); w.w = cvt_pk_bf16(v[6], v[7]);
              *(u32x4*)(op + q * 8) = w; } }
    }
    for (int rb = (opaque_bid() * 8 + wid) * 4; rb < NTOK; rb += gridDim.x * 32) {
        u32x4 w[4];
#pragma unroll
        for (int q = 0; q < 4; ++q) w[q] = *(const u32x4*)(atto + (size_t)(rb + q) * 512 + lane * 8);
        const f32x4 g0 = *(const f32x4*)(gm + lane * 8), g1 = *(const f32x4*)(gm + lane * 8 + 4);
#pragma unroll
        for (int q = 0; q < 4; ++q) {
            float v[8] = {bflo(w[q].x), bfhi(w[q].x), bflo(w[q].y), bfhi(w[q].y), bflo(w[q].z), bfhi(w[q].z), bflo(w[q].w), bfhi(w[q].w)}; float ss = 0.f;
#pragma unroll
            for (int k = 0; k < 8; ++k) ss += v[k] * v[k];
#pragma unroll
            for (int sft = 1; sft < 64; sft <<= 1) ss += __shfl_xor(ss, sft);
            const float rs = rsqrtf(ss * (1.0f / 512.0f) + 1e-6f);
#pragma unroll
            for (int k = 0; k < 8; ++k) v[k] *= rs * (k < 4 ? g0[k & 3] : g1[k & 3]);
            u32x4 o; o.x = cvt_pk_bf16(v[0], v[1]); o.y = cvt_pk_bf16(v[2], v[3]); o.z = cvt_pk_bf16(v[4], v[5]); o.w = cvt_pk_bf16(v[6], v[7]);
            *(u32x4*)(mixb + (size_t)(rb + q) * DM + 256 + lane * 8) = o;
        }
    }
}

#define XB_TMO      128
#define XB_XCNT(j)  (256  + 64 * (j))
#define XB_XSUB(j)  (1280 + 64 * (j))
#define XB_XGEN(j)  (2304 + 64 * (j))
#define XB_TOP      3328
#define XB_TOPGEN   3392
#define XCD_BAR_WORDS 3456
#define XB_SPIN_CAP (1u << 20)
__device__ __forceinline__ unsigned xb_ld(unsigned* p)              { return __hip_atomic_load(p, __ATOMIC_RELAXED, __HIP_MEMORY_SCOPE_AGENT); }
__device__ __forceinline__ unsigned xb_add(unsigned* p, unsigned v) { return __hip_atomic_fetch_add(p, v, __ATOMIC_RELAXED, __HIP_MEMORY_SCOPE_AGENT); }
__device__ __forceinline__ unsigned xb_xcc_id() { return (unsigned)__builtin_amdgcn_s_getreg((3 << 11) | 20) & 0xFu; }
#define XB_SPIN(cond, bar) do { unsigned _sp = 0; while (cond) { __builtin_amdgcn_s_sleep(1); \
    if ((++_sp & 255u) == 0u) { if (xb_ld(&(bar)[XB_TMO])) break; if (_sp > XB_SPIN_CAP) { atomicAdd(&(bar)[XB_TMO], 1u); break; } } } } while (0)
struct XcdBarrier { unsigned* bar; unsigned x; volatile LAS unsigned* st; };
__device__ __forceinline__ XcdBarrier xcd_barrier_post(unsigned* bar, volatile LAS unsigned* st) {
    XcdBarrier b; b.bar = bar; b.x = xb_xcc_id(); b.st = st;
    if (threadIdx.x == 0) (void)xb_add(&bar[XB_XCNT(b.x)], 1u);
    return b;
}
__device__ __forceinline__ void xcd_barrier_complete(unsigned* bar, unsigned x, unsigned& nloc, unsigned& nx) {
    const unsigned G = gridDim.x * gridDim.y * gridDim.z;
    unsigned sum, cnt, mine, sp = 0u;
    for (;;) {
        sum = 0u; cnt = 0u; mine = 0u;
#pragma unroll
        for (unsigned j = 0; j < 16; ++j) { const unsigned c = xb_ld(&bar[XB_XCNT(j)]); sum += c; cnt += (c > 0u) ? 1u : 0u; mine = (j == x) ? c : mine; }
        if (sum == G) break;
        __builtin_amdgcn_s_sleep(1);
        if ((++sp & 255u) == 0u) { if (xb_ld(&bar[XB_TMO])) break; if (sp > XB_SPIN_CAP) { atomicAdd(&bar[XB_TMO], 1u); break; } }
    }
    nloc = mine > 0u ? mine : 1u; nx = cnt > 0u ? cnt : 1u;
}
__device__ __forceinline__ void xcd_barrier(const XcdBarrier& b) {
    asm volatile("s_waitcnt vmcnt(0)" ::: "memory");
    __syncthreads();
    if (threadIdx.x == 0) {
        unsigned* bar = b.bar;
        __builtin_amdgcn_s_waitcnt(0);
        unsigned nloc = b.st[0], nx = b.st[1];
        if (nloc == 0u) { xcd_barrier_complete(bar, b.x, nloc, nx); b.st[0] = nloc; b.st[1] = nx; }
        const unsigned old = xb_add(&bar[XB_XSUB(b.x)], 1u);
        const unsigned gen = old / nloc;
        if (old + 1u == (gen + 1u) * nloc) {
            __builtin_amdgcn_fence(__ATOMIC_RELEASE, "agent");
            asm volatile("s_waitcnt vmcnt(0)" ::: "memory");
            const unsigned og = xb_add(&bar[XB_TOP], 1u);
            const unsigned tg = og / nx;
            if (og + 1u == (tg + 1u) * nx) xb_add(&bar[XB_TOPGEN], 1u);
            else XB_SPIN(xb_ld(&bar[XB_TOPGEN]) == tg, bar);
            __builtin_amdgcn_fence(__ATOMIC_ACQUIRE, "agent");
            xb_add(&bar[XB_XGEN(b.x)], 1u);
            asm volatile("s_waitcnt vmcnt(0)" ::: "memory");
        } else {
            XB_SPIN(xb_ld(&bar[XB_XGEN(b.x)]) == gen, bar);
            __builtin_amdgcn_fence(__ATOMIC_ACQUIRE, "agent");
            asm volatile("s_waitcnt vmcnt(0)" ::: "memory");
        }
    }
    __syncthreads();
}

template <int SEL> __global__ __launch_bounds__(NTHR, 2) void mega_t(Params pv) {
    extern __shared__ __attribute__((aligned(16))) unsigned char shm[];
    cg::grid_group grid = cg::this_grid();
    __shared__ uint4 xb_words;
    if (threadIdx.x == 0) xb_words = make_uint4(0u, 0u, 0u, 0u);
    __syncthreads();
    const XcdBarrier xb = xcd_barrier_post((unsigned*)(pv.ws + OFF_BAR), (volatile LAS unsigned*)&xb_words);
    const KP kp = (KP)__builtin_amdgcn_kernarg_segment_ptr();
    unsigned char* ws = pv.ws;
    float* X = pv.out; bf16_t* XB = (bf16_t*)(ws + OFF_XB); float* SSX = (float*)(ws + OFF_SSX);
    for (int ph = pv.ph_lo; ph < pv.ph_hi; ++ph) {
        KP p = kp; asm volatile("" : "+s"(p));
        if (ph == 0) { if constexpr (SEL < 0 || SEL == 100) for (int r0 = 0; r0 < (PROBE_REP == 100 ? 2 : 1); ++r0) phase_prep(p, (float*)shm); }
        else if (ph == 19) { if constexpr (SEL < 0 || SEL == 101) {
            const float* g = p->in[33]; const int tid = opaque_tid(), wid = tid >> 6, lane = tid & 63;
            f32x4 gv[4];
#pragma unroll
            for (int i = 0; i < 4; ++i) gv[i] = *(const f32x4*)(g + lane * 16 + 4 * i);
            for (int rb = (opaque_bid() * 8 + wid) * 4; rb < NTOK; rb += gridDim.x * 32) {
                u32x4 w0[4], w1[4]; float rs[4];
#pragma unroll
                for (int q = 0; q < 4; ++q) { const bf16_t* bp = XB + (size_t)(rb + q) * DM + lane * 16; w0[q] = *(const u32x4*)bp; w1[q] = *(const u32x4*)(bp + 8); rs[q] = rstd16(SSX, rb + q); }
#pragma unroll
                for (int q = 0; q < 4; ++q) { float* xp = X + (size_t)(rb + q) * DM + lane * 16;
                    const float xv[16] = {bflo(w0[q].x), bfhi(w0[q].x), bflo(w0[q].y), bfhi(w0[q].y), bflo(w0[q].z), bfhi(w0[q].z), bflo(w0[q].w), bfhi(w0[q].w), bflo(w1[q].x), bfhi(w1[q].x), bflo(w1[q].y), bfhi(w1[q].y), bflo(w1[q].z), bfhi(w1[q].z), bflo(w1[q].w), bfhi(w1[q].w)};
#pragma unroll
                    for (int i = 0; i < 4; ++i) { f32x4 v = {xv[4 * i], xv[4 * i + 1], xv[4 * i + 2], xv[4 * i + 3]}; v = v * rs[q] * gv[i]; *(f32x4*)(xp + 4 * i) = v; } }
            } }
        } else {
            const int l = (ph - 1) / 9, sp = (ph - 1) % 9;
            pg8::StaticOrder S;
            if constexpr (SEL < 0 || SEL == 0) if (sp == 0 || sp == 7) {
                const int f = sp == 0 ? 0 : 1;
                pg8::Gemm g{XB, (const bf16_t*)(ws + OFF_WUP + (l * 2 + f) * SZ_WUP), NTOK, 5632, 1024, 1024}; S.init(g.M, g.N, gridDim.x, opaque_bid());
                EpiFfnUp E{ws, -1, {0.f, 0.f, 0.f, 0.f, 0.f, 0.f, 0.f, 0.f}};
                for (int r1 = 0; r1 < (PROBE_REP == 0 ? 2 : 1); ++r1) pg8::gemm_phase(( LAS unsigned char*)shm, g, S, E);
            }
            if constexpr (SEL < 0 || SEL == 1) if (sp == 1 || sp == 8) {
                const int f = sp == 1 ? 0 : 1;
                pg8::Gemm g{(const bf16_t*)(ws + T_ACT), (const bf16_t*)(ws + OFF_WDN + (l * 2 + f) * SZ_WDN), NTOK, 1024, FF, FF}; S.init(g.M, g.N, gridDim.x, opaque_bid());
                for (int r1 = (PROBE_REP == 1 ? 0 : 1); r1 < 2; ++r1) { EpiResid E{ws, r1 == 0 ? 0.f : 0.5f};
                pg8::gemm_phase((LAS unsigned char*)shm, g, S, E); }
            }
            if constexpr (SEL < 0 || SEL == 2) if (sp == 2) {
                pg8::Gemm g{XB, (const bf16_t*)(ws + OFF_WIN + l * SZ_WIN), NTOK, 2048, 1024, 1024}; S.init(g.M, g.N, gridDim.x, opaque_bid());
                EpiWin E{ws};
                for (int r1 = 0; r1 < (PROBE_REP == 2 ? 2 : 1); ++r1) pg8::gemm_phase((LAS unsigned char*)shm, g, S, E);
            }
            if constexpr (SEL < 0 || SEL == 30 || SEL == 31 || SEL == 32) if (sp == 3) {
                if constexpr (SEL < 0 || SEL == 30) for (int r3 = 0; r3 < (PROBE_REP == 30 ? 2 : 1); ++r3) {
                { pg8::Gemm g{(const bf16_t*)(ws + T_CQB), (const bf16_t*)(ws + OFF_WUQ + l * SZ_WUQ), NTOK, 768, 256, 256}; S.init(g.M, g.N, gridDim.x, opaque_bid());
                  EpiUq E{ws};
                  pg8::gemm_phase((LAS unsigned char*)shm, g, S, E); }
                { pg8::Gemm g{(const bf16_t*)(ws + T_CKVB), (const bf16_t*)(ws + OFF_WUKV + l * SZ_WUKV), NTOK, 1024, 256, 256}; S.init(g.M, g.N, gridDim.x, opaque_bid());
                  EpiUkv E{ws};
                  pg8::gemm_phase((LAS unsigned char*)shm, g, S, E); }
                }
                if constexpr (SEL < 0 || SEL == 31) for (int r3 = (PROBE_REP == 31 ? 0 : 1); r3 < 2; ++r3) for (int c = opaque_bid(); c < 256; c += gridDim.x) hyena_item(p, l, c, (float2*)shm, r3 == 1);
                if constexpr (SEL < 0 || SEL == 32) for (int r3 = 0; r3 < (PROBE_REP == 32 ? 2 : 1); ++r3) gla_pass1(p, l, (float*)shm);
            }
            if constexpr (SEL < 0 || SEL == 4) if (sp == 4) {
                gla_pass2(p);
                const bf16_t* QN = (const bf16_t*)(ws + T_QN); const bf16_t* QR = (const bf16_t*)(ws + T_QR); const bf16_t* KN = (const bf16_t*)(ws + T_KN);
                const bf16_t* KR = (const bf16_t*)(ws + T_KR); const bf16_t* VV = (const bf16_t*)(ws + T_V); bf16_t* AO = (bf16_t*)(ws + T_ATTO);
                const int nper = (512 * 8) / (int)gridDim.x;
                (void)nper;
                for (int r4 = 0; r4 < (PROBE_REP == 4 ? 2 : 1); ++r4)
                for (int it = opaque_bid(); it < 512; it += gridDim.x) {
                    const int x = it & 7, y = it >> 3;
                    const int bh = x + 8 * (y >> 5), qb = y & 31;
                    const int b = bh >> 2, h = bh & 3;
                    const size_t hoff = ((size_t)bh * SEQ) * 128;
                    att::attn_body(QN + hoff + (size_t)qb * 256 * 128, QR + ((size_t)bh * SEQ + qb * 256) * 64, KN + hoff, KR + (size_t)b * SEQ * 64, VV + hoff,
                                   AO + ((size_t)b * SEQ + qb * 256) * 512 + h * 128, SEQ, (char*)shm);
                }
            }
            if constexpr (SEL < 0 || SEL == 5) if (sp == 5) {
                for (int r5 = 0; r5 < (PROBE_REP == 50 ? 2 : 1); ++r5) mix_assemble(p, l, (float*)shm);
                for (int r5 = 0; r5 < (PROBE_REP == 51 ? 2 : 1); ++r5) gla_pass3(p, l, (float*)shm);
            }
            if constexpr (SEL < 0 || SEL == 6) if (sp == 6) {
                pg8::Gemm g{(const bf16_t*)(ws + T_MIXB), (const bf16_t*)(ws + OFF_WOUT + l * SZ_WOUT), NTOK, 1024, 1024, 1024}; S.init(g.M, g.N, gridDim.x, opaque_bid());
                for (int r1 = (PROBE_REP == 6 ? 0 : 1); r1 < 2; ++r1) { EpiResid E{ws, r1 == 0 ? 0.f : 1.0f};
                pg8::gemm_phase((LAS unsigned char*)shm, g, S, E); }
            }
        }
        if (ph + 1 < pv.ph_hi) { if (pv.ph_hi > 1000) grid.sync(); else xcd_barrier(xb); }
    }
}

#if MK_COOP
#define MEGA_MAIN mega_t<-1>
#else
#define MEGA_MAIN mega_t<0>
#endif
extern "C" void kernel_launch(void* const* d_in, const int* in_sizes, int n_in, void* d_out, int out_size, void* d_ws, size_t ws_size, hipStream_t stream) {
    static int grid_blocks = 0;
    if (grid_blocks == 0) {
        if (n_in != 34 || out_size != NTOK * DM || ws_size < WS_END) { fprintf(stderr, "kernel_launch: unexpected shapes n_in %d out %d ws %zu (need %zu)\n", n_in, out_size, ws_size, (size_t)WS_END); grid_blocks = -1; return; }
        if (hipFuncSetAttribute((const void*)MEGA_MAIN, hipFuncAttributeMaxDynamicSharedMemorySize, LDS_BYTES) != hipSuccess) { fprintf(stderr, "kernel_launch: hipFuncSetAttribute failed\n"); grid_blocks = -1; return; }
        int dev = 0, cus = 0, per_cu = 0;
        (void)hipGetDevice(&dev); (void)hipDeviceGetAttribute(&cus, hipDeviceAttributeMultiprocessorCount, dev);
        (void)hipOccupancyMaxActiveBlocksPerMultiprocessor(&per_cu, (const void*)MEGA_MAIN, NTHR, LDS_BYTES);
        if (per_cu < 1) { fprintf(stderr, "kernel_launch: occupancy query says %d blocks/CU\n", per_cu); per_cu = 1; }
        (void)hipGetLastError();
        grid_blocks = cus * per_cu;
        fprintf(stderr, "kernel_launch: grid %d (cus %d x %d)\n", grid_blocks, cus, per_cu);
    }
    if (grid_blocks < 0) return;
    Params p{};
    for (int i = 0; i < 34; ++i) p.in[i] = (const float*)d_in[i];
    p.out = (float*)d_out; p.ws = (unsigned char*)d_ws;
    if (hipMemsetAsync((unsigned char*)d_ws + OFF_BAR, 0, 16384, stream) != hipSuccess) { fprintf(stderr, "kernel_launch: memset of barrier words failed\n"); return; }
#if MK_COOP == 2
    for (int ph = 0; ph < 20; ++ph) { p.ph_lo = ph; p.ph_hi = ph + 1; hipLaunchKernelGGL(mega_t<-1>, dim3(grid_blocks), dim3(NTHR), LDS_BYTES, stream, p); }
#elif MK_COOP
    p.ph_lo = 0; p.ph_hi = 20;
    void* args[] = {&p};
    hipError_t e = hipLaunchCooperativeKernel((const void*)mega_t<-1>, dim3(grid_blocks), dim3(NTHR), args, LDS_BYTES, stream);
    if (e != hipSuccess) fprintf(stderr, "cooperative launch failed: %s (grid %d)\n", hipGetErrorString(e), grid_blocks);
#else
    static int attr_done = 0;
    if (!attr_done) {
        attr_done = 1;
        (void)hipFuncSetAttribute((const void*)mega_t<0>, hipFuncAttributeMaxDynamicSharedMemorySize, LDS_BYTES); (void)hipFuncSetAttribute((const void*)mega_t<1>, hipFuncAttributeMaxDynamicSharedMemorySize, LDS_BYTES);
        (void)hipFuncSetAttribute((const void*)mega_t<2>, hipFuncAttributeMaxDynamicSharedMemorySize, LDS_BYTES); (void)hipFuncSetAttribute((const void*)mega_t<30>, hipFuncAttributeMaxDynamicSharedMemorySize, LDS_BYTES); (void)hipFuncSetAttribute((const void*)mega_t<31>, hipFuncAttributeMaxDynamicSharedMemorySize, LDS_BYTES); (void)hipFuncSetAttribute((const void*)mega_t<32>, hipFuncAttributeMaxDynamicSharedMemorySize, LDS_BYTES);
        (void)hipFuncSetAttribute((const void*)mega_t<4>, hipFuncAttributeMaxDynamicSharedMemorySize, LDS_BYTES); (void)hipFuncSetAttribute((const void*)mega_t<5>, hipFuncAttributeMaxDynamicSharedMemorySize, LDS_BYTES);
        (void)hipFuncSetAttribute((const void*)mega_t<6>, hipFuncAttributeMaxDynamicSharedMemorySize, LDS_BYTES); (void)hipFuncSetAttribute((const void*)mega_t<100>, hipFuncAttributeMaxDynamicSharedMemorySize, LDS_BYTES);
        (void)hipFuncSetAttribute((const void*)mega_t<101>, hipFuncAttributeMaxDynamicSharedMemorySize, LDS_BYTES);
    }
    for (int ph = 0; ph < 20; ++ph) {
        p.ph_lo = ph; p.ph_hi = ph + 1;
        const int sp = (ph == 0) ? 100 : (ph == 19) ? 101 : (ph - 1) % 9;
        switch (sp) {
            case 0: case 7: hipLaunchKernelGGL(mega_t<0>, dim3(grid_blocks), dim3(NTHR), LDS_BYTES, stream, p); break;
            case 1: case 8: hipLaunchKernelGGL(mega_t<1>, dim3(grid_blocks), dim3(NTHR), LDS_BYTES, stream, p); break;
            case 2: hipLaunchKernelGGL(mega_t<2>, dim3(grid_blocks), dim3(NTHR), LDS_BYTES, stream, p); break;
            case 3: hipLaunchKernelGGL(mega_t<30>, dim3(grid_blocks), dim3(NTHR), LDS_BYTES, stream, p); hipLaunchKernelGGL(mega_t<31>, dim3(grid_blocks), dim3(NTHR), LDS_BYTES, stream, p);
                    hipLaunchKernelGGL(mega_t<32>, dim3(grid_blocks), dim3(NTHR), LDS_BYTES, stream, p); break;
            case 4: hipLaunchKernelGGL(mega_t<4>, dim3(grid_blocks), dim3(NTHR), LDS_BYTES, stream, p); break;
            case 5: hipLaunchKernelGGL(mega_t<5>, dim3(grid_blocks), dim3(NTHR), LDS_BYTES, stream, p); break;
            case 6: hipLaunchKernelGGL(mega_t<6>, dim3(grid_blocks), dim3(NTHR), LDS_BYTES, stream, p); break;
            case 100: hipLaunchKernelGGL(mega_t<100>, dim3(grid_blocks), dim3(NTHR), LDS_BYTES, stream, p); break;
            default: hipLaunchKernelGGL(mega_t<101>, dim3(grid_blocks), dim3(NTHR), LDS_BYTES, stream, p); break;
        }
    }
#endif
}
```
